# Optimizing an MI355X kernel written in HIP

```python
import jax, jax.numpy as jnp
from jax import lax
import numpy as np

D_MODEL = 1024
BATCH = 8
SEQ = 8192
DEPTH = 1

HEAD_DIM = 64
MIX_WIDTH = D_MODEL
FOURIER_WIDTH = MIX_WIDTH // 2
ATTN_WIDTH = MIX_WIDTH - FOURIER_WIDTH
N_FOURIER_GROUPS = FOURIER_WIDTH // HEAD_DIM
N_SLOTS = ATTN_WIDTH // HEAD_DIM
DILATED_CONFIGS = ((128, 1), (512, 4), (2048, 16))
N_CFG = len(DILATED_CONFIGS)
N_ATTN_HEADS = N_SLOTS * N_CFG
QKV_WIDTH = N_ATTN_HEADS * HEAD_DIM
IN_WIDTH = 2 * FOURIER_WIDTH + 3 * QKV_WIDTH + ATTN_WIDTH
SPLIT_POINTS = tuple(int(p) for p in np.cumsum([FOURIER_WIDTH, FOURIER_WIDTH, QKV_WIDTH, QKV_WIDTH, QKV_WIDTH]))
NORM_EPS = 1e-6
MASK_VALUE = -1e30

kernel_name = "hymba_fnet_longnet_encoder_block"


def alibi_slopes(n):
    return 2.0 ** (-8.0 * jnp.arange(1, n + 1, dtype=jnp.float32) / n)


def rms_norm(t, w):
    t32 = t.astype(jnp.float32)
    return t32 * lax.rsqrt(jnp.mean(t32 * t32, axis=-1, keepdims=True) + NORM_EPS) * w.astype(jnp.float32)


def dilated_window_attention(q, k, v, window, dilation, slopes):
    B, S, H, DH = q.shape
    radius = window // (2 * dilation)
    blk = radius
    L = S // dilation
    N = B * dilation
    nb = -(-L // blk)
    Lp = nb * blk

    def to_sub(t):
        return t.reshape(B, L, dilation, H, DH).transpose(0, 2, 1, 3, 4).reshape(N, L, H, DH)

    qs, ks, vs = to_sub(q), to_sub(k), to_sub(v)
    qb = jnp.pad(qs, ((0, 0), (0, Lp - L), (0, 0), (0, 0))).reshape(N, nb, blk, H, DH)
    pad_kv = ((0, 0), (blk, Lp - L + blk), (0, 0), (0, 0))
    kp = jnp.pad(ks, pad_kv).reshape(N, nb + 2, blk, H, DH)
    vp = jnp.pad(vs, pad_kv).reshape(N, nb + 2, blk, H, DH)
    kb = jnp.concatenate([kp[:, :-2], kp[:, 1:-1], kp[:, 2:]], axis=2)
    vb = jnp.concatenate([vp[:, :-2], vp[:, 1:-1], vp[:, 2:]], axis=2)

    scores = jnp.einsum('nbqhd,nbkhd->nbhqk', qb, kb)
    a = jnp.arange(blk)[:, None]
    c = jnp.arange(3 * blk)[None, :]
    rel = c - blk - a
    key_pos = jnp.arange(nb)[:, None, None] * blk - blk + c[None]
    valid = (jnp.abs(rel)[None] <= radius) & (key_pos >= 0) & (key_pos < L)
    dist = (jnp.abs(rel) * dilation).astype(jnp.float32)
    bias = -slopes[:, None, None] * dist[None]
    scores = jnp.where(valid[None, :, None], scores + bias[None, None], MASK_VALUE)

    m = jnp.max(scores, axis=-1, keepdims=True)
    p = jnp.exp(scores - m)
    s = jnp.sum(p, axis=-1, keepdims=True)
    o = jnp.einsum('nbhqk,nbkhd->nbqhd', p / s, vb)
    lse = (m + jnp.log(s))[..., 0].transpose(0, 1, 3, 2)

    o = o.reshape(N, Lp, H, DH)[:, :L].reshape(B, dilation, L, H, DH).transpose(0, 2, 1, 3, 4).reshape(B, S, H, DH)
    lse = lse.reshape(N, Lp, H)[:, :L].reshape(B, dilation, L, H).transpose(0, 2, 1, 3).reshape(B, S, H)
    return o, lse


def setup_inputs(seed: int = 0) -> dict:
    key = jax.random.key(seed)
    ks = jax.random.split(key, 7)
    x = jax.random.normal(ks[0], (BATCH, SEQ, D_MODEL), jnp.float32)
    norm_w = 1.0 + 0.02 * jax.random.normal(ks[1], (D_MODEL,), jnp.float32)
    w_in = jax.random.normal(ks[2], (D_MODEL, IN_WIDTH), jnp.float32) * D_MODEL ** -0.5
    q_norm_w = 1.0 + 0.02 * jax.random.normal(ks[3], (N_ATTN_HEADS, HEAD_DIM), jnp.float32)
    k_norm_w = 1.0 + 0.02 * jax.random.normal(ks[4], (N_ATTN_HEADS, HEAD_DIM), jnp.float32)
    w_fourier = jax.random.normal(ks[5], (N_FOURIER_GROUPS, HEAD_DIM, HEAD_DIM), jnp.float32) * HEAD_DIM ** -0.5
    w_out = jax.random.normal(ks[6], (MIX_WIDTH, D_MODEL), jnp.float32) * MIX_WIDTH ** -0.5
    return {"x": x, "norm_w": norm_w, "w_in": w_in, "q_norm_w": q_norm_w,
            "k_norm_w": k_norm_w, "w_fourier": w_fourier, "w_out": w_out}


def reference(x, norm_w, w_in, q_norm_w, k_norm_w, w_fourier, w_out):
    B, S, _ = x.shape
    slopes = alibi_slopes(N_SLOTS)
    h = x.astype(jnp.float32)
    for _layer in range(DEPTH):
        hn = rms_norm(h, norm_w)
        proj = hn @ w_in.astype(jnp.float32)
        u_f, g_f, q, k, v, g_a = jnp.split(proj, SPLIT_POINTS, axis=-1)

        u_f = u_f.reshape(B, S, N_FOURIER_GROUPS, HEAD_DIM)
        f = jnp.fft.fft2(u_f, axes=(1, 3), norm="ortho").real.astype(jnp.float32)
        f = jnp.einsum('bsgc,gcd->bsgd', f, w_fourier.astype(jnp.float32)).reshape(B, S, FOURIER_WIDTH)
        y_f = f * jax.nn.silu(g_f)

        q = rms_norm(q.reshape(B, S, N_ATTN_HEADS, HEAD_DIM), q_norm_w) * HEAD_DIM ** -0.5
        k = rms_norm(k.reshape(B, S, N_ATTN_HEADS, HEAD_DIM), k_norm_w)
        v = v.reshape(B, S, N_ATTN_HEADS, HEAD_DIM)
        outs, lses = [], []
        for c, (window, dilation) in enumerate(DILATED_CONFIGS):
            sl = slice(c * N_SLOTS, (c + 1) * N_SLOTS)
            o_c, lse_c = dilated_window_attention(q[:, :, sl], k[:, :, sl], v[:, :, sl], window, dilation, slopes)
            outs.append(o_c)
            lses.append(lse_c)
        alpha = jax.nn.softmax(jnp.stack(lses, axis=0), axis=0)
        o = jnp.sum(alpha[..., None] * jnp.stack(outs, axis=0), axis=0).reshape(B, S, ATTN_WIDTH)
        y_a = o * jax.nn.silu(g_a)

        mixed = jnp.concatenate([y_f, y_a], axis=-1) @ w_out.astype(jnp.float32)
        h = h + mixed
    return h.astype(x.dtype)
```

```cpp
#include <hip/hip_runtime.h>
#include <hip/hip_cooperative_groups.h>
#include <cstdio>
#include <cstdint>
namespace cg = cooperative_groups;
namespace pg8 {
#define PG8_LAS __attribute__((address_space(3)))
typedef unsigned short bf16_t;
typedef short bf16x8 __attribute__((ext_vector_type(8)));
typedef float f32x4 __attribute__((ext_vector_type(4)));
typedef unsigned u32x4 __attribute__((ext_vector_type(4)));
constexpr int BM = 256, BK = 64, HALF = 128, HTB = HALF * BK * 2  , STAGE_BYTES = 8 * HTB, NXCD = 8, WGM = 8;

__host__ __device__ __forceinline__ int lds_byte(int r, int c) { const int st = (r >> 4) * 2 + (c >> 5), rr = r & 15, cc = c & 31, ob = rr * 64 + cc * 2; return st * 1024 + (ob ^ (((ob >> 9) & 1) << 5)); }
__host__ __device__ __forceinline__ void stage_rc(int b, int& R, int& C) { const int st = b / 1024, sb = b % 1024, swz = sb ^ (((sb >> 9) & 1) << 5); R = (st >> 1) * 16 + swz / 64; C = (st & 1) * 32 + (swz % 64) / 2; }
__host__ __device__ __forceinline__ int perm32(int rho) { const int n = rho >> 4, i = rho & 15; return 8 * (i >> 2) + 4 * n + (i & 3); }

struct Unit { int pm, pn; };
struct Gemm { const bf16_t* A; const bf16_t* Bt; int M, N, K; };

struct StaticOrder {
    int nM, nN, nwg, G, c, rep;
    __host__ __device__ void init(int M, int N, int G_, int c_, int rep_ = 1) { nM = M / BM; nN = N / BM; nwg = nM * nN; G = G_; c = c_; rep = rep_; }
    __host__ __device__ bool next(int i, Unit& u) const {
        const int per = (nwg + G - 1) / G; if (i >= per * rep) return false; const long L = (long)(i % per) * G + c; if (L >= nwg) return false;
        int wgid = (int)L; { const int q = nwg / NXCD, r = nwg % NXCD, xcd = wgid % NXCD, off = wgid / NXCD; wgid = (xcd < r ? xcd * (q + 1) : r * (q + 1) + (xcd - r) * q) + off; }
        const int nig = WGM * nN, gid = wgid / nig, fm = gid * WGM, gsz = (nM - fm) < WGM ? (nM - fm) : WGM;
        u.pm = fm + ((wgid % nig) % gsz); u.pn = (wgid % nig) / gsz; return true;
    }
    __device__ __forceinline__ void a_ready(const Unit&) const {}
    __device__ __forceinline__ void done(const Unit&) const {}
};

__device__ __forceinline__ unsigned cvt_pk_bf16(float lo, float hi) { unsigned r; asm volatile("v_cvt_pk_bf16_f32 %0, %1, %2" : "=v"(r) : "v"(lo), "v"(hi)); return r; }
typedef float f32x2 __attribute__((ext_vector_type(2)));
template <class Epi, class Sched, bool ALIGN_EPI = false, bool SP2 = false>
__device__ __forceinline__ void gemm_phase(PG8_LAS unsigned char* lds, const Gemm g, const Sched& S, const Epi& E) {
    const int tid = threadIdx.x, wid = __builtin_amdgcn_readfirstlane(tid >> 6), lane = tid & 63, wr = wid >> 2, wc = wid & 3, fr = lane & 15, fq = lane >> 4;
    const int K = g.K, nt = K / BK;
    unsigned voffA[2], voffB[2];
#pragma unroll
    for (int i = 0; i < 2; ++i) { int R, C; stage_rc(tid * 16 + i * 8192, R, C); const int Rb = Epi::PERM2 ? (64 * (R >> 5) + perm32(R & 31)) : (Epi::PERM ? ((R & ~31) + perm32(R & 31)) : R);
        voffA[i] = (unsigned)(R * K + C) * 2u; voffB[i] = (unsigned)(Rb * K + C) * 2u; }
    const size_t kstep = (size_t)(BK * 2);
    const size_t hstep = (size_t)HALF * K * 2;
    const size_t hstepB = Epi::PERM2 ? (size_t)32 * K * 2 : hstep;
    const size_t tstep = 2 * hstep;
    const unsigned ldsw = (unsigned)wid * 1024u;
    const int aoff = lds_byte(wr * 64 + fr, fq * 8), boff = lds_byte(wc * 32 + fr, fq * 8);
#define PG8_SA(b, h) (((b) * 2 + (h)) * HTB)
#define PG8_SB(b, h) ((4 + (b) * 2 + (h)) * HTB)
#define PG8_STAGE(bufoff, gbase, voff) do { _Pragma("unroll") for (int _i = 0; _i < 2; ++_i) \
        __builtin_amdgcn_global_load_lds((const unsigned*)((const char*)(gbase) + (voff)[_i]), (PG8_LAS unsigned*)(lds + (bufoff) + ldsw + _i * 8192), 16, 0, 0); } while (0)
#define PG8_LDA(dst, b, h) do { _Pragma("unroll") for (int m = 0; m < 4; ++m) _Pragma("unroll") for (int k = 0; k < 2; ++k) dst[m][k] = *(const PG8_LAS bf16x8*)(lds + PG8_SA(b, h) + aoff + m * 2048 + k * 1024); } while (0)
#define PG8_LDB(dst, b, h) do { _Pragma("unroll") for (int n = 0; n < 2; ++n) _Pragma("unroll") for (int k = 0; k < 2; ++k) dst[n][k] = *(const PG8_LAS bf16x8*)(lds + PG8_SB(b, h) + boff + n * 2048 + k * 1024); } while (0)
#define PG8_MMA(ai, bj, At, Bt) do { __builtin_amdgcn_s_setprio(1); _Pragma("unroll") for (int m = 0; m < 4; ++m) _Pragma("unroll") for (int n = 0; n < 2; ++n) _Pragma("unroll") for (int k = 0; k < 2; ++k) \
        acc[ai][bj][m][n] = __builtin_amdgcn_mfma_f32_16x16x32_bf16(Bt[n][k], At[m][k], acc[ai][bj][m][n], 0, 0, 0); __builtin_amdgcn_s_setprio(0); } while (0)
#define PG8_WAIT_V(n) asm volatile("s_waitcnt vmcnt(" #n ")" ::: "memory")
#define PG8_WAIT_L(n) asm volatile("s_waitcnt lgkmcnt(" #n ")" ::: "memory")
#define PG8_BAR __builtin_amdgcn_s_barrier()
#define PG8_SCHED __builtin_amdgcn_sched_barrier(0)
    Unit cur, nxt; int ui = 0;
    if (!S.next(0, cur)) return;
    f32x4 acc[2][2][4][2];
#pragma unroll
    for (int a = 0; a < 2; ++a)
#pragma unroll
        for (int b = 0; b < 2; ++b)
#pragma unroll
            for (int m = 0; m < 4; ++m)
#pragma unroll
                for (int n = 0; n < 2; ++n) acc[a][b][m][n] = (f32x4){0.f, 0.f, 0.f, 0.f};
    bf16x8 At[4][2], B0[2][2], B1[2][2];
    const char* cA = (const char*)g.A + (size_t)cur.pm * tstep; const char* cB = (const char*)g.Bt + (size_t)cur.pn * tstep;
    S.a_ready(cur);
    if constexpr (SP2) {
        PG8_STAGE(PG8_SB(0, 0), cB, voffB); PG8_STAGE(PG8_SB(0, 1), cB + hstepB, voffB); PG8_STAGE(PG8_SA(0, 0), cA, voffA); PG8_STAGE(PG8_SA(0, 1), cA + hstep, voffA);
        if (wr == 1) PG8_BAR;
        PG8_WAIT_V(2); PG8_BAR;
        PG8_STAGE(PG8_SB(1, 0), cB + kstep, voffB); PG8_STAGE(PG8_SA(1, 0), cA + kstep, voffA); PG8_STAGE(PG8_SB(1, 1), cB + hstepB + kstep, voffB);
        PG8_WAIT_V(6); PG8_BAR;
    } else {
        PG8_STAGE(PG8_SB(0, 0), cB, voffB); PG8_STAGE(PG8_SA(0, 0), cA, voffA); PG8_STAGE(PG8_SB(0, 1), cB + hstepB, voffB); PG8_STAGE(PG8_SA(0, 1), cA + hstep, voffA);
        if (wr == 1) PG8_BAR;
        PG8_WAIT_V(4); PG8_BAR;
        PG8_STAGE(PG8_SB(1, 0), cB + kstep, voffB); PG8_STAGE(PG8_SA(1, 0), cA + kstep, voffA); PG8_STAGE(PG8_SB(1, 1), cB + hstepB + kstep, voffB);
        PG8_WAIT_V(6); PG8_BAR;
    }
    for (;;) {
        const bool has_next = S.next(ui + 1, nxt);
        const char* nA = has_next ? (const char*)g.A + (size_t)nxt.pm * tstep : cA; const char* nB = has_next ? (const char*)g.Bt + (size_t)nxt.pn * tstep : cB;
        for (int t = 0; t < nt; t += 2) {
            const bool last = (t == nt - 2);
            const char* a1 = cA + (size_t)(t + 1) * kstep;
            const char* a2 = last ? nA : cA + (size_t)(t + 2) * kstep; const char* b2 = last ? nB : cB + (size_t)(t + 2) * kstep;
            const char* a3 = a2 + kstep; const char* b3 = b2 + kstep;
            if (last && has_next) S.a_ready(nxt);
            if constexpr (SP2) {
            PG8_LDB(B0, 0, 0); PG8_LDB(B1, 0, 1); PG8_SCHED; PG8_LDA(At, 0, 0); PG8_STAGE(PG8_SA(1, 1), a1 + hstep, voffA);
            PG8_WAIT_V(8); PG8_WAIT_L(0); PG8_BAR; PG8_MMA(0, 0, At, B0); PG8_MMA(0, 1, At, B1); PG8_BAR; PG8_SCHED;
            PG8_LDA(At, 0, 1); PG8_STAGE(PG8_SB(0, 0), b2, voffB); PG8_STAGE(PG8_SB(0, 1), b2 + hstepB, voffB); PG8_STAGE(PG8_SA(0, 0), a2, voffA);
            PG8_WAIT_V(8); PG8_WAIT_L(0); PG8_BAR; PG8_MMA(1, 0, At, B0); PG8_MMA(1, 1, At, B1); PG8_BAR; PG8_SCHED;
            PG8_LDB(B0, 1, 0); PG8_LDB(B1, 1, 1); PG8_SCHED; PG8_LDA(At, 1, 0); PG8_STAGE(PG8_SA(0, 1), a2 + hstep, voffA);
            PG8_WAIT_V(8); PG8_WAIT_L(0); PG8_BAR; PG8_MMA(0, 0, At, B0); PG8_MMA(0, 1, At, B1); PG8_BAR; PG8_SCHED;
            PG8_LDA(At, 1, 1); PG8_STAGE(PG8_SB(1, 0), b3, voffB); PG8_STAGE(PG8_SB(1, 1), b3 + hstepB, voffB); PG8_STAGE(PG8_SA(1, 0), a3, voffA);
            PG8_WAIT_V(8); PG8_WAIT_L(0); PG8_BAR; PG8_MMA(1, 0, At, B0); PG8_MMA(1, 1, At, B1); PG8_BAR; PG8_SCHED;
            } else {
            PG8_LDB(B0, 0, 0); PG8_SCHED; PG8_LDA(At, 0, 0); PG8_STAGE(PG8_SA(1, 1), a1 + hstep, voffA);
            PG8_WAIT_L(8); PG8_BAR; PG8_WAIT_L(0); PG8_MMA(0, 0, At, B0); PG8_BAR; PG8_SCHED;
            PG8_LDB(B1, 0, 1); PG8_STAGE(PG8_SB(0, 0), b2, voffB);
            PG8_BAR; PG8_WAIT_L(0); PG8_MMA(0, 1, At, B1); PG8_BAR;
            PG8_LDA(At, 0, 1); PG8_STAGE(PG8_SA(0, 0), a2, voffA);
            PG8_BAR; PG8_WAIT_L(0); PG8_MMA(1, 0, At, B0); PG8_BAR; PG8_SCHED;
            PG8_STAGE(PG8_SB(0, 1), b2 + hstepB, voffB);
            PG8_WAIT_V(6); PG8_BAR; PG8_MMA(1, 1, At, B1); PG8_BAR;
            PG8_LDB(B0, 1, 0); PG8_SCHED; PG8_LDA(At, 1, 0); PG8_STAGE(PG8_SA(0, 1), a2 + hstep, voffA);
            PG8_WAIT_L(8); PG8_BAR; PG8_WAIT_L(0); PG8_MMA(0, 0, At, B0); PG8_BAR; PG8_SCHED;
            PG8_LDB(B1, 1, 1); PG8_STAGE(PG8_SB(1, 0), b3, voffB);
            PG8_BAR; PG8_WAIT_L(0); PG8_MMA(0, 1, At, B1); PG8_BAR;
            PG8_LDA(At, 1, 1); PG8_STAGE(PG8_SA(1, 0), a3, voffA);
            PG8_BAR; PG8_WAIT_L(0); PG8_MMA(1, 0, At, B0); PG8_BAR; PG8_SCHED;
            PG8_STAGE(PG8_SB(1, 1), b3 + hstepB, voffB);
            PG8_WAIT_V(6); PG8_BAR; PG8_MMA(1, 1, At, B1); PG8_BAR;
            }
        }
        if constexpr (ALIGN_EPI) { if (wr == 0) PG8_BAR; }
        if constexpr (!Epi::AFTER_DRAIN) { E(acc, cur, wr, wc, fr, fq); S.done(cur); }
        if (!has_next) break;
#pragma unroll
        for (int a = 0; a < 2; ++a)
#pragma unroll
            for (int b = 0; b < 2; ++b)
#pragma unroll
                for (int m = 0; m < 4; ++m)
#pragma unroll
                    for (int n = 0; n < 2; ++n) acc[a][b][m][n] = (f32x4){0.f, 0.f, 0.f, 0.f};
        cur = nxt; cA = nA; cB = nB; ++ui;
        if constexpr (ALIGN_EPI) { if (wr == 1) PG8_BAR; }
    }
    PG8_WAIT_V(0);
    if constexpr (!ALIGN_EPI) { if (wr == 0) PG8_BAR; }
    PG8_BAR;
    if constexpr (Epi::AFTER_DRAIN) { E.fused(acc, cur, wr, wc, fr, fq, lds, wid, lane); S.done(cur); }
#undef PG8_SA
#undef PG8_SB
#undef PG8_STAGE
#undef PG8_LDA
#undef PG8_LDB
#undef PG8_MMA
#undef PG8_WAIT_V
#undef PG8_WAIT_L
#undef PG8_BAR
#undef PG8_SCHED
}
}
#define LAS __attribute__((address_space(3)))
typedef unsigned short bf16_t;
typedef short bf16x8 __attribute__((ext_vector_type(8)));
typedef short s16x4 __attribute__((ext_vector_type(4)));
typedef short v4i16_t __attribute__((ext_vector_type(4)));
typedef float f32x4 __attribute__((ext_vector_type(4)));
typedef float f32x16 __attribute__((ext_vector_type(16)));
typedef unsigned u32x4 __attribute__((ext_vector_type(4)));
typedef unsigned u32x2 __attribute__((ext_vector_type(2)));

constexpr int SEQ = 8192, DM = 1024, MTOK = 65536, NIN = 6144, QKVW = 1536;
constexpr size_t WS_WT = 0, WS_WOT = 13631488, WS_RS = 15728640, WS_LSE = 15990784, WS_BAR = 23068672, WS_GMT = 24117248, WS_XB = 33554432, WS_Z = 167772160, WS_G = 301989888,
                 WS_Q = 436207616, WS_K = 637534208, WS_V = 838860800, WS_END = 1040187392;
constexpr int LDS_BYTES = 162816;
constexpr float LOG2E = 1.4426950408889634f;

__device__ __forceinline__ unsigned f2bf(float f) { unsigned u = __builtin_bit_cast(unsigned, f); return (u + 0x7fffu + ((u >> 16) & 1u)) >> 16; }
typedef float f32x2_t __attribute__((ext_vector_type(2))); typedef __bf16 bf16x2_t __attribute__((ext_vector_type(2)));
__device__ __forceinline__ unsigned pk2(float lo, float hi) { f32x2_t v = {lo, hi}; bf16x2_t b = __builtin_convertvector(v, bf16x2_t); return __builtin_bit_cast(unsigned, b); }
__device__ __forceinline__ float bflo(unsigned w) { return __builtin_bit_cast(float, w << 16); }
__device__ __forceinline__ float bfhi(unsigned w) { return __builtin_bit_cast(float, w & 0xffff0000u); }
__device__ __forceinline__ int crow(int r, int hi) { return (r & 3) + 8 * (r >> 2) + 4 * hi; }
__device__ __forceinline__ float wave_sum(float v) {
#pragma unroll
    for (int o = 1; o < 64; o <<= 1) v += __shfl_xor(v, o);
    return v;
}
__device__ __forceinline__ s16x4 trrd(LAS const unsigned char* p) { return __builtin_bit_cast(s16x4, __builtin_amdgcn_ds_read_tr16_b64_v4i16((LAS v4i16_t*)p)); }
__device__ __forceinline__ float silu_f(float v) { return v * __builtin_amdgcn_rcpf(1.f + __builtin_amdgcn_exp2f(-v * LOG2E)); }
#define LDS_WAIT() asm volatile("s_waitcnt lgkmcnt(0)" ::: "memory")
template <int CTRL> __device__ __forceinline__ unsigned dpp_mov(unsigned v) { return (unsigned)__builtin_amdgcn_update_dpp(0, (int)v, CTRL, 0xF, 0xF, true); }
template <int CTRL> __device__ __forceinline__ float dpp_movf(float v) { return __builtin_bit_cast(float, dpp_mov<CTRL>(__builtin_bit_cast(unsigned, v))); }

struct Args { const float *x, *norm_w, *w_in, *qw, *kw, *wf, *w_out; float* out; unsigned char* ws; };

__device__ __forceinline__ void transpose_item(const float* W, int ldw, int ncol0, bf16_t* WT, int row_off, const float* kscale, LAS float* scr, int kb, int nb, int lane) {
    const int k0 = 64 * kb, n0 = 32 * nb;
#pragma unroll 8
    for (int i = 0; i < 32; ++i) { const int kk = 2 * i + (lane >> 5); float v = W[(size_t)(k0 + kk) * ldw + ncol0 + n0 + (lane & 31)]; if (kscale) v *= kscale[k0 + kk]; scr[kk * 33 + (lane & 31)] = v; }
    LDS_WAIT();
    const int c = lane & 7;
#pragma unroll
    for (int j = 0; j < 4; ++j) { const int n = (lane >> 3) + 8 * j; const LAS float* s = scr + (8 * c) * 33 + n;
        u32x4 o; o.x = pk2(s[0 * 33], s[1 * 33]); o.y = pk2(s[2 * 33], s[3 * 33]); o.z = pk2(s[4 * 33], s[5 * 33]); o.w = pk2(s[6 * 33], s[7 * 33]);
        *(u32x4*)(WT + (size_t)(row_off + n0 + n) * 1024 + k0 + 8 * c) = o; }
    LDS_WAIT();
}
__device__ __forceinline__ void gmt_unit(const Args& a, LAS unsigned char* lds, int unit, int tid) {
    bf16_t* GmT = (bf16_t*)(a.ws + WS_GMT);
    LAS float* tab = (LAS float*)lds;
    if (tid < 64) { float sn, cs; sincospif((float)tid * (1.f / 32.f), &sn, &cs); tab[2 * tid] = cs; tab[2 * tid + 1] = sn; }
    __syncthreads();
    const int g = unit >> 2, d = 16 * (unit & 3) + (tid >> 5), c32 = tid & 31;
    float acc[4] = {0.f, 0.f, 0.f, 0.f};
    for (int l = 0; l < 64; ++l) { const float w = a.wf[(size_t)(g * 64 + l) * 64 + d];
#pragma unroll
        for (int e = 0; e < 4; ++e) { const int cc = c32 * 4 + e, c = cc & 63, idx = (l * c) & 63; acc[e] += w * (cc < 64 ? tab[2 * idx] : -tab[2 * idx + 1]); } }
#pragma unroll
    for (int e = 0; e < 4; ++e) GmT[(size_t)(g * 64 + d) * 128 + c32 * 4 + e] = (bf16_t)f2bf(acc[e] * 0.125f);
    __syncthreads();
}
__device__ __forceinline__ void phase0(const Args& a, LAS unsigned char* lds, int tid, int lane, int wave) {
    bf16_t* Wt = (bf16_t*)(a.ws + WS_WT); bf16_t* WoT = (bf16_t*)(a.ws + WS_WOT); bf16_t* xb = (bf16_t*)(a.ws + WS_XB);
    const int G = gridDim.x, bx = blockIdx.x;
    for (int u = bx; u < 32; u += G) gmt_unit(a, lds, u, tid);
    if (bx == G - 1 && wave < 3) {
        for (int hd = wave * 8; hd < wave * 8 + 8; ++hd) {
            float gqm = fabsf(a.qw[hd * 64 + lane]), gkm = fabsf(a.kw[hd * 64 + lane]);
#pragma unroll
            for (int o = 1; o < 64; o <<= 1) { gqm = fmaxf(gqm, __shfl_xor(gqm, o)); gkm = fmaxf(gkm, __shfl_xor(gkm, o)); }
            if (lane == 0) ((float*)(a.ws + WS_RS))[hd] = 8.08f * LOG2E * gqm * gkm;
        }
    }
    LAS float* scr = (LAS float*)(lds + 32768 + wave * 8448);
    const int gw = bx * 8 + wave, NGW = G * 8;
    constexpr int I_IN = 16 * 192, I_OUT = 16 * 32;
    for (int it = gw; it < I_IN + I_OUT; it += NGW) {
        if (it < I_IN) transpose_item(a.w_in, 6144, 0, Wt, 0, a.norm_w, scr, it / 192, it % 192, lane);
        else { const int r = it - I_IN; transpose_item(a.w_out, 1024, 0, WoT, 0, nullptr, scr, r / 32, r % 32, lane); }
    }
    for (int row = gw; row < MTOK; row += 2 * NGW) {
        const int row2 = row + NGW; const bool has2 = row2 < MTOK;
        const f32x4* xr = (const f32x4*)(a.x + (size_t)row * DM) + lane; const f32x4* xr2 = (const f32x4*)(a.x + (size_t)(has2 ? row2 : row) * DM) + lane;
        f32x4 v[4], v2[4]; float s = 0.f, s2 = 0.f;
#pragma unroll
        for (int j = 0; j < 4; ++j) { v[j] = __builtin_nontemporal_load(xr + 64 * j); v2[j] = __builtin_nontemporal_load(xr2 + 64 * j); }
#pragma unroll
        for (int j = 0; j < 4; ++j) { s += (v[j].x * v[j].x + v[j].y * v[j].y) + (v[j].z * v[j].z + v[j].w * v[j].w); s2 += (v2[j].x * v2[j].x + v2[j].y * v2[j].y) + (v2[j].z * v2[j].z + v2[j].w * v2[j].w); }
        s = wave_sum(s); s2 = wave_sum(s2);
        const float r = 1.0f / sqrtf(s * (1.f / DM) + 1e-6f), r2 = 1.0f / sqrtf(s2 * (1.f / DM) + 1e-6f);
        u32x2* o = (u32x2*)(xb + (size_t)row * DM) + lane;
#pragma unroll
        for (int j = 0; j < 4; ++j) { u32x2 w; w.x = pk2(v[j].x * r, v[j].y * r); w.y = pk2(v[j].z * r, v[j].w * r); o[64 * j] = w; }
        if (has2) { u32x2* o2 = (u32x2*)(xb + (size_t)row2 * DM) + lane;
#pragma unroll
            for (int j = 0; j < 4; ++j) { u32x2 w; w.x = pk2(v2[j].x * r2, v2[j].y * r2); w.y = pk2(v2[j].z * r2, v2[j].w * r2); o2[64 * j] = w; } }
    }
}

struct Epi1 {
    static constexpr bool PERM = true, PERM2 = true, AFTER_DRAIN = false;
    bf16_t *Z, *G, *Q, *Kb, *V;
    __device__ __forceinline__ void operator()(const pg8::f32x4 (&acc)[2][2][4][2], const pg8::Unit& u, int wr, int wc, int fr, int fq) const {
        const int pn = u.pn; const int hi8 = (fr >> 3) & 1, fr7 = fr & 7; const int rbase = u.pm * 256 + wr * 64 + fr7;
        const bool qkv = (pn >= 4 && pn < 22);
        const bool act = !qkv && pn >= 2;
        const int ld = pn < 2 ? 512 : 1024;
        bf16_t* base; int dsh = 0; size_t rowstride_tok = 0; int ecol;
        if (qkv) { const int which = (pn - 4) / 6, ct = (pn - 4) % 6; dsh = 2 * (ct >> 1);
            base = Q + (size_t)which * ((WS_K - WS_Q) / 2) + (size_t)(ct * 4 + wc) * SEQ * 64; ecol = 32 * hi8 + 8 * fq; }
        else { const int c0 = pn < 2 ? pn * 256 : (pn < 4 ? (pn - 2) * 256 : 512 + (pn - 22) * 256); base = (pn < 2 ? Z : G) + c0 + wc * 64; ecol = 32 * hi8 + 8 * fq; }
        const int dmask = (1 << dsh) - 1, Lc = SEQ >> dsh;
#pragma unroll
        for (int ai = 0; ai < 2; ++ai)
#pragma unroll
            for (int m = 0; m < 4; ++m) {
                pg8::f32x4 a0 = acc[ai][0][m][0], a1 = acc[ai][0][m][1], b0 = acc[ai][1][m][0], b1 = acc[ai][1][m][1];
                if (act) {
#pragma unroll
                    for (int e = 0; e < 4; ++e) { a0[e] = silu_f(a0[e]); a1[e] = silu_f(a1[e]); b0[e] = silu_f(b0[e]); b1[e] = silu_f(b1[e]); } }
                u32x4 A, B; A.x = pk2(a0[0], a0[1]); A.y = pk2(a0[2], a0[3]); A.z = pk2(a1[0], a1[1]); A.w = pk2(a1[2], a1[3]);
                B.x = pk2(b0[0], b0[1]); B.y = pk2(b0[2], b0[3]); B.z = pk2(b1[0], b1[1]); B.w = pk2(b1[2], b1[3]);
                u32x4 snd, rcv;
#pragma unroll
                for (int e = 0; e < 4; ++e) { snd[e] = hi8 ? A[e] : B[e]; rcv[e] = dpp_mov<0x128>(snd[e]); }
                u32x4 d1, d2;
#pragma unroll
                for (int e = 0; e < 4; ++e) { d1[e] = hi8 ? rcv[e] : A[e]; d2[e] = hi8 ? B[e] : rcv[e]; }
                const int row1 = rbase + ai * 128 + m * 16, row2 = row1 + 8;
                if (qkv) {
                    const int bb = row1 >> 13, t1 = row1 & (SEQ - 1), t2 = row2 & (SEQ - 1);
                    const int p1 = (t1 & dmask) * Lc + (t1 >> dsh), p2 = (t2 & dmask) * Lc + (t2 >> dsh);
                    bf16_t* hb = base + (size_t)bb * 24 * SEQ * 64 + ecol;
                    *(u32x4*)(hb + (size_t)p1 * 64) = d1; *(u32x4*)(hb + (size_t)p2 * 64) = d2;
                } else {
                    *(u32x4*)(base + (size_t)row1 * ld + ecol) = d1; *(u32x4*)(base + (size_t)row2 * ld + ecol) = d2;
                }
            }
    }
};
struct Epi2 {
    static constexpr bool PERM = false, PERM2 = false, AFTER_DRAIN = false;
    const float* x; float* out;
    __device__ __forceinline__ void operator()(const pg8::f32x4 (&acc)[2][2][4][2], const pg8::Unit& u, int wr, int wc, int fr, int fq) const {
        const int row0 = u.pm * 256 + wr * 64 + fr, col0 = u.pn * 256 + wc * 32 + 4 * fq;
#pragma unroll
        for (int ai = 0; ai < 2; ++ai)
#pragma unroll
            for (int m = 0; m < 4; ++m) { const size_t off = (size_t)(row0 + ai * 128 + m * 16) * DM + col0;
#pragma unroll
                for (int bj = 0; bj < 2; ++bj)
#pragma unroll
                    for (int n = 0; n < 2; ++n) { const size_t o2 = off + bj * 128 + n * 16; *(pg8::f32x4*)(out + o2) = *(const pg8::f32x4*)(x + o2) + acc[ai][bj][m][n]; }
                if (m & 1) asm volatile("" ::: "memory"); }
    }
};

constexpr int TP = 192;
constexpr int TTP = 272;
template <int NROWS> __device__ __forceinline__ void load_tile(LAS unsigned char* lds, const bf16_t* src, size_t rstride, int tid) {
    u32x4 v[NROWS / 64];
#pragma unroll
    for (int i = 0; i < NROWS / 64; ++i) { const int ci = tid + 512 * i, row = ci >> 3, ch = ci & 7; v[i] = *(const u32x4*)(src + (size_t)row * rstride + ch * 8); }
#pragma unroll
    for (int i = 0; i < NROWS / 64; ++i) { const int ci = tid + 512 * i, row = ci >> 3, ch = ci & 7; *(LAS u32x4*)(lds + row * TP + ch * 16) = v[i]; }
}
__device__ __forceinline__ void dft1_phase(const Args& a, LAS unsigned char* lds, int tid, int lane, int wave) {
    asm volatile("" : "+v"(tid), "+v"(lane));
    const bf16_t* Z = (const bf16_t*)(a.ws + WS_Z); bf16_t* Y = (bf16_t*)(a.ws + WS_XB);
    const int h = lane >> 5, l31 = lane & 31, kb = wave & 3, nt = wave >> 2;
    bf16x8 af[8];
    { const int ri_row = l31 >> 4, k1 = 16 * kb + (l31 & 15);
#pragma unroll
      for (int ks = 0; ks < 8; ++ks) { unsigned pw[4];
#pragma unroll
        for (int jj = 0; jj < 4; ++jj) { float vv[2];
#pragma unroll
            for (int e = 0; e < 2; ++e) { const int s1 = 16 * ks + 8 * h + 2 * jj + e; float sn, cs; sincospif((float)((s1 * k1) & 127) * (1.f / 64.f), &sn, &cs);
                float val = ri_row == 0 ? cs : sn;
                if (ri_row == 1 && k1 == 0) val = (s1 & 1) ? -1.f : 1.f;
                vv[e] = val * 0.08838834764831845f; }
            pw[jj] = pk2(vv[0], vv[1]); }
        u32x4 t; t.x = pw[0]; t.y = pw[1]; t.z = pw[2]; t.w = pw[3]; af[ks] = __builtin_bit_cast(bf16x8, t); } }
    const int q = (lane & 15) >> 2, p = lane & 3, blk = (lane >> 4) & 1;
    LAS const unsigned char* rb = lds + (8 * h + q) * TP + 32 * blk + 8 * p + nt * 64;
    u32x4 pf[2];
#define DFT1_ISSUE(uu) do { const int dc_ = (uu) & 7, s2_ = ((uu) >> 3) & 63, b_ = (uu) >> 9; const bf16_t* src_ = Z + ((size_t)b_ * SEQ + s2_) * 512 + dc_ * 64; \
        _Pragma("unroll") for (int i_ = 0; i_ < 2; ++i_) { const int ci_ = tid + 512 * i_; pf[i_] = *(const u32x4*)(src_ + (size_t)(ci_ >> 3) * (64 * 512) + (ci_ & 7) * 8); } } while (0)
    if ((int)blockIdx.x < 4096) DFT1_ISSUE((int)blockIdx.x);
    for (int u = blockIdx.x; u < 4096; u += gridDim.x) {
        const int dc = u & 7, s2 = (u >> 3) & 63, b = u >> 9;
#pragma unroll
        for (int i = 0; i < 2; ++i) { const int ci = tid + 512 * i; *(LAS u32x4*)(lds + (ci >> 3) * TP + (ci & 7) * 16) = pf[i]; }
        __syncthreads();
        if (u + (int)gridDim.x < 4096) DFT1_ISSUE(u + (int)gridDim.x);
        f32x16 acc = f32x16{};
#pragma unroll
        for (int ks = 0; ks < 8; ++ks) { const s16x4 lo = trrd(rb + ks * 16 * TP), hi = trrd(rb + ks * 16 * TP + 4 * TP);
            const bf16x8 bfr = __builtin_shufflevector(lo, hi, 0, 1, 2, 3, 4, 5, 6, 7);
            acc = __builtin_amdgcn_mfma_f32_32x32x16_bf16(af[ks], bfr, acc, 0, 0, 0); }
        LAS bf16_t* yt = (LAS bf16_t*)(lds + 49152);
#pragma unroll
        for (int i = 0; i < 8; ++i) { const int k1 = 16 * kb + crow(i, h); const float re = acc[i], im = acc[i + 8]; const int col = 32 * nt + l31;
            if (k1 != 0) { float sn, cs; sincospif((float)(s2 * k1) * (1.f / 4096.f), &sn, &cs);
                yt[(2 * k1) * 64 + col] = (bf16_t)f2bf(cs * re - sn * im); yt[(2 * k1 + 1) * 64 + col] = (bf16_t)f2bf(sn * re + cs * im); }
            else { float sn, cs; sincospif((float)s2 * (1.f / 64.f), &sn, &cs);
                yt[col] = (bf16_t)f2bf(re); yt[64 + col] = (bf16_t)0; yt[128 * 64 + col] = (bf16_t)f2bf(cs * im); yt[129 * 64 + col] = (bf16_t)f2bf(sn * im); } }
        __syncthreads();
#pragma unroll
        for (int z = 0; z < 3; ++z) { const int ci = tid + 512 * z; if (ci < 130 * 8) { const int row = ci >> 3, ch = ci & 7, k1 = row < 128 ? (row >> 1) : 64, ri = row < 128 ? (row & 1) : (row - 128);
            *(u32x4*)(Y + ((size_t)((b * 128 + k1) * 2 + ri) * 64 + s2) * 512 + dc * 64 + ch * 8) = *(LAS const u32x4*)(yt + row * 64 + ch * 8); } }
        __syncthreads();
    }
}
__device__ __forceinline__ void dft2_phase(const Args& a, LAS unsigned char* lds, int tid, int lane, int wave) {
    asm volatile("" : "+v"(tid), "+v"(lane));
    const bf16_t* Y = (const bf16_t*)(a.ws + WS_XB); const bf16_t* Gb = (const bf16_t*)(a.ws + WS_G); bf16_t* ym = (bf16_t*)(a.ws + WS_Z); const bf16_t* GmT = (const bf16_t*)(a.ws + WS_GMT);
    const int h = lane >> 5, l31 = lane & 31, ksub = wave >> 2, mh = (wave >> 1) & 1, nt = wave & 1;
    bf16x8 af[2][8];
#pragma unroll
    for (int z = 0; z < 2; ++z) { const int m = 64 * mh + 32 * z + l31, k2 = m & 63, imrow = m >> 6;
#pragma unroll
      for (int ks = 0; ks < 8; ++ks) { unsigned pw[4];
#pragma unroll
        for (int jj = 0; jj < 4; ++jj) { float vv[2];
#pragma unroll
            for (int e = 0; e < 2; ++e) { const int kk = 16 * ks + 8 * h + 2 * jj + e, ri = kk >> 6, s2 = kk & 63; float sn, cs; sincospif((float)((s2 * k2) & 63) * (1.f / 32.f), &sn, &cs);
                vv[e] = (imrow == 0 ? (ri == 0 ? cs : -sn) : (ri == 0 ? sn : cs)) * 0.125f; }
            pw[jj] = pk2(vv[0], vv[1]); }
        u32x4 t; t.x = pw[0]; t.y = pw[1]; t.z = pw[2]; t.w = pw[3]; af[z][ks] = __builtin_bit_cast(bf16x8, t); } }
    const int q = (lane & 15) >> 2, p = lane & 3, blk = (lane >> 4) & 1;
    LAS const unsigned char* rb = lds + (ksub * 128 + 8 * h + q) * TP + 32 * blk + 8 * p + nt * 64;
    LAS unsigned char* tt = lds + 49152;
    LAS float* ot = (LAS float*)(lds + 83968);
    const int mt2 = wave >> 1, nt2 = wave & 1;
    u32x4 ld[4];
#define DFT2_ISSUE(uu) do { const int dc_ = (uu) & 7, k1p_ = ((uu) >> 3) & 63, b_ = (uu) >> 9; \
        if (k1p_ == 0) { _Pragma("unroll") for (int z_ = 0; z_ < 2; ++z_) { const int ci_ = tid + 512 * z_; const size_t o_ = (size_t)(ci_ >> 3) * 512 + dc_ * 64 + (ci_ & 7) * 8; \
                ld[z_] = __builtin_nontemporal_load((const u32x4*)(Y + ((size_t)(b_ * 128) * 128) * 512 + o_)); ld[2 + z_] = __builtin_nontemporal_load((const u32x4*)(Y + ((size_t)(b_ * 128 + 64) * 128) * 512 + o_)); } } \
        else { const bf16_t* src_ = Y + ((size_t)(b_ * 128 + k1p_) * 128 + (tid >> 3)) * 512 + dc_ * 64 + (tid & 7) * 8; ld[0] = __builtin_nontemporal_load((const u32x4*)src_); ld[1] = __builtin_nontemporal_load((const u32x4*)(src_ + (size_t)64 * 512)); } } while (0)
    if ((int)blockIdx.x < 4096) DFT2_ISSUE((int)blockIdx.x);
    for (int u = blockIdx.x; u < 4096; u += gridDim.x) {
        const int dc = u & 7, k1p = (u >> 3) & 63, b = u >> 9;
        bf16x8 gf[8];
#pragma unroll
        for (int ks = 0; ks < 8; ++ks) gf[ks] = *(const bf16x8*)(GmT + (size_t)(dc * 64 + 32 * nt2 + l31) * 128 + 16 * ks + 8 * h);
        const int k1a = k1p, k1b = k1p == 0 ? 64 : 128 - k1p;
        const int tr_e = tid >> 2, qt_e = tid & 3; const size_t tok_e = (size_t)b * SEQ + ((tr_e >> 6) ? k1b : k1a) + 128 * (tr_e & 63);
        const u32x4 g0 = __builtin_nontemporal_load((const u32x4*)(Gb + tok_e * 1024 + dc * 64 + qt_e * 16)), g1 = __builtin_nontemporal_load((const u32x4*)(Gb + tok_e * 1024 + dc * 64 + qt_e * 16 + 8));
        if (k1p == 0) {
#pragma unroll
            for (int z = 0; z < 2; ++z) { const int ci = tid + 512 * z, row = ci >> 3, ch = ci & 7; *(LAS u32x4*)(lds + row * TP + ch * 16) = ld[z]; *(LAS u32x4*)(lds + (128 + row) * TP + ch * 16) = ld[2 + z]; }
        } else {
            const int s2 = tid >> 3, ch = tid & 7;
            const u32x4 yr = ld[0], yi = ld[1];
            float sn, cs; sincospif((float)s2 * (1.f / 32.f), &sn, &cs);
            u32x4 zr, zi;
#pragma unroll
            for (int e = 0; e < 4; ++e) { const float rl = bflo(yr[e]), rh = bfhi(yr[e]), il = bflo(yi[e]), ih = bfhi(yi[e]);
                zr[e] = pk2(rl * cs + il * sn, rh * cs + ih * sn); zi[e] = pk2(rl * sn - il * cs, rh * sn - ih * cs); }
            *(LAS u32x4*)(lds + s2 * TP + ch * 16) = yr; *(LAS u32x4*)(lds + (64 + s2) * TP + ch * 16) = yi;
            *(LAS u32x4*)(lds + (128 + s2) * TP + ch * 16) = zr; *(LAS u32x4*)(lds + (192 + s2) * TP + ch * 16) = zi;
        }
        __syncthreads();
        if (u + (int)gridDim.x < 4096) DFT2_ISSUE(u + (int)gridDim.x);
        f32x16 acc[2]; acc[0] = f32x16{}; acc[1] = f32x16{};
#pragma unroll
        for (int ks = 0; ks < 8; ++ks) { const s16x4 lo = trrd(rb + ks * 16 * TP), hi = trrd(rb + ks * 16 * TP + 4 * TP);
            const bf16x8 bfr = __builtin_shufflevector(lo, hi, 0, 1, 2, 3, 4, 5, 6, 7);
            acc[0] = __builtin_amdgcn_mfma_f32_32x32x16_bf16(af[0][ks], bfr, acc[0], 0, 0, 0);
            acc[1] = __builtin_amdgcn_mfma_f32_32x32x16_bf16(af[1][ks], bfr, acc[1], 0, 0, 0); }
#pragma unroll
        for (int z = 0; z < 2; ++z)
#pragma unroll
            for (int i = 0; i < 16; ++i) *(LAS bf16_t*)(tt + (ksub * 64 + 32 * z + crow(i, h)) * TTP + (mh * 64 + 32 * nt + l31) * 2) = (bf16_t)f2bf(acc[z][i]);
        __syncthreads();
        f32x16 o2 = f32x16{};
#pragma unroll
        for (int ks = 0; ks < 8; ++ks) { const bf16x8 tf = *(LAS const bf16x8*)(tt + (32 * mt2 + l31) * TTP + (16 * ks + 8 * h) * 2);
            o2 = __builtin_amdgcn_mfma_f32_32x32x16_bf16(tf, gf[ks], o2, 0, 0, 0); }
#pragma unroll
        for (int i = 0; i < 16; ++i) ot[(32 * mt2 + crow(i, h)) * 64 + 32 * nt2 + l31] = o2[i];
        __syncthreads();
        {
            const int tr = tid >> 2, qt = tid & 3, ks2 = tr >> 6, k2 = tr & 63;
            const size_t tok = (size_t)b * SEQ + (ks2 ? k1b : k1a) + 128 * k2;
            const LAS f32x4* op = (const LAS f32x4*)(ot + tr * 64 + qt * 16);
            const f32x4 v0 = op[0], v1 = op[1], v2 = op[2], v3 = op[3];
            u32x4 w0, w1;
            w0.x = pk2(v0.x * bflo(g0.x), v0.y * bfhi(g0.x)); w0.y = pk2(v0.z * bflo(g0.y), v0.w * bfhi(g0.y)); w0.z = pk2(v1.x * bflo(g0.z), v1.y * bfhi(g0.z)); w0.w = pk2(v1.z * bflo(g0.w), v1.w * bfhi(g0.w));
            w1.x = pk2(v2.x * bflo(g1.x), v2.y * bfhi(g1.x)); w1.y = pk2(v2.z * bflo(g1.y), v2.w * bfhi(g1.y)); w1.z = pk2(v3.x * bflo(g1.z), v3.y * bfhi(g1.z)); w1.w = pk2(v3.z * bflo(g1.w), v3.w * bfhi(g1.w));
            *(u32x4*)(ym + tok * 1024 + dc * 64 + qt * 16) = w0; *(u32x4*)(ym + tok * 1024 + dc * 64 + qt * 16 + 8) = w1;
        }
        __syncthreads();
    }
}

constexpr int KP = 144, VP = 192, KROWS = 384, LDS_VOFF = KROWS * KP, ATT_TBL = 161808;
struct AUnit { int b, hd, dil, L, r, i0; };
__device__ __forceinline__ AUnit attn_decode(int u) {
    AUnit w; const int blk32 = u & 31; w.hd = (u >> 5) % 24; w.b = u / 768;
    const int dsh = 2 * (w.hd >> 3), nbr = 32 >> dsh; w.dil = 1 << dsh; w.L = SEQ >> dsh; w.r = blk32 / nbr; w.i0 = (blk32 % nbr) * 256; return w;
}
__device__ __forceinline__ void attn_issue(const AUnit& w, const bf16_t* Qb, const bf16_t* Kb, const bf16_t* Vb, int tid, int wave, int lane, u32x4 (&kv)[6], u32x4 (&vv)[6]) {
    const int ch = tid & 7;
#pragma unroll
    for (int i = 0; i < 6; ++i) { const int row = (tid + 512 * i) >> 3; int pk = w.i0 - 64 + row; pk = pk < 0 ? 0 : (pk >= w.L ? w.L - 1 : pk);
        const size_t off = ((size_t)(w.b * 24 + w.hd) * SEQ + (size_t)(w.r * w.L + pk)) * 64 + ch * 8; kv[i] = *(const u32x4*)(Kb + off); vv[i] = *(const u32x4*)(Vb + off); }
}
__device__ __forceinline__ void attn_phase(const Args& a, LAS unsigned char* lds, int tid, int lane, int wave) {
    asm volatile("" : "+v"(tid), "+v"(lane));
    bf16_t* Qb = (bf16_t*)(a.ws + WS_Q); const bf16_t* Kb = (const bf16_t*)(a.ws + WS_K); const bf16_t* Vb = (const bf16_t*)(a.ws + WS_V); float* LSE = (float*)(a.ws + WS_LSE);
    const int h = lane >> 5, l31 = lane & 31;
    const int q = (lane & 15) >> 2, p = lane & 3, blk = (lane >> 4) & 1;
    int u = blockIdx.x;
    u32x4 kv[6], vv[6];
    if (u < 6144) { const AUnit w0 = attn_decode(u); attn_issue(w0, Qb, Kb, Vb, tid, wave, lane, kv, vv); }
    while (u < 6144) {
        const AUnit w = attn_decode(u);
        const int hd = w.hd, slot = hd & 7, L = w.L, i0 = w.i0;
        const float mb = ((const float*)(a.ws + WS_RS))[hd];
        const float bsl = __builtin_amdgcn_exp2f(-(float)(slot + 1)) * (float)w.dil * LOG2E;
        const int iq = i0 + 32 * wave + l31; const size_t tq = (size_t)w.b * SEQ + (size_t)iq * w.dil + w.r;
        bf16_t* qrow = Qb + ((size_t)(w.b * 24 + hd) * SEQ + (size_t)(w.r * L + iq)) * 64;
        u32x4 qv[4];
#pragma unroll
        for (int ks = 0; ks < 4; ++ks) qv[ks] = *(const u32x4*)(qrow + 16 * ks + 8 * h);
        {
            const int ch = tid & 7;
            const f32x4 g0 = *(const f32x4*)(a.kw + hd * 64 + ch * 8), g1 = *(const f32x4*)(a.kw + hd * 64 + ch * 8 + 4);
            if (tid < 191) { const int ar = tid < 95 ? 95 - tid : tid - 95; ((LAS float*)(lds + ATT_TBL))[tid] = ar <= 64 ? -bsl * (float)ar : -1.0e30f; }
#pragma unroll
            for (int i = 0; i < 6; ++i) { const int row = (tid + 512 * i) >> 3;
                if (ch == 0) { const int pkr = i0 - 64 + row; *(LAS float*)(lds + row * KP + 128) = (pkr >= 0 && pkr < L) ? -mb : -1.0e30f; }
                const float e0 = bflo(kv[i].x), e1 = bfhi(kv[i].x), e2 = bflo(kv[i].y), e3 = bfhi(kv[i].y), e4 = bflo(kv[i].z), e5 = bfhi(kv[i].z), e6 = bflo(kv[i].w), e7 = bfhi(kv[i].w);
                float ss = (e0 * e0 + e1 * e1) + (e2 * e2 + e3 * e3) + (e4 * e4 + e5 * e5) + (e6 * e6 + e7 * e7);
                ss += dpp_movf<0xB1>(ss); ss += dpp_movf<0x4E>(ss); ss += dpp_movf<0x141>(ss);
                const float rk = __builtin_amdgcn_rsqf(ss * (1.f / 64.f) + 1e-6f);
                u32x4 wv; wv.x = pk2(e0 * rk * g0.x, e1 * rk * g0.y); wv.y = pk2(e2 * rk * g0.z, e3 * rk * g0.w); wv.z = pk2(e4 * rk * g1.x, e5 * rk * g1.y); wv.w = pk2(e6 * rk * g1.z, e7 * rk * g1.w);
                *(LAS u32x4*)(lds + row * KP + ch * 16) = wv;
                *(LAS u32x4*)(lds + LDS_VOFF + row * VP + ch * 16) = vv[i];
                if (i & 1) __builtin_amdgcn_sched_barrier(0); }
        }
        bf16x8 qf[4];
        {
            float ss = 0.f;
#pragma unroll
            for (int ks = 0; ks < 4; ++ks)
#pragma unroll
                for (int e = 0; e < 4; ++e) { const float lo = bflo(qv[ks][e]), hi = bfhi(qv[ks][e]); ss += lo * lo + hi * hi; }
            ss += __shfl_xor(ss, 32);
            const float rq = 0.125f * LOG2E * __builtin_amdgcn_rsqf(ss * (1.f / 64.f) + 1e-6f);
#pragma unroll
            for (int ks = 0; ks < 4; ++ks) { const f32x4 g0 = *(const f32x4*)(a.qw + hd * 64 + 16 * ks + 8 * h), g1 = *(const f32x4*)(a.qw + hd * 64 + 16 * ks + 8 * h + 4); u32x4 wv;
                wv.x = pk2(bflo(qv[ks].x) * rq * g0.x, bfhi(qv[ks].x) * rq * g0.y); wv.y = pk2(bflo(qv[ks].y) * rq * g0.z, bfhi(qv[ks].y) * rq * g0.w);
                wv.z = pk2(bflo(qv[ks].z) * rq * g1.x, bfhi(qv[ks].z) * rq * g1.y); wv.w = pk2(bflo(qv[ks].w) * rq * g1.z, bfhi(qv[ks].w) * rq * g1.w);
                qf[ks] = __builtin_bit_cast(bf16x8, wv); }
        }
        __syncthreads();
        const int un = u + gridDim.x;
        if (un < 6144) { const AUnit wn = attn_decode(un); attn_issue(wn, Qb, Kb, Vb, tid, wave, lane, kv, vv); }
        int tl = 4 * h - l31; asm volatile("" : "+v"(tl));
        LAS const float* tb = (LAS const float*)(lds + ATT_TBL) + (31 + tl);
        LAS const unsigned char* ev = lds + (32 * wave + 4 * h) * KP + 128;
        float sum = 0.f;
        f32x16 o[2]; o[0] = f32x16{}; o[1] = f32x16{};
#pragma unroll
        for (int j = 0; j < 5; ++j) {
            f32x16 st;
#pragma unroll
            for (int i = 0; i < 16; ++i) st[i] = *(LAS const float*)(ev + (32 * j + (i & 3) + 8 * (i >> 2)) * KP);
            LAS const unsigned char* kp = lds + (32 * wave + 32 * j + l31) * KP + 16 * h;
#pragma unroll
            for (int ks = 0; ks < 4; ++ks) { const bf16x8 kf = *(LAS const bf16x8*)(kp + 32 * ks); st = __builtin_amdgcn_mfma_f32_32x32x16_bf16(kf, qf[ks], st, 0, 0, 0); }
#pragma unroll
            for (int i = 0; i < 16; ++i) { const float pe = __builtin_amdgcn_exp2f(st[i] + tb[32 * j + (i & 3) + 8 * (i >> 2)]); st[i] = pe; sum += pe; }
#pragma unroll
            for (int s2 = 0; s2 < 2; ++s2) { u32x4 pw; pw.x = pk2(st[8 * s2 + 0], st[8 * s2 + 1]); pw.y = pk2(st[8 * s2 + 2], st[8 * s2 + 3]); pw.z = pk2(st[8 * s2 + 4], st[8 * s2 + 5]); pw.w = pk2(st[8 * s2 + 6], st[8 * s2 + 7]);
                const bf16x8 pf = __builtin_bit_cast(bf16x8, pw);
                LAS const unsigned char* vp = lds + LDS_VOFF + (32 * wave + 32 * j + 16 * s2 + 4 * h + q) * VP + 32 * blk + 8 * p;
#pragma unroll
                for (int dt = 0; dt < 2; ++dt) { const s16x4 lo = trrd(vp + dt * 64), hi = trrd(vp + 8 * VP + dt * 64);
                    const bf16x8 vf = __builtin_shufflevector(lo, hi, 0, 1, 2, 3, 4, 5, 6, 7);
                    o[dt] = __builtin_amdgcn_mfma_f32_32x32x16_bf16(vf, pf, o[dt], 0, 0, 0); } }
            __builtin_amdgcn_sched_barrier(0);
        }
        sum += __shfl_xor(sum, 32);
        const float inv = __builtin_amdgcn_rcpf(sum);
        {
            LAS unsigned char* ost = lds + 129024 + wave * 4096;
#pragma unroll
            for (int dt = 0; dt < 2; ++dt)
#pragma unroll
                for (int ig = 0; ig < 4; ++ig) { u32x2 wv; wv.x = pk2(o[dt][4 * ig] * inv, o[dt][4 * ig + 1] * inv); wv.y = pk2(o[dt][4 * ig + 2] * inv, o[dt][4 * ig + 3] * inv);
                    const int p8 = 8 * dt + 2 * ig + h; *(LAS u32x2*)(ost + l31 * 128 + 8 * (p8 ^ (l31 & 15))) = wv; }
            asm volatile("s_waitcnt lgkmcnt(0)" ::: "memory");
            bf16_t* obase = qrow - l31 * 64;
#pragma unroll
            for (int it = 0; it < 4; ++it) { const int r = 8 * it + (lane >> 3), c16 = lane & 7;
                u32x4 v = *(LAS const u32x4*)(ost + r * 128 + 16 * (c16 ^ ((r & 15) >> 1)));
                if (r & 1) { const unsigned t0 = v.x, t1 = v.y; v.x = v.z; v.y = v.w; v.z = t0; v.w = t1; }
                *(u32x4*)(obase + (size_t)r * 64 + c16 * 8) = v; asm volatile("" ::: "memory"); }
        }
        if (h == 0) LSE[tq * 24 + hd] = mb + __builtin_amdgcn_logf(sum);
        __syncthreads();
        u = un;
    }
}
__device__ __forceinline__ void merge_phase(const Args& a, int lane, int wave) {
    asm volatile("" : "+v"(lane));
    const bf16_t* Ob = (const bf16_t*)(a.ws + WS_Q); const bf16_t* Gb = (const bf16_t*)(a.ws + WS_G); const float* LSE = (const float*)(a.ws + WS_LSE); bf16_t* ym = (bf16_t*)(a.ws + WS_Z);
    const int gw = blockIdx.x * 8 + wave, NGW = gridDim.x * 8, slot = lane >> 3;
    for (int tok0 = gw; tok0 < MTOK; tok0 += 2 * NGW) {
        u32x4 o0[2], o1[2], o2[2], g[2]; float l0[2], l1[2], l2[2];
#pragma unroll
        for (int z = 0; z < 2; ++z) { int tok = tok0 + z * NGW; tok = tok < MTOK ? tok : tok0;
            l0[z] = LSE[(size_t)tok * 24 + slot]; l1[z] = LSE[(size_t)tok * 24 + 8 + slot]; l2[z] = LSE[(size_t)tok * 24 + 16 + slot];
            const int b = tok >> 13, t = tok & (SEQ - 1), part = lane & 7;
            o0[z] = __builtin_nontemporal_load((const u32x4*)(Ob + ((size_t)(b * 24 + slot) * SEQ + t) * 64 + part * 8));
            o1[z] = __builtin_nontemporal_load((const u32x4*)(Ob + ((size_t)(b * 24 + 8 + slot) * SEQ + (t & 3) * 2048 + (t >> 2)) * 64 + part * 8));
            o2[z] = __builtin_nontemporal_load((const u32x4*)(Ob + ((size_t)(b * 24 + 16 + slot) * SEQ + (t & 15) * 512 + (t >> 4)) * 64 + part * 8));
            g[z] = __builtin_nontemporal_load((const u32x4*)(Gb + (size_t)tok * 1024 + 512 + lane * 8)); }
#pragma unroll
        for (int z = 0; z < 2; ++z) { const int tok = tok0 + z * NGW; if (tok >= MTOK) break;
            const float mx = fmaxf(l0[z], fmaxf(l1[z], l2[z]));
            float w0 = __builtin_amdgcn_exp2f(l0[z] - mx), w1 = __builtin_amdgcn_exp2f(l1[z] - mx), w2 = __builtin_amdgcn_exp2f(l2[z] - mx);
            const float inv = 1.0f / (w0 + w1 + w2); w0 *= inv; w1 *= inv; w2 *= inv;
            u32x4 w;
#pragma unroll
            for (int e = 0; e < 4; ++e) { const float lo = (bflo(o0[z][e]) * w0 + bflo(o1[z][e]) * w1 + bflo(o2[z][e]) * w2) * bflo(g[z][e]); const float hi = (bfhi(o0[z][e]) * w0 + bfhi(o1[z][e]) * w1 + bfhi(o2[z][e]) * w2) * bfhi(g[z][e]); w[e] = pk2(lo, hi); }
            *(u32x4*)(ym + (size_t)tok * 1024 + 512 + lane * 8) = w; }
    }
}

#define XB_TMO      128
#define XB_XCNT(j)  (256  + 64 * (j))
#define XB_XSUB(j)  (1280 + 64 * (j))
#define XB_XGEN(j)  (2304 + 64 * (j))
#define XB_TOP      3328
#define XB_TOPGEN   3392
#define XCD_BAR_WORDS 3456
#define XB_SPIN_CAP (1u << 18)

__device__ __forceinline__ unsigned xb_ld(unsigned* p)              { return __hip_atomic_load(p, __ATOMIC_RELAXED, __HIP_MEMORY_SCOPE_AGENT); }
__device__ __forceinline__ unsigned xb_add(unsigned* p, unsigned v) { return __hip_atomic_fetch_add(p, v, __ATOMIC_RELAXED, __HIP_MEMORY_SCOPE_AGENT); }
__device__ __forceinline__ unsigned xb_xcc_id() { return (unsigned)__builtin_amdgcn_s_getreg((3 << 11) | 20) & 0xFu; }
#define XB_SPIN(cond, bar) do { unsigned _sp = 0; while (cond) { __builtin_amdgcn_s_sleep(1); \
    if ((++_sp & 255u) == 0u) { if (xb_ld(&(bar)[XB_TMO])) break; if (_sp > XB_SPIN_CAP) { atomicAdd(&(bar)[XB_TMO], 1u); break; } } } } while (0)

struct XcdBarrier {
    unsigned* bar; unsigned x;
    volatile LAS unsigned* st;
};

__device__ __forceinline__ XcdBarrier xcd_barrier_post(unsigned* bar, volatile LAS unsigned* st) {
    XcdBarrier b; b.bar = bar; b.x = xb_xcc_id(); b.st = st;
    if (threadIdx.x == 0) (void)xb_add(&bar[XB_XCNT(b.x)], 1u);
    return b;
}
__device__ __forceinline__ void xcd_barrier_complete(unsigned* bar, unsigned x, unsigned& nloc, unsigned& nx) {
    const unsigned G = gridDim.x * gridDim.y * gridDim.z;
    unsigned sum, cnt, mine, sp = 0u;
    for (;;) {
        sum = 0u; cnt = 0u; mine = 0u;
#pragma unroll
        for (unsigned j = 0; j < 16; ++j) { const unsigned c = xb_ld(&bar[XB_XCNT(j)]); sum += c; cnt += (c > 0u) ? 1u : 0u; mine = (j == x) ? c : mine; }
        if (sum == G) break;
        __builtin_amdgcn_s_sleep(1);
        if ((++sp & 255u) == 0u) { if (xb_ld(&bar[XB_TMO])) break; if (sp > XB_SPIN_CAP) { atomicAdd(&bar[XB_TMO], 1u); break; } }
    }
    nloc = mine > 0u ? mine : 1u; nx = cnt > 0u ? cnt : 1u;
}

__device__ __forceinline__ void xcd_barrier(const XcdBarrier& b) {
    asm volatile("s_waitcnt vmcnt(0)" ::: "memory");
    __syncthreads();
    if (threadIdx.x == 0) {
        unsigned* bar = b.bar;
        __builtin_amdgcn_s_waitcnt(0);
        unsigned nloc = b.st[0], nx = b.st[1];
        if (nloc == 0u) { xcd_barrier_complete(bar, b.x, nloc, nx); b.st[0] = nloc; b.st[1] = nx; }
        const unsigned old = xb_add(&bar[XB_XSUB(b.x)], 1u);
        const unsigned gen = old / nloc;
        if (old + 1u == (gen + 1u) * nloc) {
            __builtin_amdgcn_fence(__ATOMIC_RELEASE, "agent");
            asm volatile("s_waitcnt vmcnt(0)" ::: "memory");
            const unsigned og = xb_add(&bar[XB_TOP], 1u);
            const unsigned tg = og / nx;
            if (og + 1u == (tg + 1u) * nx) xb_add(&bar[XB_TOPGEN], 1u);
            else XB_SPIN(xb_ld(&bar[XB_TOPGEN]) == tg, bar);
            __builtin_amdgcn_fence(__ATOMIC_ACQUIRE, "agent");
            xb_add(&bar[XB_XGEN(b.x)], 1u);
            asm volatile("s_waitcnt vmcnt(0)" ::: "memory");
        } else {
            XB_SPIN(xb_ld(&bar[XB_XGEN(b.x)]) == gen, bar);
            __builtin_amdgcn_fence(__ATOMIC_ACQUIRE, "agent");
            asm volatile("s_waitcnt vmcnt(0)" ::: "memory");
        }
    }
    __syncthreads();
}

__global__ void __launch_bounds__(512, 2) mega_fwd(Args a) {
    extern __shared__ __attribute__((aligned(16))) unsigned char lds_raw[];
    LAS unsigned char* lds = (LAS unsigned char*)lds_raw;
    cg::grid_group grid = cg::this_grid();
    const int tid = threadIdx.x, lane = tid & 63, wave = __builtin_amdgcn_readfirstlane(tid >> 6);
    volatile LAS unsigned* bst = (volatile LAS unsigned*)(lds + 161792);
    if (tid < 2) bst[tid] = 0u;
    __syncthreads();
    XcdBarrier bar = xcd_barrier_post((unsigned*)(a.ws + WS_BAR), bst);
    if (a.ws == nullptr) grid.sync();
#ifndef REP0
#define REP0 1
#define REP1 1
#define REPD1 1
#define REPD2 1
#define REPM 1
#define REP4 1
#endif
    for (int rep = 0; rep < REP0; ++rep) phase0(a, lds, tid, lane, wave);
    xcd_barrier(bar);
    {
        pg8::Gemm g{(const pg8::bf16_t*)(a.ws + WS_XB), (const pg8::bf16_t*)(a.ws + WS_WT), MTOK, NIN, DM}; pg8::StaticOrder S; S.init(MTOK, NIN, gridDim.x, (int)blockIdx.x, REP1);
        Epi1 E{(bf16_t*)(a.ws + WS_Z), (bf16_t*)(a.ws + WS_G), (bf16_t*)(a.ws + WS_Q), (bf16_t*)(a.ws + WS_K), (bf16_t*)(a.ws + WS_V)};
        pg8::gemm_phase<Epi1, pg8::StaticOrder, true, true>(lds, g, S, E);
    }
    xcd_barrier(bar);
    attn_phase(a, lds, tid, lane, wave);
    for (int rep = 0; rep < REPD1; ++rep) dft1_phase(a, lds, tid, lane, wave);
    xcd_barrier(bar);
    for (int rep = 0; rep < REPM; ++rep) merge_phase(a, lane, wave);
    for (int rep = 0; rep < REPD2; ++rep) dft2_phase(a, lds, tid, lane, wave);
    xcd_barrier(bar);
    {
        pg8::Gemm g{(const pg8::bf16_t*)(a.ws + WS_Z), (const pg8::bf16_t*)(a.ws + WS_WOT), MTOK, DM, DM}; pg8::StaticOrder S; S.init(MTOK, DM, gridDim.x, (int)blockIdx.x, REP4);
        Epi2 E{a.x, a.out};
        pg8::gemm_phase<Epi2, pg8::StaticOrder, true, true>(lds, g, S, E);
    }
}

extern "C" void kernel_launch(void* const* d_in, const int* in_sizes, int n_in, void* d_out, int out_size, void* d_ws, size_t ws_size, hipStream_t stream) {
    static int grid = 0;
    if (grid == 0) {
        if (n_in != 7 || in_sizes[0] != MTOK * DM || out_size != MTOK * DM || ws_size < WS_END) { fprintf(stderr, "kernel_launch: unexpected shapes / workspace (%d inputs, ws %zu)\n", n_in, ws_size); grid = -1; return; }
        int dev = 0, cus = 0, per_cu = 0;
        hipGetDevice(&dev); hipDeviceGetAttribute(&cus, hipDeviceAttributeMultiprocessorCount, dev);
        hipFuncSetAttribute((const void*)mega_fwd, hipFuncAttributeMaxDynamicSharedMemorySize, LDS_BYTES);
        hipOccupancyMaxActiveBlocksPerMultiprocessor(&per_cu, (const void*)mega_fwd, 512, LDS_BYTES);
        if (per_cu < 1) { fprintf(stderr, "kernel_launch: occupancy query says %d blocks per CU\n", per_cu); per_cu = 1; }
        grid = cus;
        (void)hipGetLastError();
    }
    if (grid < 0) return;
    Args a{};
    a.x = (const float*)d_in[0]; a.norm_w = (const float*)d_in[1]; a.w_in = (const float*)d_in[2]; a.qw = (const float*)d_in[3]; a.kw = (const float*)d_in[4];
    a.wf = (const float*)d_in[5]; a.w_out = (const float*)d_in[6]; a.out = (float*)d_out; a.ws = (unsigned char*)d_ws;
    if (hipMemsetAsync((char*)d_ws + WS_BAR, 0, 16384, stream) != hipSuccess) { fprintf(stderr, "kernel_launch: memset of the barrier words failed\n"); return; }
    void* args[] = {&a};
    hipError_t e = hipLaunchCooperativeKernel((const void*)mega_fwd, dim3(grid), dim3(512), args, LDS_BYTES, stream);
    if (e != hipSuccess) fprintf(stderr, "cooperative launch failed: %s (grid %d)\n", hipGetErrorString(e), grid);
}
```

```cpp
#include <hip/hip_runtime.h>
#include <hip/hip_cooperative_groups.h>
#include <cstdio>
#include <cstdint>
namespace cg = cooperative_groups;
namespace pg8 {
#define PG8_LAS __attribute__((address_space(3)))
typedef unsigned short bf16_t;
typedef short bf16x8 __attribute__((ext_vector_type(8)));
typedef float f32x4 __attribute__((ext_vector_type(4)));
typedef unsigned u32x4 __attribute__((ext_vector_type(4)));
constexpr int BM = 256, BK = 64, HALF = 128, HTB = HALF * BK * 2  , STAGE_BYTES = 8 * HTB, NXCD = 8, WGM = 8;

__host__ __device__ __forceinline__ int lds_byte(int r, int c) { const int st = (r >> 4) * 2 + (c >> 5), rr = r & 15, cc = c & 31, ob = rr * 64 + cc * 2; return st * 1024 + (ob ^ (((ob >> 9) & 1) << 5)); }
__host__ __device__ __forceinline__ void stage_rc(int b, int& R, int& C) { const int st = b / 1024, sb = b % 1024, swz = sb ^ (((sb >> 9) & 1) << 5); R = (st >> 1) * 16 + swz / 64; C = (st & 1) * 32 + (swz % 64) / 2; }
__host__ __device__ __forceinline__ int perm32(int rho) { const int n = rho >> 4, i = rho & 15; return 8 * (i >> 2) + 4 * n + (i & 3); }

struct Unit { int pm, pn; };
struct Gemm { const bf16_t* A; const bf16_t* Bt; int M, N, K; };

struct StaticOrder {
    int nM, nN, nwg, G, c, rep;
    __host__ __device__ void init(int M, int N, int G_, int c_, int rep_ = 1) { nM = M / BM; nN = N / BM; nwg = nM * nN; G = G_; c = c_; rep = rep_; }
    __host__ __device__ bool next(int i, Unit& u) const {
        const int per = (nwg + G - 1) / G; if (i >= per * rep) return false; const long L = (long)(i % per) * G + c; if (L >= nwg) return false;
        int wgid = (int)L; { const int q = nwg / NXCD, r = nwg % NXCD, xcd = wgid % NXCD, off = wgid / NXCD; wgid = (xcd < r ? xcd * (q + 1) : r * (q + 1) + (xcd - r) * q) + off; }
        const int nig = WGM * nN, gid = wgid / nig, fm = gid * WGM, gsz = (nM - fm) < WGM ? (nM - fm) : WGM;
        u.pm = fm + ((wgid % nig) % gsz); u.pn = (wgid % nig) / gsz; return true;
    }
    __device__ __forceinline__ void a_ready(const Unit&) const {}
    __device__ __forceinline__ void done(const Unit&) const {}
};

__device__ __forceinline__ unsigned cvt_pk_bf16(float lo, float hi) { unsigned r; asm volatile("v_cvt_pk_bf16_f32 %0, %1, %2" : "=v"(r) : "v"(lo), "v"(hi)); return r; }
typedef float f32x2 __attribute__((ext_vector_type(2)));
template <class Epi, class Sched, bool ALIGN_EPI = false, bool SP2 = false>
__device__ __forceinline__ void gemm_phase(PG8_LAS unsigned char* lds, const Gemm g, const Sched& S, const Epi& E) {
    const int tid = threadIdx.x, wid = __builtin_amdgcn_readfirstlane(tid >> 6), lane = tid & 63, wr = wid >> 2, wc = wid & 3, fr = lane & 15, fq = lane >> 4;
    const int K = g.K, nt = K / BK;
    unsigned voffA[2], voffB[2];
#pragma unroll
    for (int i = 0; i < 2; ++i) { int R, C; stage_rc(tid * 16 + i * 8192, R, C); const int Rb = Epi::PERM2 ? (64 * (R >> 5) + perm32(R & 31)) : (Epi::PERM ? ((R & ~31) + perm32(R & 31)) : R);
        voffA[i] = (unsigned)(R * K + C) * 2u; voffB[i] = (unsigned)(Rb * K + C) * 2u; }
    const size_t kstep = (size_t)(BK * 2);
    const size_t hstep = (size_t)HALF * K * 2;
    const size_t hstepB = Epi::PERM2 ? (size_t)32 * K * 2 : hstep;
    const size_t tstep = 2 * hstep;
    const unsigned ldsw = (unsigned)wid * 1024u;
    const int aoff = lds_byte(wr * 64 + fr, fq * 8), boff = lds_byte(wc * 32 + fr, fq * 8);
#define PG8_SA(b, h) (((b) * 2 + (h)) * HTB)
#define PG8_SB(b, h) ((4 + (b) * 2 + (h)) * HTB)
#define PG8_STAGE(bufoff, gbase, voff) do { _Pragma("unroll") for (int _i = 0; _i < 2; ++_i) \
        __builtin_amdgcn_global_load_lds((const unsigned*)((const char*)(gbase) + (voff)[_i]), (PG8_LAS unsigned*)(lds + (bufoff) + ldsw + _i * 8192), 16, 0, 0); } while (0)
#define PG8_LDA(dst, b, h) do { _Pragma("unroll") for (int m = 0; m < 4; ++m) _Pragma("unroll") for (int k = 0; k < 2; ++k) dst[m][k] = *(const PG8_LAS bf16x8*)(lds + PG8_SA(b, h) + aoff + m * 2048 + k * 1024); } while (0)
#define PG8_LDB(dst, b, h) do { _Pragma("unroll") for (int n = 0; n < 2; ++n) _Pragma("unroll") for (int k = 0; k < 2; ++k) dst[n][k] = *(const PG8_LAS bf16x8*)(lds + PG8_SB(b, h) + boff + n * 2048 + k * 1024); } while (0)
#define PG8_MMA(ai, bj, At, Bt) do { __builtin_amdgcn_s_setprio(1); _Pragma("unroll") for (int m = 0; m < 4; ++m) _Pragma("unroll") for (int n = 0; n < 2; ++n) _Pragma("unroll") for (int k = 0; k < 2; ++k) \
        acc[ai][bj][m][n] = __builtin_amdgcn_mfma_f32_16x16x32_bf16(Bt[n][k], At[m][k], acc[ai][bj][m][n], 0, 0, 0); __builtin_amdgcn_s_setprio(0); } while (0)
#define PG8_WAIT_V(n) asm volatile("s_waitcnt vmcnt(" #n ")" ::: "memory")
#define PG8_WAIT_L(n) asm volatile("s_waitcnt lgkmcnt(" #n ")" ::: "memory")
#define PG8_BAR __builtin_amdgcn_s_barrier()
#define PG8_SCHED __builtin_amdgcn_sched_barrier(0)
    Unit cur, nxt; int ui = 0;
    if (!S.next(0, cur)) return;
    f32x4 acc[2][2][4][2];
#pragma unroll
    for (int a = 0; a < 2; ++a)
#pragma unroll
        for (int b = 0; b < 2; ++b)
#pragma unroll
            for (int m = 0; m < 4; ++m)
#pragma unroll
                for (int n = 0; n < 2; ++n) acc[a][b][m][n] = (f32x4){0.f, 0.f, 0.f, 0.f};
    bf16x8 At[4][2], B0[2][2], B1[2][2];
    const char* cA = (const char*)g.A + (size_t)cur.pm * tstep; const char* cB = (const char*)g.Bt + (size_t)cur.pn * tstep;
    S.a_ready(cur);
    if constexpr (SP2) {
        PG8_STAGE(PG8_SB(0, 0), cB, voffB); PG8_STAGE(PG8_SB(0, 1), cB + hstepB, voffB); PG8_STAGE(PG8_SA(0, 0), cA, voffA); PG8_STAGE(PG8_SA(0, 1), cA + hstep, voffA);
        if (wr == 1) PG8_BAR;
        PG8_WAIT_V(2); PG8_BAR;
        PG8_STAGE(PG8_SB(1, 0), cB + kstep, voffB); PG8_STAGE(PG8_SA(1, 0), cA + kstep, voffA); PG8_STAGE(PG8_SB(1, 1), cB + hstepB + kstep, voffB);
        PG8_WAIT_V(6); PG8_BAR;
    } else {
        PG8_STAGE(PG8_SB(0, 0), cB, voffB); PG8_STAGE(PG8_SA(0, 0), cA, voffA); PG8_STAGE(PG8_SB(0, 1), cB + hstepB, voffB); PG8_STAGE(PG8_SA(0, 1), cA + hstep, voffA);
        if (wr == 1) PG8_BAR;
        PG8_WAIT_V(4); PG8_BAR;
        PG8_STAGE(PG8_SB(1, 0), cB + kstep, voffB); PG8_STAGE(PG8_SA(1, 0), cA + kstep, voffA); PG8_STAGE(PG8_SB(1, 1), cB + hstepB + kstep, voffB);
        PG8_WAIT_V(6); PG8_BAR;
    }
    for (;;) {
        const bool has_next = S.next(ui + 1, nxt);
        const char* nA = has_next ? (const char*)g.A + (size_t)nxt.pm * tstep : cA; const char* nB = has_next ? (const char*)g.Bt + (size_t)nxt.pn * tstep : cB;
        for (int t = 0; t < nt; t += 2) {
            const bool last = (t == nt - 2);
            const char* a1 = cA + (size_t)(t + 1) * kstep;
            const char* a2 = last ? nA : cA + (size_t)(t + 2) * kstep; const char* b2 = last ? nB : cB + (size_t)(t + 2) * kstep;
            const char* a3 = a2 + kstep; const char* b3 = b2 + kstep;
            if (last && has_next) S.a_ready(nxt);
            if constexpr (SP2) {
            PG8_LDB(B0, 0, 0); PG8_LDB(B1, 0, 1); PG8_SCHED; PG8_LDA(At, 0, 0); PG8_STAGE(PG8_SA(1, 1), a1 + hstep, voffA);
            PG8_WAIT_V(8); PG8_WAIT_L(0); PG8_BAR; PG8_MMA(0, 0, At, B0); PG8_MMA(0, 1, At, B1); PG8_BAR; PG8_SCHED;
            PG8_LDA(At, 0, 1); PG8_STAGE(PG8_SB(0, 0), b2, voffB); PG8_STAGE(PG8_SB(0, 1), b2 + hstepB, voffB); PG8_STAGE(PG8_SA(0, 0), a2, voffA);
            PG8_WAIT_V(8); PG8_WAIT_L(0); PG8_BAR; PG8_MMA(1, 0, At, B0); PG8_MMA(1, 1, At, B1); PG8_BAR; PG8_SCHED;
            PG8_LDB(B0, 1, 0); PG8_LDB(B1, 1, 1); PG8_SCHED; PG8_LDA(At, 1, 0); PG8_STAGE(PG8_SA(0, 1), a2 + hstep, voffA);
            PG8_WAIT_V(8); PG8_WAIT_L(0); PG8_BAR; PG8_MMA(0, 0, At, B0); PG8_MMA(0, 1, At, B1); PG8_BAR; PG8_SCHED;
            PG8_LDA(At, 1, 1); PG8_STAGE(PG8_SB(1, 0), b3, voffB); PG8_STAGE(PG8_SB(1, 1), b3 + hstepB, voffB); PG8_STAGE(PG8_SA(1, 0), a3, voffA);
            PG8_WAIT_V(8); PG8_WAIT_L(0); PG8_BAR; PG8_MMA(1, 0, At, B0); PG8_MMA(1, 1, At, B1); PG8_BAR; PG8_SCHED;
            } else {
            PG8_LDB(B0, 0, 0); PG8_SCHED; PG8_LDA(At, 0, 0); PG8_STAGE(PG8_SA(1, 1), a1 + hstep, voffA);
            PG8_WAIT_L(8); PG8_BAR; PG8_WAIT_L(0); PG8_MMA(0, 0, At, B0); PG8_BAR; PG8_SCHED;
            PG8_LDB(B1, 0, 1); PG8_STAGE(PG8_SB(0, 0), b2, voffB);
            PG8_BAR; PG8_WAIT_L(0); PG8_MMA(0, 1, At, B1); PG8_BAR;
            PG8_LDA(At, 0, 1); PG8_STAGE(PG8_SA(0, 0), a2, voffA);
            PG8_BAR; PG8_WAIT_L(0); PG8_MMA(1, 0, At, B0); PG8_BAR; PG8_SCHED;
            PG8_STAGE(PG8_SB(0, 1), b2 + hstepB, voffB);
            PG8_WAIT_V(6); PG8_BAR; PG8_MMA(1, 1, At, B1); PG8_BAR;
            PG8_LDB(B0, 1, 0); PG8_SCHED; PG8_LDA(At, 1, 0); PG8_STAGE(PG8_SA(0, 1), a2 + hstep, voffA);
            PG8_WAIT_L(8); PG8_BAR; PG8_WAIT_L(0); PG8_MMA(0, 0, At, B0); PG8_BAR; PG8_SCHED;
            PG8_LDB(B1, 1, 1); PG8_STAGE(PG8_SB(1, 0), b3, voffB);
            PG8_BAR; PG8_WAIT_L(0); PG8_MMA(0, 1, At, B1); PG8_BAR;
            PG8_LDA(At, 1, 1); PG8_STAGE(PG8_SA(1, 0), a3, voffA);
            PG8_BAR; PG8_WAIT_L(0); PG8_MMA(1, 0, At, B0); PG8_BAR; PG8_SCHED;
            PG8_STAGE(PG8_SB(1, 1), b3 + hstepB, voffB);
            PG8_WAIT_V(6); PG8_BAR; PG8_MMA(1, 1, At, B1); PG8_BAR;
            }
        }
        if constexpr (ALIGN_EPI) { if (wr == 0) PG8_BAR; }
        if constexpr (!Epi::AFTER_DRAIN) { E(acc, cur, wr, wc, fr, fq); S.done(cur); }
        if (!has_next) break;
#pragma unroll
        for (int a = 0; a < 2; ++a)
#pragma unroll
            for (int b = 0; b < 2; ++b)
#pragma unroll
                for (int m = 0; m < 4; ++m)
#pragma unroll
                    for (int n = 0; n < 2; ++n) acc[a][b][m][n] = (f32x4){0.f, 0.f, 0.f, 0.f};
        cur = nxt; cA = nA; cB = nB; ++ui;
        if constexpr (ALIGN_EPI) { if (wr == 1) PG8_BAR; }
    }
    PG8_WAIT_V(0);
    if constexpr (!ALIGN_EPI) { if (wr == 0) PG8_BAR; }
    PG8_BAR;
    if constexpr (Epi::AFTER_DRAIN) { E.fused(acc, cur, wr, wc, fr, fq, lds, wid, lane); S.done(cur); }
#undef PG8_SA
#undef PG8_SB
#undef PG8_STAGE
#undef PG8_LDA
#undef PG8_LDB
#undef PG8_MMA
#undef PG8_WAIT_V
#undef PG8_WAIT_L
#undef PG8_BAR
#undef PG8_SCHED
}
}
#define LAS __attribute__((address_space(3)))
typedef unsigned short bf16_t;
typedef short bf16x8 __attribute__((ext_vector_type(8)));
typedef short s16x4 __attribute__((ext_vector_type(4)));
typedef short v4i16_t __attribute__((ext_vector_type(4)));
typedef float f32x4 __attribute__((ext_vector_type(4)));
typedef float f32x16 __attribute__((ext_vector_type(16)));
typedef unsigned u32x4 __attribute__((ext_vector_type(4)));
typedef unsigned u32x2 __attribute__((ext_vector_type(2)));

constexpr int SEQ = 8192, DM = 1024, MTOK = 65536, NIN = 6144, QKVW = 1536;
constexpr size_t WS_WT = 0, WS_WOT = 13631488, WS_RS = 15728640, WS_LSE = 15990784, WS_BAR = 23068672, WS_GMT = 24117248, WS_XB = 33554432, WS_Z = 167772160, WS_G = 301989888,
                 WS_Q = 436207616, WS_K = 637534208, WS_V = 838860800, WS_END = 1040187392;
constexpr int LDS_BYTES = 161856;
constexpr float LOG2E = 1.4426950408889634f;

__device__ __forceinline__ unsigned f2bf(float f) { unsigned u = __builtin_bit_cast(unsigned, f); return (u + 0x7fffu + ((u >> 16) & 1u)) >> 16; }
typedef float f32x2_t __attribute__((ext_vector_type(2))); typedef __bf16 bf16x2_t __attribute__((ext_vector_type(2)));
__device__ __forceinline__ unsigned pk2(float lo, float hi) { f32x2_t v = {lo, hi}; bf16x2_t b = __builtin_convertvector(v, bf16x2_t); return __builtin_bit_cast(unsigned, b); }
__device__ __forceinline__ float bflo(unsigned w) { return __builtin_bit_cast(float, w << 16); }
__device__ __forceinline__ float bfhi(unsigned w) { return __builtin_bit_cast(float, w & 0xffff0000u); }
__device__ __forceinline__ int crow(int r, int hi) { return (r & 3) + 8 * (r >> 2) + 4 * hi; }
__device__ __forceinline__ float wave_sum(float v) {
#pragma unroll
    for (int o = 1; o < 64; o <<= 1) v += __shfl_xor(v, o);
    return v;
}
__device__ __forceinline__ s16x4 trrd(LAS const unsigned char* p) { return __builtin_bit_cast(s16x4, __builtin_amdgcn_ds_read_tr16_b64_v4i16((LAS v4i16_t*)p)); }
__device__ __forceinline__ float silu_f(float v) { return v * __builtin_amdgcn_rcpf(1.f + __builtin_amdgcn_exp2f(-v * LOG2E)); }
#define LDS_WAIT() asm volatile("s_waitcnt lgkmcnt(0)" ::: "memory")
template <int CTRL> __device__ __forceinline__ unsigned dpp_mov(unsigned v) { return (unsigned)__builtin_amdgcn_update_dpp(0, (int)v, CTRL, 0xF, 0xF, true); }
template <int CTRL> __device__ __forceinline__ float dpp_movf(float v) { return __builtin_bit_cast(float, dpp_mov<CTRL>(__builtin_bit_cast(unsigned, v))); }

struct Args { const float *x, *norm_w, *w_in, *qw, *kw, *wf, *w_out; float* out; unsigned char* ws; };

__device__ __forceinline__ void transpose_item(const float* W, int ldw, int ncol0, bf16_t* WT, int row_off, const float* kscale, LAS float* scr, int kb, int nb, int lane) {
    const int k0 = 64 * kb, n0 = 32 * nb;
#pragma unroll 8
    for (int i = 0; i < 32; ++i) { const int kk = 2 * i + (lane >> 5); float v = W[(size_t)(k0 + kk) * ldw + ncol0 + n0 + (lane & 31)]; if (kscale) v *= kscale[k0 + kk]; scr[kk * 33 + (lane & 31)] = v; }
    LDS_WAIT();
    const int c = lane & 7;
#pragma unroll
    for (int j = 0; j < 4; ++j) { const int n = (lane >> 3) + 8 * j; const LAS float* s = scr + (8 * c) * 33 + n;
        u32x4 o; o.x = pk2(s[0 * 33], s[1 * 33]); o.y = pk2(s[2 * 33], s[3 * 33]); o.z = pk2(s[4 * 33], s[5 * 33]); o.w = pk2(s[6 * 33], s[7 * 33]);
        *(u32x4*)(WT + (size_t)(row_off + n0 + n) * 1024 + k0 + 8 * c) = o; }
    LDS_WAIT();
}
__device__ __forceinline__ void gmt_unit(const Args& a, LAS unsigned char* lds, int unit, int tid) {
    bf16_t* GmT = (bf16_t*)(a.ws + WS_GMT);
    LAS float* tab = (LAS float*)lds;
    if (tid < 64) { float sn, cs; sincospif((float)tid * (1.f / 32.f), &sn, &cs); tab[2 * tid] = cs; tab[2 * tid + 1] = sn; }
    __syncthreads();
    const int g = unit >> 2, d = 16 * (unit & 3) + (tid >> 5), c32 = tid & 31;
    float acc[4] = {0.f, 0.f, 0.f, 0.f};
    for (int l = 0; l < 64; ++l) { const float w = a.wf[(size_t)(g * 64 + l) * 64 + d];
#pragma unroll
        for (int e = 0; e < 4; ++e) { const int cc = c32 * 4 + e, c = cc & 63, idx = (l * c) & 63; acc[e] += w * (cc < 64 ? tab[2 * idx] : -tab[2 * idx + 1]); } }
#pragma unroll
    for (int e = 0; e < 4; ++e) GmT[(size_t)(g * 64 + d) * 128 + c32 * 4 + e] = (bf16_t)f2bf(acc[e] * 0.125f);
    __syncthreads();
}
__device__ __forceinline__ void phase0(const Args& a, LAS unsigned char* lds, int tid, int lane, int wave) {
    bf16_t* Wt = (bf16_t*)(a.ws + WS_WT); bf16_t* WoT = (bf16_t*)(a.ws + WS_WOT); bf16_t* xb = (bf16_t*)(a.ws + WS_XB);
    const int G = gridDim.x, bx = blockIdx.x;
    for (int u = bx; u < 32; u += G) gmt_unit(a, lds, u, tid);
    if (bx == G - 1 && wave < 3) {
        for (int hd = wave * 8; hd < wave * 8 + 8; ++hd) {
            float gqm = fabsf(a.qw[hd * 64 + lane]), gkm = fabsf(a.kw[hd * 64 + lane]);
#pragma unroll
            for (int o = 1; o < 64; o <<= 1) { gqm = fmaxf(gqm, __shfl_xor(gqm, o)); gkm = fmaxf(gkm, __shfl_xor(gkm, o)); }
            if (lane == 0) ((float*)(a.ws + WS_RS))[hd] = 8.08f * LOG2E * gqm * gkm;
        }
    }
    LAS float* scr = (LAS float*)(lds + 32768 + wave * 8448);
    const int gw = bx * 8 + wave, NGW = G * 8;
    constexpr int I_IN = 16 * 192, I_OUT = 16 * 32;
    for (int it = gw; it < I_IN + I_OUT; it += NGW) {
        if (it < I_IN) transpose_item(a.w_in, 6144, 0, Wt, 0, a.norm_w, scr, it / 192, it % 192, lane);
        else { const int r = it - I_IN; transpose_item(a.w_out, 1024, 0, WoT, 0, nullptr, scr, r / 32, r % 32, lane); }
    }
    for (int row = gw; row < MTOK; row += 2 * NGW) {
        const int row2 = row + NGW; const bool has2 = row2 < MTOK;
        const f32x4* xr = (const f32x4*)(a.x + (size_t)row * DM) + lane; const f32x4* xr2 = (const f32x4*)(a.x + (size_t)(has2 ? row2 : row) * DM) + lane;
        f32x4 v[4], v2[4]; float s = 0.f, s2 = 0.f;
#pragma unroll
        for (int j = 0; j < 4; ++j) { v[j] = __builtin_nontemporal_load(xr + 64 * j); v2[j] = __builtin_nontemporal_load(xr2 + 64 * j); }
#pragma unroll
        for (int j = 0; j < 4; ++j) { s += (v[j].x * v[j].x + v[j].y * v[j].y) + (v[j].z * v[j].z + v[j].w * v[j].w); s2 += (v2[j].x * v2[j].x + v2[j].y * v2[j].y) + (v2[j].z * v2[j].z + v2[j].w * v2[j].w); }
        s = wave_sum(s); s2 = wave_sum(s2);
        const float r = 1.0f / sqrtf(s * (1.f / DM) + 1e-6f), r2 = 1.0f / sqrtf(s2 * (1.f / DM) + 1e-6f);
        u32x2* o = (u32x2*)(xb + (size_t)row * DM) + lane;
#pragma unroll
        for (int j = 0; j < 4; ++j) { u32x2 w; w.x = pk2(v[j].x * r, v[j].y * r); w.y = pk2(v[j].z * r, v[j].w * r); o[64 * j] = w; }
        if (has2) { u32x2* o2 = (u32x2*)(xb + (size_t)row2 * DM) + lane;
#pragma unroll
            for (int j = 0; j < 4; ++j) { u32x2 w; w.x = pk2(v2[j].x * r2, v2[j].y * r2); w.y = pk2(v2[j].z * r2, v2[j].w * r2); o2[64 * j] = w; } }
    }
}

struct Epi1 {
    static constexpr bool PERM = true, PERM2 = true, AFTER_DRAIN = false;
    bf16_t *Z, *G, *Q, *Kb, *V;
    __device__ __forceinline__ void operator()(const pg8::f32x4 (&acc)[2][2][4][2], const pg8::Unit& u, int wr, int wc, int fr, int fq) const {
        const int pn = u.pn; const int hi8 = (fr >> 3) & 1, fr7 = fr & 7; const int rbase = u.pm * 256 + wr * 64 + fr7;
        const bool qkv = (pn >= 4 && pn < 22);
        const bool act = !qkv && pn >= 2;
        const int ld = pn < 2 ? 512 : 1024;
        bf16_t* base; int dsh = 0; size_t rowstride_tok = 0; int ecol;
        if (qkv) { const int which = (pn - 4) / 6, ct = (pn - 4) % 6; dsh = 2 * (ct >> 1);
            base = Q + (size_t)which * ((WS_K - WS_Q) / 2) + (size_t)(ct * 4 + wc) * SEQ * 64; ecol = 32 * hi8 + 8 * fq; }
        else { const int c0 = pn < 2 ? pn * 256 : (pn < 4 ? (pn - 2) * 256 : 512 + (pn - 22) * 256); base = (pn < 2 ? Z : G) + c0 + wc * 64; ecol = 32 * hi8 + 8 * fq; }
        const int dmask = (1 << dsh) - 1, Lc = SEQ >> dsh;
#pragma unroll
        for (int ai = 0; ai < 2; ++ai)
#pragma unroll
            for (int m = 0; m < 4; ++m) {
                pg8::f32x4 a0 = acc[ai][0][m][0], a1 = acc[ai][0][m][1], b0 = acc[ai][1][m][0], b1 = acc[ai][1][m][1];
                if (act) {
#pragma unroll
                    for (int e = 0; e < 4; ++e) { a0[e] = silu_f(a0[e]); a1[e] = silu_f(a1[e]); b0[e] = silu_f(b0[e]); b1[e] = silu_f(b1[e]); } }
                u32x4 A, B; A.x = pk2(a0[0], a0[1]); A.y = pk2(a0[2], a0[3]); A.z = pk2(a1[0], a1[1]); A.w = pk2(a1[2], a1[3]);
                B.x = pk2(b0[0], b0[1]); B.y = pk2(b0[2], b0[3]); B.z = pk2(b1[0], b1[1]); B.w = pk2(b1[2], b1[3]);
                u32x4 snd, rcv;
#pragma unroll
                for (int e = 0; e < 4; ++e) { snd[e] = hi8 ? A[e] : B[e]; rcv[e] = dpp_mov<0x128>(snd[e]); }
                u32x4 d1, d2;
#pragma unroll
                for (int e = 0; e < 4; ++e) { d1[e] = hi8 ? rcv[e] : A[e]; d2[e] = hi8 ? B[e] : rcv[e]; }
                const int row1 = rbase + ai * 128 + m * 16, row2 = row1 + 8;
                if (qkv) {
                    const int bb = row1 >> 13, t1 = row1 & (SEQ - 1), t2 = row2 & (SEQ - 1);
                    const int p1 = (t1 & dmask) * Lc + (t1 >> dsh), p2 = (t2 & dmask) * Lc + (t2 >> dsh);
                    bf16_t* hb = base + (size_t)bb * 24 * SEQ * 64 + ecol;
                    *(u32x4*)(hb + (size_t)p1 * 64) = d1; *(u32x4*)(hb + (size_t)p2 * 64) = d2;
                } else {
                    *(u32x4*)(base + (size_t)row1 * ld + ecol) = d1; *(u32x4*)(base + (size_t)row2 * ld + ecol) = d2;
                }
            }
    }
};
struct Epi2 {
    static constexpr bool PERM = false, PERM2 = false, AFTER_DRAIN = false;
    const float* x; float* out;
    __device__ __forceinline__ void operator()(const pg8::f32x4 (&acc)[2][2][4][2], const pg8::Unit& u, int wr, int wc, int fr, int fq) const {
        const int row0 = u.pm * 256 + wr * 64 + fr, col0 = u.pn * 256 + wc * 32 + 4 * fq;
#pragma unroll
        for (int ai = 0; ai < 2; ++ai)
#pragma unroll
            for (int m = 0; m < 4; ++m) { const size_t off = (size_t)(row0 + ai * 128 + m * 16) * DM + col0;
#pragma unroll
                for (int bj = 0; bj < 2; ++bj)
#pragma unroll
                    for (int n = 0; n < 2; ++n) { const size_t o2 = off + bj * 128 + n * 16; *(pg8::f32x4*)(out + o2) = *(const pg8::f32x4*)(x + o2) + acc[ai][bj][m][n]; }
                if (m & 1) asm volatile("" ::: "memory"); }
    }
};

constexpr int TP = 192;
constexpr int TTP = 272;
template <int NROWS> __device__ __forceinline__ void load_tile(LAS unsigned char* lds, const bf16_t* src, size_t rstride, int tid) {
    u32x4 v[NROWS / 64];
#pragma unroll
    for (int i = 0; i < NROWS / 64; ++i) { const int ci = tid + 512 * i, row = ci >> 3, ch = ci & 7; v[i] = *(const u32x4*)(src + (size_t)row * rstride + ch * 8); }
#pragma unroll
    for (int i = 0; i < NROWS / 64; ++i) { const int ci = tid + 512 * i, row = ci >> 3, ch = ci & 7; *(LAS u32x4*)(lds + row * TP + ch * 16) = v[i]; }
}
__device__ __forceinline__ void dft1_phase(const Args& a, LAS unsigned char* lds, int tid, int lane, int wave) {
    asm volatile("" : "+v"(tid), "+v"(lane));
    const bf16_t* Z = (const bf16_t*)(a.ws + WS_Z); bf16_t* Y = (bf16_t*)(a.ws + WS_XB);
    const int h = lane >> 5, l31 = lane & 31, kb = wave & 3, nt = wave >> 2;
    bf16x8 af[8];
    { const int ri_row = l31 >> 4, k1 = 16 * kb + (l31 & 15);
#pragma unroll
      for (int ks = 0; ks < 8; ++ks) { unsigned pw[4];
#pragma unroll
        for (int jj = 0; jj < 4; ++jj) { float vv[2];
#pragma unroll
            for (int e = 0; e < 2; ++e) { const int s1 = 16 * ks + 8 * h + 2 * jj + e; float sn, cs; sincospif((float)((s1 * k1) & 127) * (1.f / 64.f), &sn, &cs);
                float val = ri_row == 0 ? cs : sn;
                if (ri_row == 1 && k1 == 0) val = (s1 & 1) ? -1.f : 1.f;
                vv[e] = val * 0.08838834764831845f; }
            pw[jj] = pk2(vv[0], vv[1]); }
        u32x4 t; t.x = pw[0]; t.y = pw[1]; t.z = pw[2]; t.w = pw[3]; af[ks] = __builtin_bit_cast(bf16x8, t); } }
    const int q = (lane & 15) >> 2, p = lane & 3, blk = (lane >> 4) & 1;
    LAS const unsigned char* rb = lds + (8 * h + q) * TP + 32 * blk + 8 * p + nt * 64;
    u32x4 pf[2];
#define DFT1_ISSUE(uu) do { const int dc_ = (uu) & 7, s2_ = ((uu) >> 3) & 63, b_ = (uu) >> 9; const bf16_t* src_ = Z + ((size_t)b_ * SEQ + s2_) * 512 + dc_ * 64; \
        _Pragma("unroll") for (int i_ = 0; i_ < 2; ++i_) { const int ci_ = tid + 512 * i_; pf[i_] = *(const u32x4*)(src_ + (size_t)(ci_ >> 3) * (64 * 512) + (ci_ & 7) * 8); } } while (0)
    if ((int)blockIdx.x < 4096) DFT1_ISSUE((int)blockIdx.x);
    for (int u = blockIdx.x; u < 4096; u += gridDim.x) {
        const int dc = u & 7, s2 = (u >> 3) & 63, b = u >> 9;
#pragma unroll
        for (int i = 0; i < 2; ++i) { const int ci = tid + 512 * i; *(LAS u32x4*)(lds + (ci >> 3) * TP + (ci & 7) * 16) = pf[i]; }
        __syncthreads();
        if (u + (int)gridDim.x < 4096) DFT1_ISSUE(u + (int)gridDim.x);
        f32x16 acc = f32x16{};
#pragma unroll
        for (int ks = 0; ks < 8; ++ks) { const s16x4 lo = trrd(rb + ks * 16 * TP), hi = trrd(rb + ks * 16 * TP + 4 * TP);
            const bf16x8 bfr = __builtin_shufflevector(lo, hi, 0, 1, 2, 3, 4, 5, 6, 7);
            acc = __builtin_amdgcn_mfma_f32_32x32x16_bf16(af[ks], bfr, acc, 0, 0, 0); }
        LAS bf16_t* yt = (LAS bf16_t*)(lds + 49152);
#pragma unroll
        for (int i = 0; i < 8; ++i) { const int k1 = 16 * kb + crow(i, h); const float re = acc[i], im = acc[i + 8]; const int col = 32 * nt + l31;
            if (k1 != 0) { float sn, cs; sincospif((float)(s2 * k1) * (1.f / 4096.f), &sn, &cs);
                yt[(2 * k1) * 64 + col] = (bf16_t)f2bf(cs * re - sn * im); yt[(2 * k1 + 1) * 64 + col] = (bf16_t)f2bf(sn * re + cs * im); }
            else { float sn, cs; sincospif((float)s2 * (1.f / 64.f), &sn, &cs);
                yt[col] = (bf16_t)f2bf(re); yt[64 + col] = (bf16_t)0; yt[128 * 64 + col] = (bf16_t)f2bf(cs * im); yt[129 * 64 + col] = (bf16_t)f2bf(sn * im); } }
        __syncthreads();
#pragma unroll
        for (int z = 0; z < 3; ++z) { const int ci = tid + 512 * z; if (ci < 130 * 8) { const int row = ci >> 3, ch = ci & 7, k1 = row < 128 ? (row >> 1) : 64, ri = row < 128 ? (row & 1) : (row - 128);
            *(u32x4*)(Y + ((size_t)((b * 128 + k1) * 2 + ri) * 64 + s2) * 512 + dc * 64 + ch * 8) = *(LAS const u32x4*)(yt + row * 64 + ch * 8); } }
        __syncthreads();
    }
}
__device__ __forceinline__ void dft2_phase(const Args& a, LAS unsigned char* lds, int tid, int lane, int wave) {
    asm volatile("" : "+v"(tid), "+v"(lane));
    const bf16_t* Y = (const bf16_t*)(a.ws + WS_XB); const bf16_t* Gb = (const bf16_t*)(a.ws + WS_G); bf16_t* ym = (bf16_t*)(a.ws + WS_Z); const bf16_t* GmT = (const bf16_t*)(a.ws + WS_GMT);
    const int h = lane >> 5, l31 = lane & 31, ksub = wave >> 2, mh = (wave >> 1) & 1, nt = wave & 1;
    bf16x8 af[2][8];
#pragma unroll
    for (int z = 0; z < 2; ++z) { const int m = 64 * mh + 32 * z + l31, k2 = m & 63, imrow = m >> 6;
#pragma unroll
      for (int ks = 0; ks < 8; ++ks) { unsigned pw[4];
#pragma unroll
        for (int jj = 0; jj < 4; ++jj) { float vv[2];
#pragma unroll
            for (int e = 0; e < 2; ++e) { const int kk = 16 * ks + 8 * h + 2 * jj + e, ri = kk >> 6, s2 = kk & 63; float sn, cs; sincospif((float)((s2 * k2) & 63) * (1.f / 32.f), &sn, &cs);
                vv[e] = (imrow == 0 ? (ri == 0 ? cs : -sn) : (ri == 0 ? sn : cs)) * 0.125f; }
            pw[jj] = pk2(vv[0], vv[1]); }
        u32x4 t; t.x = pw[0]; t.y = pw[1]; t.z = pw[2]; t.w = pw[3]; af[z][ks] = __builtin_bit_cast(bf16x8, t); } }
    const int q = (lane & 15) >> 2, p = lane & 3, blk = (lane >> 4) & 1;
    LAS const unsigned char* rb = lds + (ksub * 128 + 8 * h + q) * TP + 32 * blk + 8 * p + nt * 64;
    LAS unsigned char* tt = lds + 49152;
    LAS float* ot = (LAS float*)(lds + 83968);
    const int mt2 = wave >> 1, nt2 = wave & 1;
    u32x4 ld[4];
#define DFT2_ISSUE(uu) do { const int dc_ = (uu) & 7, k1p_ = ((uu) >> 3) & 63, b_ = (uu) >> 9; \
        if (k1p_ == 0) { _Pragma("unroll") for (int z_ = 0; z_ < 2; ++z_) { const int ci_ = tid + 512 * z_; const size_t o_ = (size_t)(ci_ >> 3) * 512 + dc_ * 64 + (ci_ & 7) * 8; \
                ld[z_] = __builtin_nontemporal_load((const u32x4*)(Y + ((size_t)(b_ * 128) * 128) * 512 + o_)); ld[2 + z_] = __builtin_nontemporal_load((const u32x4*)(Y + ((size_t)(b_ * 128 + 64) * 128) * 512 + o_)); } } \
        else { const bf16_t* src_ = Y + ((size_t)(b_ * 128 + k1p_) * 128 + (tid >> 3)) * 512 + dc_ * 64 + (tid & 7) * 8; ld[0] = __builtin_nontemporal_load((const u32x4*)src_); ld[1] = __builtin_nontemporal_load((const u32x4*)(src_ + (size_t)64 * 512)); } } while (0)
    if ((int)blockIdx.x < 4096) DFT2_ISSUE((int)blockIdx.x);
    for (int u = blockIdx.x; u < 4096; u += gridDim.x) {
        const int dc = u & 7, k1p = (u >> 3) & 63, b = u >> 9;
        bf16x8 gf[8];
#pragma unroll
        for (int ks = 0; ks < 8; ++ks) gf[ks] = *(const bf16x8*)(GmT + (size_t)(dc * 64 + 32 * nt2 + l31) * 128 + 16 * ks + 8 * h);
        const int k1a = k1p, k1b = k1p == 0 ? 64 : 128 - k1p;
        const int tr_e = tid >> 2, qt_e = tid & 3; const size_t tok_e = (size_t)b * SEQ + ((tr_e >> 6) ? k1b : k1a) + 128 * (tr_e & 63);
        const u32x4 g0 = __builtin_nontemporal_load((const u32x4*)(Gb + tok_e * 1024 + dc * 64 + qt_e * 16)), g1 = __builtin_nontemporal_load((const u32x4*)(Gb + tok_e * 1024 + dc * 64 + qt_e * 16 + 8));
        if (k1p == 0) {
#pragma unroll
            for (int z = 0; z < 2; ++z) { const int ci = tid + 512 * z, row = ci >> 3, ch = ci & 7; *(LAS u32x4*)(lds + row * TP + ch * 16) = ld[z]; *(LAS u32x4*)(lds + (128 + row) * TP + ch * 16) = ld[2 + z]; }
        } else {
            const int s2 = tid >> 3, ch = tid & 7;
            const u32x4 yr = ld[0], yi = ld[1];
            float sn, cs; sincospif((float)s2 * (1.f / 32.f), &sn, &cs);
            u32x4 zr, zi;
#pragma unroll
            for (int e = 0; e < 4; ++e) { const float rl = bflo(yr[e]), rh = bfhi(yr[e]), il = bflo(yi[e]), ih = bfhi(yi[e]);
                zr[e] = pk2(rl * cs + il * sn, rh * cs + ih * sn); zi[e] = pk2(rl * sn - il * cs, rh * sn - ih * cs); }
            *(LAS u32x4*)(lds + s2 * TP + ch * 16) = yr; *(LAS u32x4*)(lds + (64 + s2) * TP + ch * 16) = yi;
            *(LAS u32x4*)(lds + (128 + s2) * TP + ch * 16) = zr; *(LAS u32x4*)(lds + (192 + s2) * TP + ch * 16) = zi;
        }
        __syncthreads();
        if (u + (int)gridDim.x < 4096) DFT2_ISSUE(u + (int)gridDim.x);
        f32x16 acc[2]; acc[0] = f32x16{}; acc[1] = f32x16{};
#pragma unroll
        for (int ks = 0; ks < 8; ++ks) { const s16x4 lo = trrd(rb + ks * 16 * TP), hi = trrd(rb + ks * 16 * TP + 4 * TP);
            const bf16x8 bfr = __builtin_shufflevector(lo, hi, 0, 1, 2, 3, 4, 5, 6, 7);
            acc[0] = __builtin_amdgcn_mfma_f32_32x32x16_bf16(af[0][ks], bfr, acc[0], 0, 0, 0);
            acc[1] = __builtin_amdgcn_mfma_f32_32x32x16_bf16(af[1][ks], bfr, acc[1], 0, 0, 0); }
#pragma unroll
        for (int z = 0; z < 2; ++z)
#pragma unroll
            for (int i = 0; i < 16; ++i) *(LAS bf16_t*)(tt + (ksub * 64 + 32 * z + crow(i, h)) * TTP + (mh * 64 + 32 * nt + l31) * 2) = (bf16_t)f2bf(acc[z][i]);
        __syncthreads();
        f32x16 o2 = f32x16{};
#pragma unroll
        for (int ks = 0; ks < 8; ++ks) { const bf16x8 tf = *(LAS const bf16x8*)(tt + (32 * mt2 + l31) * TTP + (16 * ks + 8 * h) * 2);
            o2 = __builtin_amdgcn_mfma_f32_32x32x16_bf16(tf, gf[ks], o2, 0, 0, 0); }
#pragma unroll
        for (int i = 0; i < 16; ++i) ot[(32 * mt2 + crow(i, h)) * 64 + 32 * nt2 + l31] = o2[i];
        __syncthreads();
        {
            const int tr = tid >> 2, qt = tid & 3, ks2 = tr >> 6, k2 = tr & 63;
            const size_t tok = (size_t)b * SEQ + (ks2 ? k1b : k1a) + 128 * k2;
            const LAS f32x4* op = (const LAS f32x4*)(ot + tr * 64 + qt * 16);
            const f32x4 v0 = op[0], v1 = op[1], v2 = op[2], v3 = op[3];
            u32x4 w0, w1;
            w0.x = pk2(v0.x * bflo(g0.x), v0.y * bfhi(g0.x)); w0.y = pk2(v0.z * bflo(g0.y), v0.w * bfhi(g0.y)); w0.z = pk2(v1.x * bflo(g0.z), v1.y * bfhi(g0.z)); w0.w = pk2(v1.z * bflo(g0.w), v1.w * bfhi(g0.w));
            w1.x = pk2(v2.x * bflo(g1.x), v2.y * bfhi(g1.x)); w1.y = pk2(v2.z * bflo(g1.y), v2.w * bfhi(g1.y)); w1.z = pk2(v3.x * bflo(g1.z), v3.y * bfhi(g1.z)); w1.w = pk2(v3.z * bflo(g1.w), v3.w * bfhi(g1.w));
            *(u32x4*)(ym + tok * 1024 + dc * 64 + qt * 16) = w0; *(u32x4*)(ym + tok * 1024 + dc * 64 + qt * 16 + 8) = w1;
        }
        __syncthreads();
    }
}

constexpr int KP = 144, VP = 192, KROWS = 384, LDS_VOFF = KROWS * KP;
struct AUnit { int b, hd, dil, L, r, i0; };
__device__ __forceinline__ AUnit attn_decode(int n) {
    AUnit w; const int quarter = 3 - n / 1536, m = n % 1536, sub = m & 7; w.hd = (m >> 3) % 24; w.b = m / 192;
    const int cfg = w.hd >> 3;
    const int blk32 = cfg == 0 ? quarter * 8 + sub : (cfg == 1 ? (sub >> 1) * 8 + quarter * 2 + (sub & 1) : (((quarter & 1) * 8 + sub) * 2 + (quarter >> 1)));
    const int dsh = 2 * cfg, nbr = 32 >> dsh; w.dil = 1 << dsh; w.L = SEQ >> dsh; w.r = blk32 / nbr; w.i0 = (blk32 % nbr) * 256; return w;
}
__device__ __forceinline__ void attn_issue(const AUnit& w, const bf16_t* Qb, const bf16_t* Kb, const bf16_t* Vb, int tid, int wave, int lane, u32x4 (&kv)[6], u32x4 (&vv)[6]) {
    const int ch = tid & 7;
#pragma unroll
    for (int i = 0; i < 6; ++i) { const int row = (tid + 512 * i) >> 3; int pk = w.i0 - 64 + row; pk = pk < 0 ? 0 : (pk >= w.L ? w.L - 1 : pk);
        const size_t off = ((size_t)(w.b * 24 + w.hd) * SEQ + (size_t)(w.r * w.L + pk)) * 64 + ch * 8; kv[i] = *(const u32x4*)(Kb + off); vv[i] = *(const u32x4*)(Vb + off); }
}
__device__ __forceinline__ float attn_tile_exp(f32x16& st, int j, float tlf, float bsl, float rlo, float rhi) {
    float sum = 0.f;
#pragma unroll
    for (int i = 0; i < 16; ++i) { const float tmp = (float)(32 * j - 64 + (i & 3) + 8 * (i >> 2)) + tlf;
        float arg = __builtin_fmaf(-bsl, __builtin_fabsf(tmp), st[i]);
        arg = (tmp >= rlo && tmp <= rhi) ? arg : -1.0e30f;
        const float pe = __builtin_amdgcn_exp2f(arg); st[i] = pe; sum += pe; }
    return sum;
}
__device__ __forceinline__ void attn_phase(const Args& a, LAS unsigned char* lds, int tid, int lane, int wave) {
    asm volatile("" : "+v"(tid), "+v"(lane));
    bf16_t* Qb = (bf16_t*)(a.ws + WS_Q); const bf16_t* Kb = (const bf16_t*)(a.ws + WS_K); const bf16_t* Vb = (const bf16_t*)(a.ws + WS_V); float* LSE = (float*)(a.ws + WS_LSE);
    const int h = lane >> 5, l31 = lane & 31;
    const int q = (lane & 15) >> 2, p = lane & 3, blk = (lane >> 4) & 1;
    int u = blockIdx.x;
    u32x4 kv[6], vv[6];
    if (u < 6144) { const AUnit w0 = attn_decode(u); attn_issue(w0, Qb, Kb, Vb, tid, wave, lane, kv, vv); }
    while (u < 6144) {
        const AUnit w = attn_decode(u);
        const int hd = w.hd, slot = hd & 7, L = w.L, i0 = w.i0;
        const int iq = i0 + 32 * wave + l31; const size_t tq = (size_t)w.b * SEQ + (size_t)iq * w.dil + w.r;
        bf16_t* qrow = Qb + ((size_t)(w.b * 24 + hd) * SEQ + (size_t)(w.r * L + iq)) * 64;
        u32x4 qv[4];
#pragma unroll
        for (int ks = 0; ks < 4; ++ks) qv[ks] = *(const u32x4*)(qrow + 16 * ks + 8 * h);
        {
            const int ch = tid & 7;
            const f32x4 g0 = *(const f32x4*)(a.kw + hd * 64 + ch * 8), g1 = *(const f32x4*)(a.kw + hd * 64 + ch * 8 + 4);
#pragma unroll
            for (int i = 0; i < 6; ++i) { const int row = (tid + 512 * i) >> 3;
                const float e0 = bflo(kv[i].x), e1 = bfhi(kv[i].x), e2 = bflo(kv[i].y), e3 = bfhi(kv[i].y), e4 = bflo(kv[i].z), e5 = bfhi(kv[i].z), e6 = bflo(kv[i].w), e7 = bfhi(kv[i].w);
                float ss = (e0 * e0 + e1 * e1) + (e2 * e2 + e3 * e3) + (e4 * e4 + e5 * e5) + (e6 * e6 + e7 * e7);
                ss += dpp_movf<0xB1>(ss); ss += dpp_movf<0x4E>(ss); ss += dpp_movf<0x141>(ss);
                const float rk = __builtin_amdgcn_rsqf(ss * (1.f / 64.f) + 1e-6f);
                u32x4 wv; wv.x = pk2(e0 * rk * g0.x, e1 * rk * g0.y); wv.y = pk2(e2 * rk * g0.z, e3 * rk * g0.w); wv.z = pk2(e4 * rk * g1.x, e5 * rk * g1.y); wv.w = pk2(e6 * rk * g1.z, e7 * rk * g1.w);
                *(LAS u32x4*)(lds + row * KP + ch * 16) = wv;
                *(LAS u32x4*)(lds + LDS_VOFF + row * VP + ch * 16) = vv[i];
                if (i & 1) __builtin_amdgcn_sched_barrier(0); }
        }
        bf16x8 qf[4];
        {
            float ss = 0.f;
#pragma unroll
            for (int ks = 0; ks < 4; ++ks)
#pragma unroll
                for (int e = 0; e < 4; ++e) { const float lo = bflo(qv[ks][e]), hi = bfhi(qv[ks][e]); ss += lo * lo + hi * hi; }
            ss += __shfl_xor(ss, 32);
            const float rq = 0.125f * LOG2E * __builtin_amdgcn_rsqf(ss * (1.f / 64.f) + 1e-6f);
#pragma unroll
            for (int ks = 0; ks < 4; ++ks) { const f32x4 g0 = *(const f32x4*)(a.qw + hd * 64 + 16 * ks + 8 * h), g1 = *(const f32x4*)(a.qw + hd * 64 + 16 * ks + 8 * h + 4); u32x4 wv;
                wv.x = pk2(bflo(qv[ks].x) * rq * g0.x, bfhi(qv[ks].x) * rq * g0.y); wv.y = pk2(bflo(qv[ks].y) * rq * g0.z, bfhi(qv[ks].y) * rq * g0.w);
                wv.z = pk2(bflo(qv[ks].z) * rq * g1.x, bfhi(qv[ks].z) * rq * g1.y); wv.w = pk2(bflo(qv[ks].w) * rq * g1.z, bfhi(qv[ks].w) * rq * g1.w);
                qf[ks] = __builtin_bit_cast(bf16x8, wv); }
        }
        const float mb = ((const float*)(a.ws + WS_RS))[hd];
        __syncthreads();
        const int un = u + gridDim.x;
        if (un < 6144) { const AUnit wn = attn_decode(un); attn_issue(wn, Qb, Kb, Vb, tid, wave, lane, kv, vv); }
        const float bsl = __builtin_amdgcn_exp2f(-(float)(slot + 1)) * (float)w.dil * LOG2E;
        int tl = 4 * h - l31; asm volatile("" : "+v"(tl));
        const float tlf = (float)tl;
        const int lo_i = -iq > -64 ? -iq : -64, hi_i = (L - 1 - iq) < 64 ? (L - 1 - iq) : 64;
        const float rlo = (float)lo_i, rhi = (float)hi_i;
        const int wq0 = i0 + 32 * wave;
        const bool edge = (wq0 < 64) || (wq0 + 32 > L - 64);
        float sum = 0.f;
        f32x16 o[2]; o[0] = f32x16{}; o[1] = f32x16{};
#pragma unroll
        for (int j = 0; j < 5; ++j) {
            f32x16 st;
#pragma unroll
            for (int i = 0; i < 16; ++i) st[i] = -mb;
            LAS const unsigned char* kp = lds + (32 * wave + 32 * j + l31) * KP + 16 * h;
#pragma unroll
            for (int ks = 0; ks < 4; ++ks) { const bf16x8 kf = *(LAS const bf16x8*)(kp + 32 * ks); st = __builtin_amdgcn_mfma_f32_32x32x16_bf16(kf, qf[ks], st, 0, 0, 0); }
            sum += attn_tile_exp(st, j, tlf, bsl, rlo, rhi);
#pragma unroll
            for (int s2 = 0; s2 < 2; ++s2) { u32x4 pw; pw.x = pk2(st[8 * s2 + 0], st[8 * s2 + 1]); pw.y = pk2(st[8 * s2 + 2], st[8 * s2 + 3]); pw.z = pk2(st[8 * s2 + 4], st[8 * s2 + 5]); pw.w = pk2(st[8 * s2 + 6], st[8 * s2 + 7]);
                const bf16x8 pf = __builtin_bit_cast(bf16x8, pw);
                LAS const unsigned char* vp = lds + LDS_VOFF + (32 * wave + 32 * j + 16 * s2 + 4 * h + q) * VP + 32 * blk + 8 * p;
#pragma unroll
                for (int dt = 0; dt < 2; ++dt) { const s16x4 lo = trrd(vp + dt * 64), hi = trrd(vp + 8 * VP + dt * 64);
                    const bf16x8 vf = __builtin_shufflevector(lo, hi, 0, 1, 2, 3, 4, 5, 6, 7);
                    o[dt] = __builtin_amdgcn_mfma_f32_32x32x16_bf16(vf, pf, o[dt], 0, 0, 0); } }
            __builtin_amdgcn_sched_barrier(0);
        }
        sum += __shfl_xor(sum, 32);
        const float inv = __builtin_amdgcn_rcpf(sum);
        {
            LAS unsigned char* ost = lds + 129024 + wave * 4096;
#pragma unroll
            for (int dt = 0; dt < 2; ++dt)
#pragma unroll
                for (int ig = 0; ig < 4; ++ig) { u32x2 wv; wv.x = pk2(o[dt][4 * ig] * inv, o[dt][4 * ig + 1] * inv); wv.y = pk2(o[dt][4 * ig + 2] * inv, o[dt][4 * ig + 3] * inv);
                    const int p8 = 8 * dt + 2 * ig + h; *(LAS u32x2*)(ost + l31 * 128 + 8 * (p8 ^ (l31 & 15))) = wv; }
            asm volatile("s_waitcnt lgkmcnt(0)" ::: "memory");
            bf16_t* obase = qrow - l31 * 64;
#pragma unroll
            for (int it = 0; it < 4; ++it) { const int r = 8 * it + (lane >> 3), c16 = lane & 7;
                u32x4 v = *(LAS const u32x4*)(ost + r * 128 + 16 * (c16 ^ ((r & 15) >> 1)));
                if (r & 1) { const unsigned t0 = v.x, t1 = v.y; v.x = v.z; v.y = v.w; v.z = t0; v.w = t1; }
                *(u32x4*)(obase + (size_t)r * 64 + c16 * 8) = v; asm volatile("" ::: "memory"); }
        }
        if (h == 0) LSE[tq * 24 + hd] = mb + __builtin_amdgcn_logf(sum);
        __syncthreads();
        u = un;
    }
}
__device__ __forceinline__ void merge_phase(const Args& a, int lane, int wave) {
    asm volatile("" : "+v"(lane));
    const bf16_t* Ob = (const bf16_t*)(a.ws + WS_Q); const bf16_t* Gb = (const bf16_t*)(a.ws + WS_G); const float* LSE = (const float*)(a.ws + WS_LSE); bf16_t* ym = (bf16_t*)(a.ws + WS_Z);
    const int gw = blockIdx.x * 8 + wave, NGW = gridDim.x * 8, slot = lane >> 3;
    for (int tok0 = gw; tok0 < MTOK; tok0 += 2 * NGW) {
        u32x4 o0[2], o1[2], o2[2], g[2]; float l0[2], l1[2], l2[2];
#pragma unroll
        for (int z = 0; z < 2; ++z) { int tok = tok0 + z * NGW; tok = tok < MTOK ? tok : tok0;
            l0[z] = LSE[(size_t)tok * 24 + slot]; l1[z] = LSE[(size_t)tok * 24 + 8 + slot]; l2[z] = LSE[(size_t)tok * 24 + 16 + slot];
            const int b = tok >> 13, t = tok & (SEQ - 1), part = lane & 7;
            o0[z] = __builtin_nontemporal_load((const u32x4*)(Ob + ((size_t)(b * 24 + slot) * SEQ + t) * 64 + part * 8));
            o1[z] = __builtin_nontemporal_load((const u32x4*)(Ob + ((size_t)(b * 24 + 8 + slot) * SEQ + (t & 3) * 2048 + (t >> 2)) * 64 + part * 8));
            o2[z] = __builtin_nontemporal_load((const u32x4*)(Ob + ((size_t)(b * 24 + 16 + slot) * SEQ + (t & 15) * 512 + (t >> 4)) * 64 + part * 8));
            g[z] = __builtin_nontemporal_load((const u32x4*)(Gb + (size_t)tok * 1024 + 512 + lane * 8)); }
#pragma unroll
        for (int z = 0; z < 2; ++z) { const int tok = tok0 + z * NGW; if (tok >= MTOK) break;
            const float mx = fmaxf(l0[z], fmaxf(l1[z], l2[z]));
            float w0 = __builtin_amdgcn_exp2f(l0[z] - mx), w1 = __builtin_amdgcn_exp2f(l1[z] - mx), w2 = __builtin_amdgcn_exp2f(l2[z] - mx);
            const float inv = 1.0f / (w0 + w1 + w2); w0 *= inv; w1 *= inv; w2 *= inv;
            u32x4 w;
#pragma unroll
            for (int e = 0; e < 4; ++e) { const float lo = (bflo(o0[z][e]) * w0 + bflo(o1[z][e]) * w1 + bflo(o2[z][e]) * w2) * bflo(g[z][e]); const float hi = (bfhi(o0[z][e]) * w0 + bfhi(o1[z][e]) * w1 + bfhi(o2[z][e]) * w2) * bfhi(g[z][e]); w[e] = pk2(lo, hi); }
            *(u32x4*)(ym + (size_t)tok * 1024 + 512 + lane * 8) = w; }
    }
}

#define XB_TMO      128
#define XB_XCNT(j)  (256  + 64 * (j))
#define XB_XSUB(j)  (1280 + 64 * (j))
#define XB_XGEN(j)  (2304 + 64 * (j))
#define XB_TOP      3328
#define XB_TOPGEN   3392
#define XCD_BAR_WORDS 3456
#define XB_SPIN_CAP (1u << 18)

__device__ __forceinline__ unsigned xb_ld(unsigned* p)              { return __hip_atomic_load(p, __ATOMIC_RELAXED, __HIP_MEMORY_SCOPE_AGENT); }
__device__ __forceinline__ unsigned xb_add(unsigned* p, unsigned v) { return __hip_atomic_fetch_add(p, v, __ATOMIC_RELAXED, __HIP_MEMORY_SCOPE_AGENT); }
__device__ __forceinline__ unsigned xb_xcc_id() { return (unsigned)__builtin_amdgcn_s_getreg((3 << 11) | 20) & 0xFu; }
#define XB_SPIN(cond, bar) do { unsigned _sp = 0; while (cond) { __builtin_amdgcn_s_sleep(1); \
    if ((++_sp & 255u) == 0u) { if (xb_ld(&(bar)[XB_TMO])) break; if (_sp > XB_SPIN_CAP) { atomicAdd(&(bar)[XB_TMO], 1u); break; } } } } while (0)

struct XcdBarrier {
    unsigned* bar; unsigned x;
    volatile LAS unsigned* st;
};

__device__ __forceinline__ XcdBarrier xcd_barrier_post(unsigned* bar, volatile LAS unsigned* st) {
    XcdBarrier b; b.bar = bar; b.x = xb_xcc_id(); b.st = st;
    if (threadIdx.x == 0) (void)xb_add(&bar[XB_XCNT(b.x)], 1u);
    return b;
}
__device__ __forceinline__ void xcd_barrier_complete(unsigned* bar, unsigned x, unsigned& nloc, unsigned& nx) {
    const unsigned G = gridDim.x * gridDim.y * gridDim.z;
    unsigned sum, cnt, mine, sp = 0u;
    for (;;) {
        sum = 0u; cnt = 0u; mine = 0u;
#pragma unroll
        for (unsigned j = 0; j < 16; ++j) { const unsigned c = xb_ld(&bar[XB_XCNT(j)]); sum += c; cnt += (c > 0u) ? 1u : 0u; mine = (j == x) ? c : mine; }
        if (sum == G) break;
        __builtin_amdgcn_s_sleep(1);
        if ((++sp & 255u) == 0u) { if (xb_ld(&bar[XB_TMO])) break; if (sp > XB_SPIN_CAP) { atomicAdd(&bar[XB_TMO], 1u); break; } }
    }
    nloc = mine > 0u ? mine : 1u; nx = cnt > 0u ? cnt : 1u;
}

__device__ __forceinline__ void xcd_barrier(const XcdBarrier& b) {
    asm volatile("s_waitcnt vmcnt(0)" ::: "memory");
    __syncthreads();
    if (threadIdx.x == 0) {
        unsigned* bar = b.bar;
        __builtin_amdgcn_s_waitcnt(0);
        unsigned nloc = b.st[0], nx = b.st[1];
        if (nloc == 0u) { xcd_barrier_complete(bar, b.x, nloc, nx); b.st[0] = nloc; b.st[1] = nx; }
        const unsigned old = xb_add(&bar[XB_XSUB(b.x)], 1u);
        const unsigned gen = old / nloc;
        if (old + 1u == (gen + 1u) * nloc) {
            __builtin_amdgcn_fence(__ATOMIC_RELEASE, "agent");
            asm volatile("s_waitcnt vmcnt(0)" ::: "memory");
            const unsigned og = xb_add(&bar[XB_TOP], 1u);
            const unsigned tg = og / nx;
            if (og + 1u == (tg + 1u) * nx) xb_add(&bar[XB_TOPGEN], 1u);
            else XB_SPIN(xb_ld(&bar[XB_TOPGEN]) == tg, bar);
            __builtin_amdgcn_fence(__ATOMIC_ACQUIRE, "agent");
            xb_add(&bar[XB_XGEN(b.x)], 1u);
            asm volatile("s_waitcnt vmcnt(0)" ::: "memory");
        } else {
            XB_SPIN(xb_ld(&bar[XB_XGEN(b.x)]) == gen, bar);
            __builtin_amdgcn_fence(__ATOMIC_ACQUIRE, "agent");
            asm volatile("s_waitcnt vmcnt(0)" ::: "memory");
        }
    }
    __syncthreads();
}

__global__ void __launch_bounds__(512, 2) mega_fwd(Args a) {
    extern __shared__ __attribute__((aligned(16))) unsigned char lds_raw[];
    LAS unsigned char* lds = (LAS unsigned char*)lds_raw;
    cg::grid_group grid = cg::this_grid();
    const int tid = threadIdx.x, lane = tid & 63, wave = __builtin_amdgcn_readfirstlane(tid >> 6);
    volatile LAS unsigned* bst = (volatile LAS unsigned*)(lds + 161792);
    if (tid < 2) bst[tid] = 0u;
    __syncthreads();
    XcdBarrier bar = xcd_barrier_post((unsigned*)(a.ws + WS_BAR), bst);
    if (a.ws == nullptr) grid.sync();
#ifndef REP0
#define REP0 1
#define REP1 1
#define REPD1 1
#define REPD2 1
#define REPM 1
#define REP4 1
#endif
    for (int rep = 0; rep < REP0; ++rep) phase0(a, lds, tid, lane, wave);
    xcd_barrier(bar);
    {
        pg8::Gemm g{(const pg8::bf16_t*)(a.ws + WS_XB), (const pg8::bf16_t*)(a.ws + WS_WT), MTOK, NIN, DM}; pg8::StaticOrder S; S.init(MTOK, NIN, gridDim.x, (int)blockIdx.x, REP1);
        Epi1 E{(bf16_t*)(a.ws + WS_Z), (bf16_t*)(a.ws + WS_G), (bf16_t*)(a.ws + WS_Q), (bf16_t*)(a.ws + WS_K), (bf16_t*)(a.ws + WS_V)};
        pg8::gemm_phase<Epi1, pg8::StaticOrder, true, true>(lds, g, S, E);
    }
    xcd_barrier(bar);
    attn_phase(a, lds, tid, lane, wave);
    for (int rep = 0; rep < REPD1; ++rep) dft1_phase(a, lds, tid, lane, wave);
    xcd_barrier(bar);
    for (int rep = 0; rep < REPM; ++rep) merge_phase(a, lane, wave);
    for (int rep = 0; rep < REPD2; ++rep) dft2_phase(a, lds, tid, lane, wave);
    xcd_barrier(bar);
    {
        pg8::Gemm g{(const pg8::bf16_t*)(a.ws + WS_Z), (const pg8::bf16_t*)(a.ws + WS_WOT), MTOK, DM, DM}; pg8::StaticOrder S; S.init(MTOK, DM, gridDim.x, (int)blockIdx.x, REP4);
        Epi2 E{a.x, a.out};
        pg8::gemm_phase<Epi2, pg8::StaticOrder, true, true>(lds, g, S, E);
    }
}

extern "C" void kernel_launch(void* const* d_in, const int* in_sizes, int n_in, void* d_out, int out_size, void* d_ws, size_t ws_size, hipStream_t stream) {
    static int grid = 0;
    if (grid == 0) {
        if (n_in != 7 || in_sizes[0] != MTOK * DM || out_size != MTOK * DM || ws_size < WS_END) { fprintf(stderr, "kernel_launch: unexpected shapes / workspace (%d inputs, ws %zu)\n", n_in, ws_size); grid = -1; return; }
        int dev = 0, cus = 0, per_cu = 0;
        hipGetDevice(&dev); hipDeviceGetAttribute(&cus, hipDeviceAttributeMultiprocessorCount, dev);
        hipFuncSetAttribute((const void*)mega_fwd, hipFuncAttributeMaxDynamicSharedMemorySize, LDS_BYTES);
        hipOccupancyMaxActiveBlocksPerMultiprocessor(&per_cu, (const void*)mega_fwd, 512, LDS_BYTES);
        if (per_cu < 1) { fprintf(stderr, "kernel_launch: occupancy query says %d blocks per CU\n", per_cu); per_cu = 1; }
        grid = cus;
        (void)hipGetLastError();
    }
    if (grid < 0) return;
    Args a{};
    a.x = (const float*)d_in[0]; a.norm_w = (const float*)d_in[1]; a.w_in = (const float*)d_in[2]; a.qw = (const float*)d_in[3]; a.kw = (const float*)d_in[4];
    a.wf = (const float*)d_in[5]; a.w_out = (const float*)d_in[6]; a.out = (float*)d_out; a.ws = (unsigned char*)d_ws;
    if (hipMemsetAsync((char*)d_ws + WS_BAR, 0, 16384, stream) != hipSuccess) { fprintf(stderr, "kernel_launch: memset of the barrier words failed\n"); return; }
    void* args[] = {&a};
    hipError_t e = hipLaunchCooperativeKernel((const void*)mega_fwd, dim3(grid), dim3(512), args, LDS_BYTES, stream);
    if (e != hipSuccess) fprintf(stderr, "cooperative launch failed: %s (grid %d)\n", hipGetErrorString(e), grid);
}
```

```cpp
#include <hip/hip_runtime.h>
#include <hip/hip_cooperative_groups.h>
#include <cstdio>
#include <cstdint>
namespace cg = cooperative_groups;
namespace pg8 {
#define PG8_LAS __attribute__((address_space(3)))
typedef unsigned short bf16_t;
typedef short bf16x8 __attribute__((ext_vector_type(8)));
typedef float f32x4 __attribute__((ext_vector_type(4)));
typedef unsigned u32x4 __attribute__((ext_vector_type(4)));
constexpr int BM = 256, BK = 64, HALF = 128, HTB = HALF * BK * 2  , STAGE_BYTES = 8 * HTB, NXCD = 8, WGM = 8;

__host__ __device__ __forceinline__ int lds_byte(int r, int c) { const int st = (r >> 4) * 2 + (c >> 5), rr = r & 15, cc = c & 31, ob = rr * 64 + cc * 2; return st * 1024 + (ob ^ (((ob >> 9) & 1) << 5)); }
__host__ __device__ __forceinline__ void stage_rc(int b, int& R, int& C) { const int st = b / 1024, sb = b % 1024, swz = sb ^ (((sb >> 9) & 1) << 5); R = (st >> 1) * 16 + swz / 64; C = (st & 1) * 32 + (swz % 64) / 2; }
__host__ __device__ __forceinline__ int perm32(int rho) { const int n = rho >> 4, i = rho & 15; return 8 * (i >> 2) + 4 * n + (i & 3); }

struct Unit { int pm, pn; };
struct Gemm { const bf16_t* A; const bf16_t* Bt; int M, N, K; };

struct StaticOrder {
    int nM, nN, nwg, G, c, rep;
    __host__ __device__ void init(int M, int N, int G_, int c_, int rep_ = 1) { nM = M / BM; nN = N / BM; nwg = nM * nN; G = G_; c = c_; rep = rep_; }
    __host__ __device__ bool next(int i, Unit& u) const {
        const int per = (nwg + G - 1) / G; if (i >= per * rep) return false; const long L = (long)(i % per) * G + c; if (L >= nwg) return false;
        int wgid = (int)L; { const int q = nwg / NXCD, r = nwg % NXCD, xcd = wgid % NXCD, off = wgid / NXCD; wgid = (xcd < r ? xcd * (q + 1) : r * (q + 1) + (xcd - r) * q) + off; }
        const int nig = WGM * nN, gid = wgid / nig, fm = gid * WGM, gsz = (nM - fm) < WGM ? (nM - fm) : WGM;
        u.pm = fm + ((wgid % nig) % gsz); u.pn = (wgid % nig) / gsz; return true;
    }
    __device__ __forceinline__ void a_ready(const Unit&) const {}
    __device__ __forceinline__ void done(const Unit&) const {}
};

__device__ __forceinline__ unsigned cvt_pk_bf16(float lo, float hi) { unsigned r; asm volatile("v_cvt_pk_bf16_f32 %0, %1, %2" : "=v"(r) : "v"(lo), "v"(hi)); return r; }
typedef float f32x2 __attribute__((ext_vector_type(2)));
template <class Epi, class Sched, bool ALIGN_EPI = false, bool SP2 = false>
__device__ __forceinline__ void gemm_phase(PG8_LAS unsigned char* lds, const Gemm g, const Sched& S, const Epi& E) {
    const int tid = threadIdx.x, wid = __builtin_amdgcn_readfirstlane(tid >> 6), lane = tid & 63, wr = wid >> 2, wc = wid & 3, fr = lane & 15, fq = lane >> 4;
    const int K = g.K, nt = K / BK;
    unsigned voffA[2], voffB[2];
#pragma unroll
    for (int i = 0; i < 2; ++i) { int R, C; stage_rc(tid * 16 + i * 8192, R, C); const int Rb = Epi::PERM2 ? (64 * (R >> 5) + perm32(R & 31)) : (Epi::PERM ? ((R & ~31) + perm32(R & 31)) : R);
        voffA[i] = (unsigned)(R * K + C) * 2u; voffB[i] = (unsigned)(Rb * K + C) * 2u; }
    const size_t kstep = (size_t)(BK * 2);
    const size_t hstep = (size_t)HALF * K * 2;
    const size_t hstepB = Epi::PERM2 ? (size_t)32 * K * 2 : hstep;
    const size_t tstep = 2 * hstep;
    const unsigned ldsw = (unsigned)wid * 1024u;
    const int aoff = lds_byte(wr * 64 + fr, fq * 8), boff = lds_byte(wc * 32 + fr, fq * 8);
#define PG8_SA(b, h) (((b) * 2 + (h)) * HTB)
#define PG8_SB(b, h) ((4 + (b) * 2 + (h)) * HTB)
#define PG8_STAGE(bufoff, gbase, voff) do { _Pragma("unroll") for (int _i = 0; _i < 2; ++_i) \
        __builtin_amdgcn_global_load_lds((const unsigned*)((const char*)(gbase) + (voff)[_i]), (PG8_LAS unsigned*)(lds + (bufoff) + ldsw + _i * 8192), 16, 0, 0); } while (0)
#define PG8_LDA(dst, b, h) do { _Pragma("unroll") for (int m = 0; m < 4; ++m) _Pragma("unroll") for (int k = 0; k < 2; ++k) dst[m][k] = *(const PG8_LAS bf16x8*)(lds + PG8_SA(b, h) + aoff + m * 2048 + k * 1024); } while (0)
#define PG8_LDB(dst, b, h) do { _Pragma("unroll") for (int n = 0; n < 2; ++n) _Pragma("unroll") for (int k = 0; k < 2; ++k) dst[n][k] = *(const PG8_LAS bf16x8*)(lds + PG8_SB(b, h) + boff + n * 2048 + k * 1024); } while (0)
#define PG8_MMA(ai, bj, At, Bt) do { __builtin_amdgcn_s_setprio(1); _Pragma("unroll") for (int m = 0; m < 4; ++m) _Pragma("unroll") for (int n = 0; n < 2; ++n) _Pragma("unroll") for (int k = 0; k < 2; ++k) \
        acc[ai][bj][m][n] = __builtin_amdgcn_mfma_f32_16x16x32_bf16(Bt[n][k], At[m][k], acc[ai][bj][m][n], 0, 0, 0); __builtin_amdgcn_s_setprio(0); } while (0)
#define PG8_WAIT_V(n) asm volatile("s_waitcnt vmcnt(" #n ")" ::: "memory")
#define PG8_WAIT_L(n) asm volatile("s_waitcnt lgkmcnt(" #n ")" ::: "memory")
#define PG8_BAR __builtin_amdgcn_s_barrier()
#define PG8_SCHED __builtin_amdgcn_sched_barrier(0)
    Unit cur, nxt; int ui = 0;
    if (!S.next(0, cur)) return;
    f32x4 acc[2][2][4][2];
#pragma unroll
    for (int a = 0; a < 2; ++a)
#pragma unroll
        for (int b = 0; b < 2; ++b)
#pragma unroll
            for (int m = 0; m < 4; ++m)
#pragma unroll
                for (int n = 0; n < 2; ++n) acc[a][b][m][n] = (f32x4){0.f, 0.f, 0.f, 0.f};
    bf16x8 At[4][2], B0[2][2], B1[2][2];
    const char* cA = (const char*)g.A + (size_t)cur.pm * tstep; const char* cB = (const char*)g.Bt + (size_t)cur.pn * tstep;
    S.a_ready(cur);
    if constexpr (SP2) {
        PG8_STAGE(PG8_SB(0, 0), cB, voffB); PG8_STAGE(PG8_SB(0, 1), cB + hstepB, voffB); PG8_STAGE(PG8_SA(0, 0), cA, voffA); PG8_STAGE(PG8_SA(0, 1), cA + hstep, voffA);
        if (wr == 1) PG8_BAR;
        PG8_WAIT_V(2); PG8_BAR;
        PG8_STAGE(PG8_SB(1, 0), cB + kstep, voffB); PG8_STAGE(PG8_SA(1, 0), cA + kstep, voffA); PG8_STAGE(PG8_SB(1, 1), cB + hstepB + kstep, voffB);
        PG8_WAIT_V(6); PG8_BAR;
    } else {
        PG8_STAGE(PG8_SB(0, 0), cB, voffB); PG8_STAGE(PG8_SA(0, 0), cA, voffA); PG8_STAGE(PG8_SB(0, 1), cB + hstepB, voffB); PG8_STAGE(PG8_SA(0, 1), cA + hstep, voffA);
        if (wr == 1) PG8_BAR;
        PG8_WAIT_V(4); PG8_BAR;
        PG8_STAGE(PG8_SB(1, 0), cB + kstep, voffB); PG8_STAGE(PG8_SA(1, 0), cA + kstep, voffA); PG8_STAGE(PG8_SB(1, 1), cB + hstepB + kstep, voffB);
        PG8_WAIT_V(6); PG8_BAR;
    }
    for (;;) {
        const bool has_next = S.next(ui + 1, nxt);
        const char* nA = has_next ? (const char*)g.A + (size_t)nxt.pm * tstep : cA; const char* nB = has_next ? (const char*)g.Bt + (size_t)nxt.pn * tstep : cB;
        for (int t = 0; t < nt; t += 2) {
            const bool last = (t == nt - 2);
            const char* a1 = cA + (size_t)(t + 1) * kstep;
            const char* a2 = last ? nA : cA + (size_t)(t + 2) * kstep; const char* b2 = last ? nB : cB + (size_t)(t + 2) * kstep;
            const char* a3 = a2 + kstep; const char* b3 = b2 + kstep;
            if (last && has_next) S.a_ready(nxt);
            if constexpr (SP2) {
            PG8_LDB(B0, 0, 0); PG8_LDB(B1, 0, 1); PG8_SCHED; PG8_LDA(At, 0, 0); PG8_STAGE(PG8_SA(1, 1), a1 + hstep, voffA);
            PG8_WAIT_V(8); PG8_WAIT_L(0); PG8_BAR; PG8_MMA(0, 0, At, B0); PG8_MMA(0, 1, At, B1); PG8_BAR; PG8_SCHED;
            PG8_LDA(At, 0, 1); PG8_STAGE(PG8_SB(0, 0), b2, voffB); PG8_STAGE(PG8_SB(0, 1), b2 + hstepB, voffB); PG8_STAGE(PG8_SA(0, 0), a2, voffA);
            PG8_WAIT_V(8); PG8_WAIT_L(0); PG8_BAR; PG8_MMA(1, 0, At, B0); PG8_MMA(1, 1, At, B1); PG8_BAR; PG8_SCHED;
            PG8_LDB(B0, 1, 0); PG8_LDB(B1, 1, 1); PG8_SCHED; PG8_LDA(At, 1, 0); PG8_STAGE(PG8_SA(0, 1), a2 + hstep, voffA);
            PG8_WAIT_V(8); PG8_WAIT_L(0); PG8_BAR; PG8_MMA(0, 0, At, B0); PG8_MMA(0, 1, At, B1); PG8_BAR; PG8_SCHED;
            PG8_LDA(At, 1, 1); PG8_STAGE(PG8_SB(1, 0), b3, voffB); PG8_STAGE(PG8_SB(1, 1), b3 + hstepB, voffB); PG8_STAGE(PG8_SA(1, 0), a3, voffA);
            PG8_WAIT_V(8); PG8_WAIT_L(0); PG8_BAR; PG8_MMA(1, 0, At, B0); PG8_MMA(1, 1, At, B1); PG8_BAR; PG8_SCHED;
            } else {
            PG8_LDB(B0, 0, 0); PG8_SCHED; PG8_LDA(At, 0, 0); PG8_STAGE(PG8_SA(1, 1), a1 + hstep, voffA);
            PG8_WAIT_L(8); PG8_BAR; PG8_WAIT_L(0); PG8_MMA(0, 0, At, B0); PG8_BAR; PG8_SCHED;
            PG8_LDB(B1, 0, 1); PG8_STAGE(PG8_SB(0, 0), b2, voffB);
            PG8_BAR; PG8_WAIT_L(0); PG8_MMA(0, 1, At, B1); PG8_BAR;
            PG8_LDA(At, 0, 1); PG8_STAGE(PG8_SA(0, 0), a2, voffA);
            PG8_BAR; PG8_WAIT_L(0); PG8_MMA(1, 0, At, B0); PG8_BAR; PG8_SCHED;
            PG8_STAGE(PG8_SB(0, 1), b2 + hstepB, voffB);
            PG8_WAIT_V(6); PG8_BAR; PG8_MMA(1, 1, At, B1); PG8_BAR;
            PG8_LDB(B0, 1, 0); PG8_SCHED; PG8_LDA(At, 1, 0); PG8_STAGE(PG8_SA(0, 1), a2 + hstep, voffA);
            PG8_WAIT_L(8); PG8_BAR; PG8_WAIT_L(0); PG8_MMA(0, 0, At, B0); PG8_BAR; PG8_SCHED;
            PG8_LDB(B1, 1, 1); PG8_STAGE(PG8_SB(1, 0), b3, voffB);
            PG8_BAR; PG8_WAIT_L(0); PG8_MMA(0, 1, At, B1); PG8_BAR;
            PG8_LDA(At, 1, 1); PG8_STAGE(PG8_SA(1, 0), a3, voffA);
            PG8_BAR; PG8_WAIT_L(0); PG8_MMA(1, 0, At, B0); PG8_BAR; PG8_SCHED;
            PG8_STAGE(PG8_SB(1, 1), b3 + hstepB, voffB);
            PG8_WAIT_V(6); PG8_BAR; PG8_MMA(1, 1, At, B1); PG8_BAR;
            }
        }
        if constexpr (ALIGN_EPI) { if (wr == 0) PG8_BAR; }
        if constexpr (!Epi::AFTER_DRAIN) { E(acc, cur, wr, wc, fr, fq); S.done(cur); }
        if (!has_next) break;
#pragma unroll
        for (int a = 0; a < 2; ++a)
#pragma unroll
            for (int b = 0; b < 2; ++b)
#pragma unroll
                for (int m = 0; m < 4; ++m)
#pragma unroll
                    for (int n = 0; n < 2; ++n) acc[a][b][m][n] = (f32x4){0.f, 0.f, 0.f, 0.f};
        cur = nxt; cA = nA; cB = nB; ++ui;
        if constexpr (ALIGN_EPI) { if (wr == 1) PG8_BAR; }
    }
    PG8_WAIT_V(0);
    if constexpr (!ALIGN_EPI) { if (wr == 0) PG8_BAR; }
    PG8_BAR;
    if constexpr (Epi::AFTER_DRAIN) { E.fused(acc, cur, wr, wc, fr, fq, lds, wid, lane); S.done(cur); }
#undef PG8_SA
#undef PG8_SB
#undef PG8_STAGE
#undef PG8_LDA
#undef PG8_LDB
#undef PG8_MMA
#undef PG8_WAIT_V
#undef PG8_WAIT_L
#undef PG8_BAR
#undef PG8_SCHED
}
}
#define LAS __attribute__((address_space(3)))
typedef unsigned short bf16_t;
typedef short bf16x8 __attribute__((ext_vector_type(8)));
typedef short s16x4 __attribute__((ext_vector_type(4)));
typedef short v4i16_t __attribute__((ext_vector_type(4)));
typedef float f32x4 __attribute__((ext_vector_type(4)));
typedef float f32x16 __attribute__((ext_vector_type(16)));
typedef unsigned u32x4 __attribute__((ext_vector_type(4)));
typedef unsigned u32x2 __attribute__((ext_vector_type(2)));

constexpr int SEQ = 8192, DM = 1024, MTOK = 65536, NIN = 6144, QKVW = 1536;
constexpr size_t WS_WT = 0, WS_WOT = 13631488, WS_RS = 15728640, WS_LSE = 15990784, WS_BAR = 23068672, WS_GMT = 24117248, WS_XB = 33554432, WS_Z = 167772160, WS_G = 301989888,
                 WS_Q = 436207616, WS_K = 637534208, WS_V = 838860800, WS_END = 1040187392;
constexpr int LDS_BYTES = 162944;
constexpr float LOG2E = 1.4426950408889634f;

__device__ __forceinline__ unsigned f2bf(float f) { unsigned u = __builtin_bit_cast(unsigned, f); return (u + 0x7fffu + ((u >> 16) & 1u)) >> 16; }
typedef float f32x2_t __attribute__((ext_vector_type(2))); typedef __bf16 bf16x2_t __attribute__((ext_vector_type(2)));
__device__ __forceinline__ unsigned pk2(float lo, float hi) { f32x2_t v = {lo, hi}; bf16x2_t b = __builtin_convertvector(v, bf16x2_t); return __builtin_bit_cast(unsigned, b); }
__device__ __forceinline__ float bflo(unsigned w) { return __builtin_bit_cast(float, w << 16); }
__device__ __forceinline__ float bfhi(unsigned w) { return __builtin_bit_cast(float, w & 0xffff0000u); }
__device__ __forceinline__ int crow(int r, int hi) { return (r & 3) + 8 * (r >> 2) + 4 * hi; }
__device__ __forceinline__ float wave_sum(float v) {
#pragma unroll
    for (int o = 1; o < 64; o <<= 1) v += __shfl_xor(v, o);
    return v;
}
__device__ __forceinline__ s16x4 trrd(LAS const unsigned char* p) { return __builtin_bit_cast(s16x4, __builtin_amdgcn_ds_read_tr16_b64_v4i16((LAS v4i16_t*)p)); }
__device__ __forceinline__ float silu_f(float v) { return v * __builtin_amdgcn_rcpf(1.f + __builtin_amdgcn_exp2f(-v * LOG2E)); }
#define LDS_WAIT() asm volatile("s_waitcnt lgkmcnt(0)" ::: "memory")
template <int CTRL> __device__ __forceinline__ unsigned dpp_mov(unsigned v) { return (unsigned)__builtin_amdgcn_update_dpp(0, (int)v, CTRL, 0xF, 0xF, true); }
template <int CTRL> __device__ __forceinline__ float dpp_movf(float v) { return __builtin_bit_cast(float, dpp_mov<CTRL>(__builtin_bit_cast(unsigned, v))); }

struct Args { const float *x, *norm_w, *w_in, *qw, *kw, *wf, *w_out; float* out; unsigned char* ws; };

__device__ __forceinline__ void transpose_item(const float* W, int ldw, int ncol0, bf16_t* WT, int row_off, const float* kscale, LAS float* scr, int kb, int nb, int lane) {
    const int k0 = 64 * kb, n0 = 32 * nb;
#pragma unroll 8
    for (int i = 0; i < 32; ++i) { const int kk = 2 * i + (lane >> 5); float v = W[(size_t)(k0 + kk) * ldw + ncol0 + n0 + (lane & 31)]; if (kscale) v *= kscale[k0 + kk]; scr[kk * 33 + (lane & 31)] = v; }
    LDS_WAIT();
    const int c = lane & 7;
#pragma unroll
    for (int j = 0; j < 4; ++j) { const int n = (lane >> 3) + 8 * j; const LAS float* s = scr + (8 * c) * 33 + n;
        u32x4 o; o.x = pk2(s[0 * 33], s[1 * 33]); o.y = pk2(s[2 * 33], s[3 * 33]); o.z = pk2(s[4 * 33], s[5 * 33]); o.w = pk2(s[6 * 33], s[7 * 33]);
        *(u32x4*)(WT + (size_t)(row_off + n0 + n) * 1024 + k0 + 8 * c) = o; }
    LDS_WAIT();
}
__device__ __forceinline__ void gmt_unit(const Args& a, LAS unsigned char* lds, int unit, int tid) {
    bf16_t* GmT = (bf16_t*)(a.ws + WS_GMT);
    LAS float* tab = (LAS float*)lds;
    if (tid < 64) { float sn, cs; sincospif((float)tid * (1.f / 32.f), &sn, &cs); tab[2 * tid] = cs; tab[2 * tid + 1] = sn; }
    __syncthreads();
    const int g = unit >> 2, d = 16 * (unit & 3) + (tid >> 5), c32 = tid & 31;
    float acc[4] = {0.f, 0.f, 0.f, 0.f};
    for (int l = 0; l < 64; ++l) { const float w = a.wf[(size_t)(g * 64 + l) * 64 + d];
#pragma unroll
        for (int e = 0; e < 4; ++e) { const int cc = c32 * 4 + e, c = cc & 63, idx = (l * c) & 63; acc[e] += w * (cc < 64 ? tab[2 * idx] : -tab[2 * idx + 1]); } }
#pragma unroll
    for (int e = 0; e < 4; ++e) GmT[(size_t)(g * 64 + d) * 128 + c32 * 4 + e] = (bf16_t)f2bf(acc[e] * 0.125f);
    __syncthreads();
}
__device__ __forceinline__ void phase0(const Args& a, LAS unsigned char* lds, int tid, int lane, int wave) {
    bf16_t* Wt = (bf16_t*)(a.ws + WS_WT); bf16_t* WoT = (bf16_t*)(a.ws + WS_WOT); bf16_t* xb = (bf16_t*)(a.ws + WS_XB);
    const int G = gridDim.x, bx = blockIdx.x;
    for (int u = bx; u < 32; u += G) gmt_unit(a, lds, u, tid);
    if (bx == G - 1 && wave < 3) {
        for (int hd = wave * 8; hd < wave * 8 + 8; ++hd) {
            float gqm = fabsf(a.qw[hd * 64 + lane]), gkm = fabsf(a.kw[hd * 64 + lane]);
#pragma unroll
            for (int o = 1; o < 64; o <<= 1) { gqm = fmaxf(gqm, __shfl_xor(gqm, o)); gkm = fmaxf(gkm, __shfl_xor(gkm, o)); }
            if (lane == 0) ((float*)(a.ws + WS_RS))[hd] = 8.08f * LOG2E * gqm * gkm;
        }
    }
    LAS float* scr = (LAS float*)(lds + 32768 + wave * 8448);
    const int gw = bx * 8 + wave, NGW = G * 8;
    constexpr int I_IN = 16 * 192, I_OUT = 16 * 32;
    for (int it = gw; it < I_IN + I_OUT; it += NGW) {
        if (it < I_IN) transpose_item(a.w_in, 6144, 0, Wt, 0, a.norm_w, scr, it / 192, it % 192, lane);
        else { const int r = it - I_IN; transpose_item(a.w_out, 1024, 0, WoT, 0, nullptr, scr, r / 32, r % 32, lane); }
    }
    for (int row = gw; row < MTOK; row += 2 * NGW) {
        const int row2 = row + NGW; const bool has2 = row2 < MTOK;
        const f32x4* xr = (const f32x4*)(a.x + (size_t)row * DM) + lane; const f32x4* xr2 = (const f32x4*)(a.x + (size_t)(has2 ? row2 : row) * DM) + lane;
        f32x4 v[4], v2[4]; float s = 0.f, s2 = 0.f;
#pragma unroll
        for (int j = 0; j < 4; ++j) { v[j] = __builtin_nontemporal_load(xr + 64 * j); v2[j] = __builtin_nontemporal_load(xr2 + 64 * j); }
#pragma unroll
        for (int j = 0; j < 4; ++j) { s += (v[j].x * v[j].x + v[j].y * v[j].y) + (v[j].z * v[j].z + v[j].w * v[j].w); s2 += (v2[j].x * v2[j].x + v2[j].y * v2[j].y) + (v2[j].z * v2[j].z + v2[j].w * v2[j].w); }
        s = wave_sum(s); s2 = wave_sum(s2);
        const float r = 1.0f / sqrtf(s * (1.f / DM) + 1e-6f), r2 = 1.0f / sqrtf(s2 * (1.f / DM) + 1e-6f);
        u32x2* o = (u32x2*)(xb + (size_t)row * DM) + lane;
#pragma unroll
        for (int j = 0; j < 4; ++j) { u32x2 w; w.x = pk2(v[j].x * r, v[j].y * r); w.y = pk2(v[j].z * r, v[j].w * r); o[64 * j] = w; }
        if (has2) { u32x2* o2 = (u32x2*)(xb + (size_t)row2 * DM) + lane;
#pragma unroll
            for (int j = 0; j < 4; ++j) { u32x2 w; w.x = pk2(v2[j].x * r2, v2[j].y * r2); w.y = pk2(v2[j].z * r2, v2[j].w * r2); o2[64 * j] = w; } }
    }
}

struct Epi1 {
    static constexpr bool PERM = true, PERM2 = true, AFTER_DRAIN = false;
    bf16_t *Z, *G, *Q, *Kb, *V;
    __device__ __forceinline__ void operator()(const pg8::f32x4 (&acc)[2][2][4][2], const pg8::Unit& u, int wr, int wc, int fr, int fq) const {
        const int pn = u.pn; const int hi8 = (fr >> 3) & 1, fr7 = fr & 7; const int rbase = u.pm * 256 + wr * 64 + fr7;
        const bool qkv = (pn >= 4 && pn < 22);
        const bool act = !qkv && pn >= 2;
        const int ld = pn < 2 ? 512 : 1024;
        bf16_t* base; int dsh = 0; size_t rowstride_tok = 0; int ecol;
        if (qkv) { const int which = (pn - 4) / 6, ct = (pn - 4) % 6; dsh = 2 * (ct >> 1);
            base = Q + (size_t)which * ((WS_K - WS_Q) / 2) + (size_t)(ct * 4 + wc) * SEQ * 64; ecol = 32 * hi8 + 8 * fq; }
        else { const int c0 = pn < 2 ? pn * 256 : (pn < 4 ? (pn - 2) * 256 : 512 + (pn - 22) * 256); base = (pn < 2 ? Z : G) + c0 + wc * 64; ecol = 32 * hi8 + 8 * fq; }
        const int dmask = (1 << dsh) - 1, Lc = SEQ >> dsh;
#pragma unroll
        for (int ai = 0; ai < 2; ++ai)
#pragma unroll
            for (int m = 0; m < 4; ++m) {
                pg8::f32x4 a0 = acc[ai][0][m][0], a1 = acc[ai][0][m][1], b0 = acc[ai][1][m][0], b1 = acc[ai][1][m][1];
                if (act) {
#pragma unroll
                    for (int e = 0; e < 4; ++e) { a0[e] = silu_f(a0[e]); a1[e] = silu_f(a1[e]); b0[e] = silu_f(b0[e]); b1[e] = silu_f(b1[e]); } }
                u32x4 A, B; A.x = pk2(a0[0], a0[1]); A.y = pk2(a0[2], a0[3]); A.z = pk2(a1[0], a1[1]); A.w = pk2(a1[2], a1[3]);
                B.x = pk2(b0[0], b0[1]); B.y = pk2(b0[2], b0[3]); B.z = pk2(b1[0], b1[1]); B.w = pk2(b1[2], b1[3]);
                u32x4 snd, rcv;
#pragma unroll
                for (int e = 0; e < 4; ++e) { snd[e] = hi8 ? A[e] : B[e]; rcv[e] = dpp_mov<0x128>(snd[e]); }
                u32x4 d1, d2;
#pragma unroll
                for (int e = 0; e < 4; ++e) { d1[e] = hi8 ? rcv[e] : A[e]; d2[e] = hi8 ? B[e] : rcv[e]; }
                const int row1 = rbase + ai * 128 + m * 16, row2 = row1 + 8;
                if (qkv) {
                    const int bb = row1 >> 13, t1 = row1 & (SEQ - 1), t2 = row2 & (SEQ - 1);
                    const int p1 = (t1 & dmask) * Lc + (t1 >> dsh), p2 = (t2 & dmask) * Lc + (t2 >> dsh);
                    bf16_t* hb = base + (size_t)bb * 24 * SEQ * 64 + ecol;
                    *(u32x4*)(hb + (size_t)p1 * 64) = d1; *(u32x4*)(hb + (size_t)p2 * 64) = d2;
                } else {
                    *(u32x4*)(base + (size_t)row1 * ld + ecol) = d1; *(u32x4*)(base + (size_t)row2 * ld + ecol) = d2;
                }
            }
    }
};
struct Epi2 {
    static constexpr bool PERM = false, PERM2 = false, AFTER_DRAIN = false;
    const float* x; float* out;
    __device__ __forceinline__ void operator()(const pg8::f32x4 (&acc)[2][2][4][2], const pg8::Unit& u, int wr, int wc, int fr, int fq) const {
        const int row0 = u.pm * 256 + wr * 64 + fr, col0 = u.pn * 256 + wc * 32 + 4 * fq;
#pragma unroll
        for (int ai = 0; ai < 2; ++ai)
#pragma unroll
            for (int m = 0; m < 4; ++m) { const size_t off = (size_t)(row0 + ai * 128 + m * 16) * DM + col0;
#pragma unroll
                for (int bj = 0; bj < 2; ++bj)
#pragma unroll
                    for (int n = 0; n < 2; ++n) { const size_t o2 = off + bj * 128 + n * 16; *(pg8::f32x4*)(out + o2) = *(const pg8::f32x4*)(x + o2) + acc[ai][bj][m][n]; }
                if (m & 1) asm volatile("" ::: "memory"); }
    }
};

constexpr int TP = 192;
constexpr int TTP = 272;
template <int NROWS> __device__ __forceinline__ void load_tile(LAS unsigned char* lds, const bf16_t* src, size_t rstride, int tid) {
    u32x4 v[NROWS / 64];
#pragma unroll
    for (int i = 0; i < NROWS / 64; ++i) { const int ci = tid + 512 * i, row = ci >> 3, ch = ci & 7; v[i] = *(const u32x4*)(src + (size_t)row * rstride + ch * 8); }
#pragma unroll
    for (int i = 0; i < NROWS / 64; ++i) { const int ci = tid + 512 * i, row = ci >> 3, ch = ci & 7; *(LAS u32x4*)(lds + row * TP + ch * 16) = v[i]; }
}
__device__ __forceinline__ void dft1_phase(const Args& a, LAS unsigned char* lds, int tid, int lane, int wave) {
    asm volatile("" : "+v"(tid), "+v"(lane));
    const bf16_t* Z = (const bf16_t*)(a.ws + WS_Z); bf16_t* Y = (bf16_t*)(a.ws + WS_XB);
    const int h = lane >> 5, l31 = lane & 31, kb = wave & 3, nt = wave >> 2;
    bf16x8 af[8];
    { const int ri_row = l31 >> 4, k1 = 16 * kb + (l31 & 15);
#pragma unroll
      for (int ks = 0; ks < 8; ++ks) { unsigned pw[4];
#pragma unroll
        for (int jj = 0; jj < 4; ++jj) { float vv[2];
#pragma unroll
            for (int e = 0; e < 2; ++e) { const int s1 = 16 * ks + 8 * h + 2 * jj + e; float sn, cs; sincospif((float)((s1 * k1) & 127) * (1.f / 64.f), &sn, &cs);
                float val = ri_row == 0 ? cs : sn;
                if (ri_row == 1 && k1 == 0) val = (s1 & 1) ? -1.f : 1.f;
                vv[e] = val * 0.08838834764831845f; }
            pw[jj] = pk2(vv[0], vv[1]); }
        u32x4 t; t.x = pw[0]; t.y = pw[1]; t.z = pw[2]; t.w = pw[3]; af[ks] = __builtin_bit_cast(bf16x8, t); } }
    const int q = (lane & 15) >> 2, p = lane & 3, blk = (lane >> 4) & 1;
    LAS const unsigned char* rb = lds + (8 * h + q) * TP + 32 * blk + 8 * p + nt * 64;
    u32x4 pf[2];
#define DFT1_ISSUE(uu) do { const int dc_ = (uu) & 7, s2_ = ((uu) >> 3) & 63, b_ = (uu) >> 9; const bf16_t* src_ = Z + ((size_t)b_ * SEQ + s2_) * 512 + dc_ * 64; \
        _Pragma("unroll") for (int i_ = 0; i_ < 2; ++i_) { const int ci_ = tid + 512 * i_; pf[i_] = *(const u32x4*)(src_ + (size_t)(ci_ >> 3) * (64 * 512) + (ci_ & 7) * 8); } } while (0)
    if ((int)blockIdx.x < 4096) DFT1_ISSUE((int)blockIdx.x);
    for (int u = blockIdx.x; u < 4096; u += gridDim.x) {
        const int dc = u & 7, s2 = (u >> 3) & 63, b = u >> 9;
#pragma unroll
        for (int i = 0; i < 2; ++i) { const int ci = tid + 512 * i; *(LAS u32x4*)(lds + (ci >> 3) * TP + (ci & 7) * 16) = pf[i]; }
        __syncthreads();
        if (u + (int)gridDim.x < 4096) DFT1_ISSUE(u + (int)gridDim.x);
        f32x16 acc = f32x16{};
#pragma unroll
        for (int ks = 0; ks < 8; ++ks) { const s16x4 lo = trrd(rb + ks * 16 * TP), hi = trrd(rb + ks * 16 * TP + 4 * TP);
            const bf16x8 bfr = __builtin_shufflevector(lo, hi, 0, 1, 2, 3, 4, 5, 6, 7);
            acc = __builtin_amdgcn_mfma_f32_32x32x16_bf16(af[ks], bfr, acc, 0, 0, 0); }
        LAS bf16_t* yt = (LAS bf16_t*)(lds + 49152);
#pragma unroll
        for (int i = 0; i < 8; ++i) { const int k1 = 16 * kb + crow(i, h); const float re = acc[i], im = acc[i + 8]; const int col = 32 * nt + l31;
            if (k1 != 0) { float sn, cs; sincospif((float)(s2 * k1) * (1.f / 4096.f), &sn, &cs);
                yt[(2 * k1) * 64 + col] = (bf16_t)f2bf(cs * re - sn * im); yt[(2 * k1 + 1) * 64 + col] = (bf16_t)f2bf(sn * re + cs * im); }
            else { float sn, cs; sincospif((float)s2 * (1.f / 64.f), &sn, &cs);
                yt[col] = (bf16_t)f2bf(re); yt[64 + col] = (bf16_t)0; yt[128 * 64 + col] = (bf16_t)f2bf(cs * im); yt[129 * 64 + col] = (bf16_t)f2bf(sn * im); } }
        __syncthreads();
#pragma unroll
        for (int z = 0; z < 3; ++z) { const int ci = tid + 512 * z; if (ci < 130 * 8) { const int row = ci >> 3, ch = ci & 7, k1 = row < 128 ? (row >> 1) : 64, ri = row < 128 ? (row & 1) : (row - 128);
            *(u32x4*)(Y + ((size_t)((b * 128 + k1) * 2 + ri) * 64 + s2) * 512 + dc * 64 + ch * 8) = *(LAS const u32x4*)(yt + row * 64 + ch * 8); } }
        __syncthreads();
    }
}
__device__ __forceinline__ void dft2_phase(const Args& a, LAS unsigned char* lds, int tid, int lane, int wave) {
    asm volatile("" : "+v"(tid), "+v"(lane));
    const bf16_t* Y = (const bf16_t*)(a.ws + WS_XB); const bf16_t* Gb = (const bf16_t*)(a.ws + WS_G); bf16_t* ym = (bf16_t*)(a.ws + WS_Z); const bf16_t* GmT = (const bf16_t*)(a.ws + WS_GMT);
    const int h = lane >> 5, l31 = lane & 31, ksub = wave >> 2, mh = (wave >> 1) & 1, nt = wave & 1;
    bf16x8 af[2][8];
#pragma unroll
    for (int z = 0; z < 2; ++z) { const int m = 64 * mh + 32 * z + l31, k2 = m & 63, imrow = m >> 6;
#pragma unroll
      for (int ks = 0; ks < 8; ++ks) { unsigned pw[4];
#pragma unroll
        for (int jj = 0; jj < 4; ++jj) { float vv[2];
#pragma unroll
            for (int e = 0; e < 2; ++e) { const int kk = 16 * ks + 8 * h + 2 * jj + e, ri = kk >> 6, s2 = kk & 63; float sn, cs; sincospif((float)((s2 * k2) & 63) * (1.f / 32.f), &sn, &cs);
                vv[e] = (imrow == 0 ? (ri == 0 ? cs : -sn) : (ri == 0 ? sn : cs)) * 0.125f; }
            pw[jj] = pk2(vv[0], vv[1]); }
        u32x4 t; t.x = pw[0]; t.y = pw[1]; t.z = pw[2]; t.w = pw[3]; af[z][ks] = __builtin_bit_cast(bf16x8, t); } }
    const int q = (lane & 15) >> 2, p = lane & 3, blk = (lane >> 4) & 1;
    LAS const unsigned char* rb = lds + (ksub * 128 + 8 * h + q) * TP + 32 * blk + 8 * p + nt * 64;
    LAS unsigned char* tt = lds + 49152;
    LAS float* ot = (LAS float*)(lds + 83968);
    const int mt2 = wave >> 1, nt2 = wave & 1;
    u32x4 ld[4];
#define DFT2_ISSUE(uu) do { const int dc_ = (uu) & 7, k1p_ = ((uu) >> 3) & 63, b_ = (uu) >> 9; \
        if (k1p_ == 0) { _Pragma("unroll") for (int z_ = 0; z_ < 2; ++z_) { const int ci_ = tid + 512 * z_; const size_t o_ = (size_t)(ci_ >> 3) * 512 + dc_ * 64 + (ci_ & 7) * 8; \
                ld[z_] = __builtin_nontemporal_load((const u32x4*)(Y + ((size_t)(b_ * 128) * 128) * 512 + o_)); ld[2 + z_] = __builtin_nontemporal_load((const u32x4*)(Y + ((size_t)(b_ * 128 + 64) * 128) * 512 + o_)); } } \
        else { const bf16_t* src_ = Y + ((size_t)(b_ * 128 + k1p_) * 128 + (tid >> 3)) * 512 + dc_ * 64 + (tid & 7) * 8; ld[0] = __builtin_nontemporal_load((const u32x4*)src_); ld[1] = __builtin_nontemporal_load((const u32x4*)(src_ + (size_t)64 * 512)); } } while (0)
    if ((int)blockIdx.x < 4096) DFT2_ISSUE((int)blockIdx.x);
    for (int u = blockIdx.x; u < 4096; u += gridDim.x) {
        const int dc = u & 7, k1p = (u >> 3) & 63, b = u >> 9;
        bf16x8 gf[8];
#pragma unroll
        for (int ks = 0; ks < 8; ++ks) gf[ks] = *(const bf16x8*)(GmT + (size_t)(dc * 64 + 32 * nt2 + l31) * 128 + 16 * ks + 8 * h);
        const int k1a = k1p, k1b = k1p == 0 ? 64 : 128 - k1p;
        const int tr_e = tid >> 2, qt_e = tid & 3; const size_t tok_e = (size_t)b * SEQ + ((tr_e >> 6) ? k1b : k1a) + 128 * (tr_e & 63);
        const u32x4 g0 = __builtin_nontemporal_load((const u32x4*)(Gb + tok_e * 1024 + dc * 64 + qt_e * 16)), g1 = __builtin_nontemporal_load((const u32x4*)(Gb + tok_e * 1024 + dc * 64 + qt_e * 16 + 8));
        if (k1p == 0) {
#pragma unroll
            for (int z = 0; z < 2; ++z) { const int ci = tid + 512 * z, row = ci >> 3, ch = ci & 7; *(LAS u32x4*)(lds + row * TP + ch * 16) = ld[z]; *(LAS u32x4*)(lds + (128 + row) * TP + ch * 16) = ld[2 + z]; }
        } else {
            const int s2 = tid >> 3, ch = tid & 7;
            const u32x4 yr = ld[0], yi = ld[1];
            float sn, cs; sincospif((float)s2 * (1.f / 32.f), &sn, &cs);
            u32x4 zr, zi;
#pragma unroll
            for (int e = 0; e < 4; ++e) { const float rl = bflo(yr[e]), rh = bfhi(yr[e]), il = bflo(yi[e]), ih = bfhi(yi[e]);
                zr[e] = pk2(rl * cs + il * sn, rh * cs + ih * sn); zi[e] = pk2(rl * sn - il * cs, rh * sn - ih * cs); }
            *(LAS u32x4*)(lds + s2 * TP + ch * 16) = yr; *(LAS u32x4*)(lds + (64 + s2) * TP + ch * 16) = yi;
            *(LAS u32x4*)(lds + (128 + s2) * TP + ch * 16) = zr; *(LAS u32x4*)(lds + (192 + s2) * TP + ch * 16) = zi;
        }
        __syncthreads();
        if (u + (int)gridDim.x < 4096) DFT2_ISSUE(u + (int)gridDim.x);
        f32x16 acc[2]; acc[0] = f32x16{}; acc[1] = f32x16{};
#pragma unroll
        for (int ks = 0; ks < 8; ++ks) { const s16x4 lo = trrd(rb + ks * 16 * TP), hi = trrd(rb + ks * 16 * TP + 4 * TP);
            const bf16x8 bfr = __builtin_shufflevector(lo, hi, 0, 1, 2, 3, 4, 5, 6, 7);
            acc[0] = __builtin_amdgcn_mfma_f32_32x32x16_bf16(af[0][ks], bfr, acc[0], 0, 0, 0);
            acc[1] = __builtin_amdgcn_mfma_f32_32x32x16_bf16(af[1][ks], bfr, acc[1], 0, 0, 0); }
#pragma unroll
        for (int z = 0; z < 2; ++z)
#pragma unroll
            for (int i = 0; i < 16; ++i) *(LAS bf16_t*)(tt + (ksub * 64 + 32 * z + crow(i, h)) * TTP + (mh * 64 + 32 * nt + l31) * 2) = (bf16_t)f2bf(acc[z][i]);
        __syncthreads();
        f32x16 o2 = f32x16{};
#pragma unroll
        for (int ks = 0; ks < 8; ++ks) { const bf16x8 tf = *(LAS const bf16x8*)(tt + (32 * mt2 + l31) * TTP + (16 * ks + 8 * h) * 2);
            o2 = __builtin_amdgcn_mfma_f32_32x32x16_bf16(tf, gf[ks], o2, 0, 0, 0); }
#pragma unroll
        for (int i = 0; i < 16; ++i) ot[(32 * mt2 + crow(i, h)) * 64 + 32 * nt2 + l31] = o2[i];
        __syncthreads();
        {
            const int tr = tid >> 2, qt = tid & 3, ks2 = tr >> 6, k2 = tr & 63;
            const size_t tok = (size_t)b * SEQ + (ks2 ? k1b : k1a) + 128 * k2;
            const LAS f32x4* op = (const LAS f32x4*)(ot + tr * 64 + qt * 16);
            const f32x4 v0 = op[0], v1 = op[1], v2 = op[2], v3 = op[3];
            u32x4 w0, w1;
            w0.x = pk2(v0.x * bflo(g0.x), v0.y * bfhi(g0.x)); w0.y = pk2(v0.z * bflo(g0.y), v0.w * bfhi(g0.y)); w0.z = pk2(v1.x * bflo(g0.z), v1.y * bfhi(g0.z)); w0.w = pk2(v1.z * bflo(g0.w), v1.w * bfhi(g0.w));
            w1.x = pk2(v2.x * bflo(g1.x), v2.y * bfhi(g1.x)); w1.y = pk2(v2.z * bflo(g1.y), v2.w * bfhi(g1.y)); w1.z = pk2(v3.x * bflo(g1.z), v3.y * bfhi(g1.z)); w1.w = pk2(v3.z * bflo(g1.w), v3.w * bfhi(g1.w));
            *(u32x4*)(ym + tok * 1024 + dc * 64 + qt * 16) = w0; *(u32x4*)(ym + tok * 1024 + dc * 64 + qt * 16 + 8) = w1;
        }
        __syncthreads();
    }
}

constexpr int KP = 144, VP = 192, KROWS = 384, LDS_VOFF = KROWS * KP;
struct AUnit { int b, hd, dil, L, r, i0; };
__device__ __forceinline__ AUnit attn_decode(int u, int hd0, int nh) {
    AUnit w; const int blk32 = u & 31; w.hd = hd0 + (u >> 5) % nh; w.b = u / (32 * nh);
    const int dsh = 2 * (w.hd >> 3), nbr = 32 >> dsh; w.dil = 1 << dsh; w.L = SEQ >> dsh; w.r = blk32 / nbr; w.i0 = (blk32 % nbr) * 256; return w;
}
__device__ __forceinline__ void attn_issue(const AUnit& w, const bf16_t* Qb, const bf16_t* Kb, const bf16_t* Vb, int tid, int wave, int lane, u32x4 (&kv)[6], u32x4 (&vv)[6]) {
    const int ch = tid & 7;
#pragma unroll
    for (int i = 0; i < 6; ++i) { const int row = (tid + 512 * i) >> 3; int pk = w.i0 - 64 + row; pk = pk < 0 ? 0 : (pk >= w.L ? w.L - 1 : pk);
        const size_t off = ((size_t)(w.b * 24 + w.hd) * SEQ + (size_t)(w.r * w.L + pk)) * 64 + ch * 8; kv[i] = *(const u32x4*)(Kb + off); vv[i] = *(const u32x4*)(Vb + off); }
}
__device__ __forceinline__ float attn_tile_exp(f32x16& st, int j, float tlf, float bsl, float rlo, float rhi) {
    float sum = 0.f;
#pragma unroll
    for (int i = 0; i < 16; ++i) { const float tmp = (float)(32 * j - 64 + (i & 3) + 8 * (i >> 2)) + tlf;
        float arg = __builtin_fmaf(-bsl, __builtin_fabsf(tmp), st[i]);
        arg = (tmp >= rlo && tmp <= rhi) ? arg : -1.0e30f;
        const float pe = __builtin_amdgcn_exp2f(arg); st[i] = pe; sum += pe; }
    return sum;
}
template <bool FUSED> __device__ __forceinline__ void attn_phase(const Args& a, LAS unsigned char* lds, int tid, int lane, int wave) {
    constexpr int HD0 = FUSED ? 0 : 8, NH = FUSED ? 8 : 16, NU = 8 * NH * 32;
    asm volatile("" : "+v"(tid), "+v"(lane));
    bf16_t* Qb = (bf16_t*)(a.ws + WS_Q); const bf16_t* Kb = (const bf16_t*)(a.ws + WS_K); const bf16_t* Vb = (const bf16_t*)(a.ws + WS_V); float* LSE = (float*)(a.ws + WS_LSE);
    const int h = lane >> 5, l31 = lane & 31;
    const int q = (lane & 15) >> 2, p = lane & 3, blk = (lane >> 4) & 1;
    int u = blockIdx.x;
    u32x4 kv[6], vv[6], qv[4];
#define ATTN_QLOAD(W) do { const bf16_t* qr_ = Qb + ((size_t)((W).b * 24 + (W).hd) * SEQ + (size_t)((W).r * (W).L + (W).i0 + 32 * wave + l31)) * 64; \
        _Pragma("unroll") for (int ks_ = 0; ks_ < 4; ++ks_) qv[ks_] = *(const u32x4*)(qr_ + 16 * ks_ + 8 * h); } while (0)
    if (u < NU) { const AUnit w0 = attn_decode(u, HD0, NH); attn_issue(w0, Qb, Kb, Vb, tid, wave, lane, kv, vv); ATTN_QLOAD(w0); }
    while (u < NU) {
        const AUnit w = attn_decode(u, HD0, NH);
        const int hd = w.hd, slot = hd & 7, L = w.L, i0 = w.i0;
        const int iq = i0 + 32 * wave + l31; const size_t tq = (size_t)w.b * SEQ + (size_t)iq * w.dil + w.r;
        bf16_t* qrow = Qb + ((size_t)(w.b * 24 + hd) * SEQ + (size_t)(w.r * L + iq)) * 64;
        {
            const int ch = tid & 7;
            const f32x4 g0 = *(const f32x4*)(a.kw + hd * 64 + ch * 8), g1 = *(const f32x4*)(a.kw + hd * 64 + ch * 8 + 4);
#pragma unroll
            for (int i = 0; i < 6; ++i) { const int row = (tid + 512 * i) >> 3;
                const float e0 = bflo(kv[i].x), e1 = bfhi(kv[i].x), e2 = bflo(kv[i].y), e3 = bfhi(kv[i].y), e4 = bflo(kv[i].z), e5 = bfhi(kv[i].z), e6 = bflo(kv[i].w), e7 = bfhi(kv[i].w);
                float ss = (e0 * e0 + e1 * e1) + (e2 * e2 + e3 * e3) + (e4 * e4 + e5 * e5) + (e6 * e6 + e7 * e7);
                ss += dpp_movf<0xB1>(ss); ss += dpp_movf<0x4E>(ss); ss += dpp_movf<0x141>(ss);
                const float rk = __builtin_amdgcn_rsqf(ss * (1.f / 64.f) + 1e-6f);
                u32x4 wv; wv.x = pk2(e0 * rk * g0.x, e1 * rk * g0.y); wv.y = pk2(e2 * rk * g0.z, e3 * rk * g0.w); wv.z = pk2(e4 * rk * g1.x, e5 * rk * g1.y); wv.w = pk2(e6 * rk * g1.z, e7 * rk * g1.w);
                *(LAS u32x4*)(lds + row * KP + ch * 16) = wv;
                *(LAS u32x4*)(lds + LDS_VOFF + row * VP + ch * 16) = vv[i];
                if (i & 1) __builtin_amdgcn_sched_barrier(0); }
        }
        bf16x8 qf[4];
        {
            float ss = 0.f;
#pragma unroll
            for (int ks = 0; ks < 4; ++ks)
#pragma unroll
                for (int e = 0; e < 4; ++e) { const float lo = bflo(qv[ks][e]), hi = bfhi(qv[ks][e]); ss += lo * lo + hi * hi; }
            ss += __shfl_xor(ss, 32);
            const float rq = 0.125f * LOG2E * __builtin_amdgcn_rsqf(ss * (1.f / 64.f) + 1e-6f);
#pragma unroll
            for (int ks = 0; ks < 4; ++ks) { const f32x4 g0 = *(const f32x4*)(a.qw + hd * 64 + 16 * ks + 8 * h), g1 = *(const f32x4*)(a.qw + hd * 64 + 16 * ks + 8 * h + 4); u32x4 wv;
                wv.x = pk2(bflo(qv[ks].x) * rq * g0.x, bfhi(qv[ks].x) * rq * g0.y); wv.y = pk2(bflo(qv[ks].y) * rq * g0.z, bfhi(qv[ks].y) * rq * g0.w);
                wv.z = pk2(bflo(qv[ks].z) * rq * g1.x, bfhi(qv[ks].z) * rq * g1.y); wv.w = pk2(bflo(qv[ks].w) * rq * g1.z, bfhi(qv[ks].w) * rq * g1.w);
                qf[ks] = __builtin_bit_cast(bf16x8, wv); }
        }
        const float mb = ((const float*)(a.ws + WS_RS))[hd];
        __syncthreads();
        const int un = u + gridDim.x;
        if (un < NU) { const AUnit wn = attn_decode(un, HD0, NH); attn_issue(wn, Qb, Kb, Vb, tid, wave, lane, kv, vv); }
        const float bsl = __builtin_amdgcn_exp2f(-(float)(slot + 1)) * (float)w.dil * LOG2E;
        int tl = 4 * h - l31; asm volatile("" : "+v"(tl));
        const float tlf = (float)tl;
        const int lo_i = -iq > -64 ? -iq : -64, hi_i = (L - 1 - iq) < 64 ? (L - 1 - iq) : 64;
        const float rlo = (float)lo_i, rhi = (float)hi_i;
        const int wq0 = i0 + 32 * wave;
        const bool edge = (wq0 < 64) || (wq0 + 32 > L - 64);
        float sum = 0.f;
        f32x16 o[2]; o[0] = f32x16{}; o[1] = f32x16{};
#pragma unroll
        for (int j = 0; j < 5; ++j) {
            f32x16 st;
#pragma unroll
            for (int i = 0; i < 16; ++i) st[i] = -mb;
            LAS const unsigned char* kp = lds + (32 * wave + 32 * j + l31) * KP + 16 * h;
#pragma unroll
            for (int ks = 0; ks < 4; ++ks) { const bf16x8 kf = *(LAS const bf16x8*)(kp + 32 * ks); st = __builtin_amdgcn_mfma_f32_32x32x16_bf16(kf, qf[ks], st, 0, 0, 0); }
            sum += attn_tile_exp(st, j, tlf, bsl, rlo, rhi);
#pragma unroll
            for (int s2 = 0; s2 < 2; ++s2) { u32x4 pw; pw.x = pk2(st[8 * s2 + 0], st[8 * s2 + 1]); pw.y = pk2(st[8 * s2 + 2], st[8 * s2 + 3]); pw.z = pk2(st[8 * s2 + 4], st[8 * s2 + 5]); pw.w = pk2(st[8 * s2 + 6], st[8 * s2 + 7]);
                const bf16x8 pf = __builtin_bit_cast(bf16x8, pw);
                LAS const unsigned char* vp = lds + LDS_VOFF + (32 * wave + 32 * j + 16 * s2 + 4 * h + q) * VP + 32 * blk + 8 * p;
#pragma unroll
                for (int dt = 0; dt < 2; ++dt) { const s16x4 lo = trrd(vp + dt * 64), hi = trrd(vp + 8 * VP + dt * 64);
                    const bf16x8 vf = __builtin_shufflevector(lo, hi, 0, 1, 2, 3, 4, 5, 6, 7);
                    o[dt] = __builtin_amdgcn_mfma_f32_32x32x16_bf16(vf, pf, o[dt], 0, 0, 0); } }
            __builtin_amdgcn_sched_barrier(0);
        }
        sum += __shfl_xor(sum, 32);
        if (un < NU) { const AUnit wq = attn_decode(un, HD0, NH); ATTN_QLOAD(wq); }
        const float inv = __builtin_amdgcn_rcpf(sum);
        {
            LAS unsigned char* ost = lds + 129024 + wave * 4096;
#pragma unroll
            for (int dt = 0; dt < 2; ++dt)
#pragma unroll
                for (int ig = 0; ig < 4; ++ig) { u32x2 wv; wv.x = pk2(o[dt][4 * ig] * inv, o[dt][4 * ig + 1] * inv); wv.y = pk2(o[dt][4 * ig + 2] * inv, o[dt][4 * ig + 3] * inv);
                    const int p8 = 8 * dt + 2 * ig + h; *(LAS u32x2*)(ost + l31 * 128 + 8 * (p8 ^ (l31 & 15))) = wv; }
            if constexpr (FUSED) { if (h == 0) ((LAS float*)(lds + 161808))[wave * 32 + l31] = mb + __builtin_amdgcn_logf(sum); }
            asm volatile("s_waitcnt lgkmcnt(0)" ::: "memory");
            if constexpr (!FUSED) {
                bf16_t* obase = qrow - l31 * 64;
#pragma unroll
                for (int it = 0; it < 4; ++it) { const int r = 8 * it + (lane >> 3), c16 = lane & 7;
                    u32x4 v = *(LAS const u32x4*)(ost + r * 128 + 16 * (c16 ^ ((r & 15) >> 1)));
                    if (r & 1) { const unsigned t0 = v.x, t1 = v.y; v.x = v.z; v.y = v.w; v.z = t0; v.w = t1; }
                    *(u32x4*)(obase + (size_t)r * 64 + c16 * 8) = v; asm volatile("" ::: "memory"); }
            } else {
                const bf16_t* Gb = (const bf16_t*)(a.ws + WS_G); bf16_t* ym = (bf16_t*)(a.ws + WS_Z);
#pragma unroll
                for (int it = 0; it < 4; ++it) { const int r = 8 * it + (lane >> 3), c16 = lane & 7;
                    u32x4 v = *(LAS const u32x4*)(ost + r * 128 + 16 * (c16 ^ ((r & 15) >> 1)));
                    if (r & 1) { const unsigned t0 = v.x, t1 = v.y; v.x = v.z; v.y = v.w; v.z = t0; v.w = t1; }
                    const int t = i0 + 32 * wave + r; const size_t tokg = (size_t)w.b * SEQ + t;
                    const float l0 = ((LAS const float*)(lds + 161808))[wave * 32 + r], l1 = LSE[tokg * 24 + 8 + slot], l2 = LSE[tokg * 24 + 16 + slot];
                    const u32x4 o1 = __builtin_nontemporal_load((const u32x4*)(Qb + ((size_t)(w.b * 24 + 8 + slot) * SEQ + (t & 3) * 2048 + (t >> 2)) * 64 + c16 * 8));
                    const u32x4 o2 = __builtin_nontemporal_load((const u32x4*)(Qb + ((size_t)(w.b * 24 + 16 + slot) * SEQ + (t & 15) * 512 + (t >> 4)) * 64 + c16 * 8));
                    const u32x4 g = __builtin_nontemporal_load((const u32x4*)(Gb + tokg * 1024 + 512 + slot * 64 + c16 * 8));
                    const float mxl = fmaxf(l0, fmaxf(l1, l2));
                    float w0 = __builtin_amdgcn_exp2f(l0 - mxl), w1 = __builtin_amdgcn_exp2f(l1 - mxl), w2 = __builtin_amdgcn_exp2f(l2 - mxl);
                    const float iw = 1.0f / (w0 + w1 + w2); w0 *= iw; w1 *= iw; w2 *= iw;
                    u32x4 ov;
#pragma unroll
                    for (int e = 0; e < 4; ++e) { const float lo = (bflo(v[e]) * w0 + bflo(o1[e]) * w1 + bflo(o2[e]) * w2) * bflo(g[e]); const float hi = (bfhi(v[e]) * w0 + bfhi(o1[e]) * w1 + bfhi(o2[e]) * w2) * bfhi(g[e]); ov[e] = pk2(lo, hi); }
                    *(u32x4*)(ym + tokg * 1024 + 512 + slot * 64 + c16 * 8) = ov; asm volatile("" ::: "memory"); }
            }
        }
        if constexpr (!FUSED) { if (h == 0) LSE[tq * 24 + hd] = mb + __builtin_amdgcn_logf(sum); }
        __syncthreads();
        u = un;
    }
}
__device__ __forceinline__ void merge_phase(const Args& a, int lane, int wave) {
    asm volatile("" : "+v"(lane));
    const bf16_t* Ob = (const bf16_t*)(a.ws + WS_Q); const bf16_t* Gb = (const bf16_t*)(a.ws + WS_G); const float* LSE = (const float*)(a.ws + WS_LSE); bf16_t* ym = (bf16_t*)(a.ws + WS_Z);
    const int gw = blockIdx.x * 8 + wave, NGW = gridDim.x * 8, slot = lane >> 3;
    for (int tok0 = gw; tok0 < MTOK; tok0 += 2 * NGW) {
        u32x4 o0[2], o1[2], o2[2], g[2]; float l0[2], l1[2], l2[2];
#pragma unroll
        for (int z = 0; z < 2; ++z) { int tok = tok0 + z * NGW; tok = tok < MTOK ? tok : tok0;
            l0[z] = LSE[(size_t)tok * 24 + slot]; l1[z] = LSE[(size_t)tok * 24 + 8 + slot]; l2[z] = LSE[(size_t)tok * 24 + 16 + slot];
            const int b = tok >> 13, t = tok & (SEQ - 1), part = lane & 7;
            o0[z] = __builtin_nontemporal_load((const u32x4*)(Ob + ((size_t)(b * 24 + slot) * SEQ + t) * 64 + part * 8));
            o1[z] = __builtin_nontemporal_load((const u32x4*)(Ob + ((size_t)(b * 24 + 8 + slot) * SEQ + (t & 3) * 2048 + (t >> 2)) * 64 + part * 8));
            o2[z] = __builtin_nontemporal_load((const u32x4*)(Ob + ((size_t)(b * 24 + 16 + slot) * SEQ + (t & 15) * 512 + (t >> 4)) * 64 + part * 8));
            g[z] = __builtin_nontemporal_load((const u32x4*)(Gb + (size_t)tok * 1024 + 512 + lane * 8)); }
#pragma unroll
        for (int z = 0; z < 2; ++z) { const int tok = tok0 + z * NGW; if (tok >= MTOK) break;
            const float mx = fmaxf(l0[z], fmaxf(l1[z], l2[z]));
            float w0 = __builtin_amdgcn_exp2f(l0[z] - mx), w1 = __builtin_amdgcn_exp2f(l1[z] - mx), w2 = __builtin_amdgcn_exp2f(l2[z] - mx);
            const float inv = 1.0f / (w0 + w1 + w2); w0 *= inv; w1 *= inv; w2 *= inv;
            u32x4 w;
#pragma unroll
            for (int e = 0; e < 4; ++e) { const float lo = (bflo(o0[z][e]) * w0 + bflo(o1[z][e]) * w1 + bflo(o2[z][e]) * w2) * bflo(g[z][e]); const float hi = (bfhi(o0[z][e]) * w0 + bfhi(o1[z][e]) * w1 + bfhi(o2[z][e]) * w2) * bfhi(g[z][e]); w[e] = pk2(lo, hi); }
            *(u32x4*)(ym + (size_t)tok * 1024 + 512 + lane * 8) = w; }
    }
}

#define XB_TMO      128
#define XB_XCNT(j)  (256  + 64 * (j))
#define XB_XSUB(j)  (1280 + 64 * (j))
#define XB_XGEN(j)  (2304 + 64 * (j))
#define XB_TOP      3328
#define XB_TOPGEN   3392
#define XCD_BAR_WORDS 3456
#define XB_SPIN_CAP (1u << 18)

__device__ __forceinline__ unsigned xb_ld(unsigned* p)              { return __hip_atomic_load(p, __ATOMIC_RELAXED, __HIP_MEMORY_SCOPE_AGENT); }
__device__ __forceinline__ unsigned xb_add(unsigned* p, unsigned v) { return __hip_atomic_fetch_add(p, v, __ATOMIC_RELAXED, __HIP_MEMORY_SCOPE_AGENT); }
__device__ __forceinline__ unsigned xb_xcc_id() { return (unsigned)__builtin_amdgcn_s_getreg((3 << 11) | 20) & 0xFu; }
#define XB_SPIN(cond, bar) do { unsigned _sp = 0; while (cond) { __builtin_amdgcn_s_sleep(1); \
    if ((++_sp & 255u) == 0u) { if (xb_ld(&(bar)[XB_TMO])) break; if (_sp > XB_SPIN_CAP) { atomicAdd(&(bar)[XB_TMO], 1u); break; } } } } while (0)

struct XcdBarrier {
    unsigned* bar; unsigned x;
    volatile LAS unsigned* st;
};

__device__ __forceinline__ XcdBarrier xcd_barrier_post(unsigned* bar, volatile LAS unsigned* st) {
    XcdBarrier b; b.bar = bar; b.x = xb_xcc_id(); b.st = st;
    if (threadIdx.x == 0) (void)xb_add(&bar[XB_XCNT(b.x)], 1u);
    return b;
}
__device__ __forceinline__ void xcd_barrier_complete(unsigned* bar, unsigned x, unsigned& nloc, unsigned& nx) {
    const unsigned G = gridDim.x * gridDim.y * gridDim.z;
    unsigned sum, cnt, mine, sp = 0u;
    for (;;) {
        sum = 0u; cnt = 0u; mine = 0u;
#pragma unroll
        for (unsigned j = 0; j < 16; ++j) { const unsigned c = xb_ld(&bar[XB_XCNT(j)]); sum += c; cnt += (c > 0u) ? 1u : 0u; mine = (j == x) ? c : mine; }
        if (sum == G) break;
        __builtin_amdgcn_s_sleep(1);
        if ((++sp & 255u) == 0u) { if (xb_ld(&bar[XB_TMO])) break; if (sp > XB_SPIN_CAP) { atomicAdd(&bar[XB_TMO], 1u); break; } }
    }
    nloc = mine > 0u ? mine : 1u; nx = cnt > 0u ? cnt : 1u;
}

__device__ __forceinline__ void xcd_barrier(const XcdBarrier& b) {
    asm volatile("s_waitcnt vmcnt(0)" ::: "memory");
    __syncthreads();
    if (threadIdx.x == 0) {
        unsigned* bar = b.bar;
        __builtin_amdgcn_s_waitcnt(0);
        unsigned nloc = b.st[0], nx = b.st[1];
        if (nloc == 0u) { xcd_barrier_complete(bar, b.x, nloc, nx); b.st[0] = nloc; b.st[1] = nx; }
        const unsigned old = xb_add(&bar[XB_XSUB(b.x)], 1u);
        const unsigned gen = old / nloc;
        if (old + 1u == (gen + 1u) * nloc) {
            __builtin_amdgcn_fence(__ATOMIC_RELEASE, "agent");
            asm volatile("s_waitcnt vmcnt(0)" ::: "memory");
            const unsigned og = xb_add(&bar[XB_TOP], 1u);
            const unsigned tg = og / nx;
            if (og + 1u == (tg + 1u) * nx) xb_add(&bar[XB_TOPGEN], 1u);
            else XB_SPIN(xb_ld(&bar[XB_TOPGEN]) == tg, bar);
            __builtin_amdgcn_fence(__ATOMIC_ACQUIRE, "agent");
            xb_add(&bar[XB_XGEN(b.x)], 1u);
            asm volatile("s_waitcnt vmcnt(0)" ::: "memory");
        } else {
            XB_SPIN(xb_ld(&bar[XB_XGEN(b.x)]) == gen, bar);
            __builtin_amdgcn_fence(__ATOMIC_ACQUIRE, "agent");
            asm volatile("s_waitcnt vmcnt(0)" ::: "memory");
        }
    }
    __syncthreads();
}

__global__ void __launch_bounds__(512, 2) mega_fwd(Args a) {
    extern __shared__ __attribute__((aligned(16))) unsigned char lds_raw[];
    LAS unsigned char* lds = (LAS unsigned char*)lds_raw;
    cg::grid_group grid = cg::this_grid();
    const int tid = threadIdx.x, lane = tid & 63, wave = __builtin_amdgcn_readfirstlane(tid >> 6);
    volatile LAS unsigned* bst = (volatile LAS unsigned*)(lds + 161792);
    if (tid < 2) bst[tid] = 0u;
    __syncthreads();
    XcdBarrier bar = xcd_barrier_post((unsigned*)(a.ws + WS_BAR), bst);
    if (a.ws == nullptr) grid.sync();
#ifndef REP0
#define REP0 1
#define REP1 1
#define REPD1 1
#define REPD2 1
#define REPM 1
#define REP4 1
#endif
    for (int rep = 0; rep < REP0; ++rep) phase0(a, lds, tid, lane, wave);
    xcd_barrier(bar);
    {
        pg8::Gemm g{(const pg8::bf16_t*)(a.ws + WS_XB), (const pg8::bf16_t*)(a.ws + WS_WT), MTOK, NIN, DM}; pg8::StaticOrder S; S.init(MTOK, NIN, gridDim.x, (int)blockIdx.x, REP1);
        Epi1 E{(bf16_t*)(a.ws + WS_Z), (bf16_t*)(a.ws + WS_G), (bf16_t*)(a.ws + WS_Q), (bf16_t*)(a.ws + WS_K), (bf16_t*)(a.ws + WS_V)};
        pg8::gemm_phase<Epi1, pg8::StaticOrder, true, true>(lds, g, S, E);
    }
    xcd_barrier(bar);
    attn_phase<false>(a, lds, tid, lane, wave);
    for (int rep = 0; rep < REPD1; ++rep) dft1_phase(a, lds, tid, lane, wave);
    xcd_barrier(bar);
    attn_phase<true>(a, lds, tid, lane, wave);
    for (int rep = 0; rep < REPD2; ++rep) dft2_phase(a, lds, tid, lane, wave);
    xcd_barrier(bar);
    {
        pg8::Gemm g{(const pg8::bf16_t*)(a.ws + WS_Z), (const pg8::bf16_t*)(a.ws + WS_WOT), MTOK, DM, DM}; pg8::StaticOrder S; S.init(MTOK, DM, gridDim.x, (int)blockIdx.x, REP4);
        Epi2 E{a.x, a.out};
        pg8::gemm_phase<Epi2, pg8::StaticOrder, true, true>(lds, g, S, E);
    }
}

extern "C" void kernel_launch(void* const* d_in, const int* in_sizes, int n_in, void* d_out, int out_size, void* d_ws, size_t ws_size, hipStream_t stream) {
    static int grid = 0;
    if (grid == 0) {
        if (n_in != 7 || in_sizes[0] != MTOK * DM || out_size != MTOK * DM || ws_size < WS_END) { fprintf(stderr, "kernel_launch: unexpected shapes / workspace (%d inputs, ws %zu)\n", n_in, ws_size); grid = -1; return; }
        int dev = 0, cus = 0, per_cu = 0;
        hipGetDevice(&dev); hipDeviceGetAttribute(&cus, hipDeviceAttributeMultiprocessorCount, dev);
        hipFuncSetAttribute((const void*)mega_fwd, hipFuncAttributeMaxDynamicSharedMemorySize, LDS_BYTES);
        hipOccupancyMaxActiveBlocksPerMultiprocessor(&per_cu, (const void*)mega_fwd, 512, LDS_BYTES);
        if (per_cu < 1) { fprintf(stderr, "kernel_launch: occupancy query says %d blocks per CU\n", per_cu); per_cu = 1; }
        grid = cus;
        (void)hipGetLastError();
    }
    if (grid < 0) return;
    Args a{};
    a.x = (const float*)d_in[0]; a.norm_w = (const float*)d_in[1]; a.w_in = (const float*)d_in[2]; a.qw = (const float*)d_in[3]; a.kw = (const float*)d_in[4];
    a.wf = (const float*)d_in[5]; a.w_out = (const float*)d_in[6]; a.out = (float*)d_out; a.ws = (unsigned char*)d_ws;
    if (hipMemsetAsync((char*)d_ws + WS_BAR, 0, 16384, stream) != hipSuccess) { fprintf(stderr, "kernel_launch: memset of the barrier words failed\n"); return; }
    void* args[] = {&a};
    hipError_t e = hipLaunchCooperativeKernel((const void*)mega_fwd, dim3(grid), dim3(512), args, LDS_BYTES, stream);
    if (e != hipSuccess) fprintf(stderr, "cooperative launch failed: %s (grid %d)\n", hipGetErrorString(e), grid);
}
```

```cpp
#include <hip/hip_runtime.h>
#include <hip/hip_cooperative_groups.h>
#include <cstdio>
#include <cstdint>
namespace cg = cooperative_groups;
namespace pg8 {
#define PG8_LAS __attribute__((address_space(3)))
typedef unsigned short bf16_t;
typedef short bf16x8 __attribute__((ext_vector_type(8)));
typedef float f32x4 __attribute__((ext_vector_type(4)));
typedef unsigned u32x4 __attribute__((ext_vector_type(4)));
constexpr int BM = 256, BK = 64, HALF = 128, HTB = HALF * BK * 2  , STAGE_BYTES = 8 * HTB, NXCD = 8, WGM = 8;

__host__ __device__ __forceinline__ int lds_byte(int r, int c) { const int st = (r >> 4) * 2 + (c >> 5), rr = r & 15, cc = c & 31, ob = rr * 64 + cc * 2; return st * 1024 + (ob ^ (((ob >> 9) & 1) << 5)); }
__host__ __device__ __forceinline__ void stage_rc(int b, int& R, int& C) { const int st = b / 1024, sb = b % 1024, swz = sb ^ (((sb >> 9) & 1) << 5); R = (st >> 1) * 16 + swz / 64; C = (st & 1) * 32 + (swz % 64) / 2; }
__host__ __device__ __forceinline__ int perm32(int rho) { const int n = rho >> 4, i = rho & 15; return 8 * (i >> 2) + 4 * n + (i & 3); }

struct Unit { int pm, pn; };
struct Gemm { const bf16_t* A; const bf16_t* Bt; int M, N, K; };

struct StaticOrder {
    int nM, nN, nwg, G, c, rep;
    __host__ __device__ void init(int M, int N, int G_, int c_, int rep_ = 1) { nM = M / BM; nN = N / BM; nwg = nM * nN; G = G_; c = c_; rep = rep_; }
    __host__ __device__ bool next(int i, Unit& u) const {
        const int per = (nwg + G - 1) / G; if (i >= per * rep) return false; const long L = (long)(i % per) * G + c; if (L >= nwg) return false;
        int wgid = (int)L; { const int q = nwg / NXCD, r = nwg % NXCD, xcd = wgid % NXCD, off = wgid / NXCD; wgid = (xcd < r ? xcd * (q + 1) : r * (q + 1) + (xcd - r) * q) + off; }
        const int nig = WGM * nN, gid = wgid / nig, fm = gid * WGM, gsz = (nM - fm) < WGM ? (nM - fm) : WGM;
        u.pm = fm + ((wgid % nig) % gsz); u.pn = (wgid % nig) / gsz; return true;
    }
    __device__ __forceinline__ void a_ready(const Unit&) const {}
    __device__ __forceinline__ void done(const Unit&) const {}
};

__device__ __forceinline__ unsigned cvt_pk_bf16(float lo, float hi) { unsigned r; asm volatile("v_cvt_pk_bf16_f32 %0, %1, %2" : "=v"(r) : "v"(lo), "v"(hi)); return r; }
typedef float f32x2 __attribute__((ext_vector_type(2)));
template <class Epi, class Sched, bool ALIGN_EPI = false, bool SP2 = false>
__device__ __forceinline__ void gemm_phase(PG8_LAS unsigned char* lds, const Gemm g, const Sched& S, const Epi& E) {
    const int tid = threadIdx.x, wid = __builtin_amdgcn_readfirstlane(tid >> 6), lane = tid & 63, wr = wid >> 2, wc = wid & 3, fr = lane & 15, fq = lane >> 4;
    const int K = g.K, nt = K / BK;
    unsigned voffA[2], voffB[2];
#pragma unroll
    for (int i = 0; i < 2; ++i) { int R, C; stage_rc(tid * 16 + i * 8192, R, C); const int Rb = Epi::PERM2 ? (64 * (R >> 5) + perm32(R & 31)) : (Epi::PERM ? ((R & ~31) + perm32(R & 31)) : R);
        voffA[i] = (unsigned)(R * K + C) * 2u; voffB[i] = (unsigned)(Rb * K + C) * 2u; }
    const size_t kstep = (size_t)(BK * 2);
    const size_t hstep = (size_t)HALF * K * 2;
    const size_t hstepB = Epi::PERM2 ? (size_t)32 * K * 2 : hstep;
    const size_t tstep = 2 * hstep;
    const unsigned ldsw = (unsigned)wid * 1024u;
    const int aoff = lds_byte(wr * 64 + fr, fq * 8), boff = lds_byte(wc * 32 + fr, fq * 8);
#define PG8_SA(b, h) (((b) * 2 + (h)) * HTB)
#define PG8_SB(b, h) ((4 + (b) * 2 + (h)) * HTB)
#define PG8_STAGE(bufoff, gbase, voff) do { _Pragma("unroll") for (int _i = 0; _i < 2; ++_i) \
        __builtin_amdgcn_global_load_lds((const unsigned*)((const char*)(gbase) + (voff)[_i]), (PG8_LAS unsigned*)(lds + (bufoff) + ldsw + _i * 8192), 16, 0, 0); } while (0)
#define PG8_LDA(dst, b, h) do { _Pragma("unroll") for (int m = 0; m < 4; ++m) _Pragma("unroll") for (int k = 0; k < 2; ++k) dst[m][k] = *(const PG8_LAS bf16x8*)(lds + PG8_SA(b, h) + aoff + m * 2048 + k * 1024); } while (0)
#define PG8_LDB(dst, b, h) do { _Pragma("unroll") for (int n = 0; n < 2; ++n) _Pragma("unroll") for (int k = 0; k < 2; ++k) dst[n][k] = *(const PG8_LAS bf16x8*)(lds + PG8_SB(b, h) + boff + n * 2048 + k * 1024); } while (0)
#define PG8_MMA(ai, bj, At, Bt) do { __builtin_amdgcn_s_setprio(1); _Pragma("unroll") for (int m = 0; m < 4; ++m) _Pragma("unroll") for (int n = 0; n < 2; ++n) _Pragma("unroll") for (int k = 0; k < 2; ++k) \
        acc[ai][bj][m][n] = __builtin_amdgcn_mfma_f32_16x16x32_bf16(Bt[n][k], At[m][k], acc[ai][bj][m][n], 0, 0, 0); __builtin_amdgcn_s_setprio(0); } while (0)
#define PG8_WAIT_V(n) asm volatile("s_waitcnt vmcnt(" #n ")" ::: "memory")
#define PG8_WAIT_L(n) asm volatile("s_waitcnt lgkmcnt(" #n ")" ::: "memory")
#define PG8_BAR __builtin_amdgcn_s_barrier()
#define PG8_SCHED __builtin_amdgcn_sched_barrier(0)
    Unit cur, nxt; int ui = 0;
    if (!S.next(0, cur)) return;
    f32x4 acc[2][2][4][2];
#pragma unroll
    for (int a = 0; a < 2; ++a)
#pragma unroll
        for (int b = 0; b < 2; ++b)
#pragma unroll
            for (int m = 0; m < 4; ++m)
#pragma unroll
                for (int n = 0; n < 2; ++n) acc[a][b][m][n] = (f32x4){0.f, 0.f, 0.f, 0.f};
    bf16x8 At[4][2], B0[2][2], B1[2][2];
    const char* cA = (const char*)g.A + (size_t)cur.pm * tstep; const char* cB = (const char*)g.Bt + (size_t)cur.pn * tstep;
    S.a_ready(cur);
    if constexpr (SP2) {
        PG8_STAGE(PG8_SB(0, 0), cB, voffB); PG8_STAGE(PG8_SB(0, 1), cB + hstepB, voffB); PG8_STAGE(PG8_SA(0, 0), cA, voffA); PG8_STAGE(PG8_SA(0, 1), cA + hstep, voffA);
        if (wr == 1) PG8_BAR;
        PG8_WAIT_V(2); PG8_BAR;
        PG8_STAGE(PG8_SB(1, 0), cB + kstep, voffB); PG8_STAGE(PG8_SA(1, 0), cA + kstep, voffA); PG8_STAGE(PG8_SB(1, 1), cB + hstepB + kstep, voffB);
        PG8_WAIT_V(6); PG8_BAR;
    } else {
        PG8_STAGE(PG8_SB(0, 0), cB, voffB); PG8_STAGE(PG8_SA(0, 0), cA, voffA); PG8_STAGE(PG8_SB(0, 1), cB + hstepB, voffB); PG8_STAGE(PG8_SA(0, 1), cA + hstep, voffA);
        if (wr == 1) PG8_BAR;
        PG8_WAIT_V(4); PG8_BAR;
        PG8_STAGE(PG8_SB(1, 0), cB + kstep, voffB); PG8_STAGE(PG8_SA(1, 0), cA + kstep, voffA); PG8_STAGE(PG8_SB(1, 1), cB + hstepB + kstep, voffB);
        PG8_WAIT_V(6); PG8_BAR;
    }
    for (;;) {
        const bool has_next = S.next(ui + 1, nxt);
        const char* nA = has_next ? (const char*)g.A + (size_t)nxt.pm * tstep : cA; const char* nB = has_next ? (const char*)g.Bt + (size_t)nxt.pn * tstep : cB;
        for (int t = 0; t < nt; t += 2) {
            const bool last = (t == nt - 2);
            const char* a1 = cA + (size_t)(t + 1) * kstep;
            const char* a2 = last ? nA : cA + (size_t)(t + 2) * kstep; const char* b2 = last ? nB : cB + (size_t)(t + 2) * kstep;
            const char* a3 = a2 + kstep; const char* b3 = b2 + kstep;
            if (last && has_next) S.a_ready(nxt);
            if constexpr (SP2) {
            PG8_LDB(B0, 0, 0); PG8_LDB(B1, 0, 1); PG8_SCHED; PG8_LDA(At, 0, 0); PG8_STAGE(PG8_SA(1, 1), a1 + hstep, voffA);
            PG8_WAIT_V(8); PG8_WAIT_L(0); PG8_BAR; PG8_MMA(0, 0, At, B0); PG8_MMA(0, 1, At, B1); PG8_BAR; PG8_SCHED;
            PG8_LDA(At, 0, 1); PG8_STAGE(PG8_SB(0, 0), b2, voffB); PG8_STAGE(PG8_SB(0, 1), b2 + hstepB, voffB); PG8_STAGE(PG8_SA(0, 0), a2, voffA);
            PG8_WAIT_V(8); PG8_WAIT_L(0); PG8_BAR; PG8_MMA(1, 0, At, B0); PG8_MMA(1, 1, At, B1); PG8_BAR; PG8_SCHED;
            PG8_LDB(B0, 1, 0); PG8_LDB(B1, 1, 1); PG8_SCHED; PG8_LDA(At, 1, 0); PG8_STAGE(PG8_SA(0, 1), a2 + hstep, voffA);
            PG8_WAIT_V(8); PG8_WAIT_L(0); PG8_BAR; PG8_MMA(0, 0, At, B0); PG8_MMA(0, 1, At, B1); PG8_BAR; PG8_SCHED;
            PG8_LDA(At, 1, 1); PG8_STAGE(PG8_SB(1, 0), b3, voffB); PG8_STAGE(PG8_SB(1, 1), b3 + hstepB, voffB); PG8_STAGE(PG8_SA(1, 0), a3, voffA);
            PG8_WAIT_V(8); PG8_WAIT_L(0); PG8_BAR; PG8_MMA(1, 0, At, B0); PG8_MMA(1, 1, At, B1); PG8_BAR; PG8_SCHED;
            } else {
            PG8_LDB(B0, 0, 0); PG8_SCHED; PG8_LDA(At, 0, 0); PG8_STAGE(PG8_SA(1, 1), a1 + hstep, voffA);
            PG8_WAIT_L(8); PG8_BAR; PG8_WAIT_L(0); PG8_MMA(0, 0, At, B0); PG8_BAR; PG8_SCHED;
            PG8_LDB(B1, 0, 1); PG8_STAGE(PG8_SB(0, 0), b2, voffB);
            PG8_BAR; PG8_WAIT_L(0); PG8_MMA(0, 1, At, B1); PG8_BAR;
            PG8_LDA(At, 0, 1); PG8_STAGE(PG8_SA(0, 0), a2, voffA);
            PG8_BAR; PG8_WAIT_L(0); PG8_MMA(1, 0, At, B0); PG8_BAR; PG8_SCHED;
            PG8_STAGE(PG8_SB(0, 1), b2 + hstepB, voffB);
            PG8_WAIT_V(6); PG8_BAR; PG8_MMA(1, 1, At, B1); PG8_BAR;
            PG8_LDB(B0, 1, 0); PG8_SCHED; PG8_LDA(At, 1, 0); PG8_STAGE(PG8_SA(0, 1), a2 + hstep, voffA);
            PG8_WAIT_L(8); PG8_BAR; PG8_WAIT_L(0); PG8_MMA(0, 0, At, B0); PG8_BAR; PG8_SCHED;
            PG8_LDB(B1, 1, 1); PG8_STAGE(PG8_SB(1, 0), b3, voffB);
            PG8_BAR; PG8_WAIT_L(0); PG8_MMA(0, 1, At, B1); PG8_BAR;
            PG8_LDA(At, 1, 1); PG8_STAGE(PG8_SA(1, 0), a3, voffA);
            PG8_BAR; PG8_WAIT_L(0); PG8_MMA(1, 0, At, B0); PG8_BAR; PG8_SCHED;
            PG8_STAGE(PG8_SB(1, 1), b3 + hstepB, voffB);
            PG8_WAIT_V(6); PG8_BAR; PG8_MMA(1, 1, At, B1); PG8_BAR;
            }
        }
        if constexpr (ALIGN_EPI) { if (wr == 0) PG8_BAR; }
        if constexpr (!Epi::AFTER_DRAIN) { E(acc, cur, wr, wc, fr, fq); S.done(cur); }
        if (!has_next) break;
#pragma unroll
        for (int a = 0; a < 2; ++a)
#pragma unroll
            for (int b = 0; b < 2; ++b)
#pragma unroll
                for (int m = 0; m < 4; ++m)
#pragma unroll
                    for (int n = 0; n < 2; ++n) acc[a][b][m][n] = (f32x4){0.f, 0.f, 0.f, 0.f};
        cur = nxt; cA = nA; cB = nB; ++ui;
        if constexpr (ALIGN_EPI) { if (wr == 1) PG8_BAR; }
    }
    PG8_WAIT_V(0);
    if constexpr (!ALIGN_EPI) { if (wr == 0) PG8_BAR; }
    PG8_BAR;
    if constexpr (Epi::AFTER_DRAIN) { E.fused(acc, cur, wr, wc, fr, fq, lds, wid, lane); S.done(cur); }
#undef PG8_SA
#undef PG8_SB
#undef PG8_STAGE
#undef PG8_LDA
#undef PG8_LDB
#undef PG8_MMA
#undef PG8_WAIT_V
#undef PG8_WAIT_L
#undef PG8_BAR
#undef PG8_SCHED
}
}
#define LAS __attribute__((address_space(3)))
typedef unsigned short bf16_t;
typedef short bf16x8 __attribute__((ext_vector_type(8)));
typedef short s16x4 __attribute__((ext_vector_type(4)));
typedef short v4i16_t __attribute__((ext_vector_type(4)));
typedef float f32x4 __attribute__((ext_vector_type(4)));
typedef float f32x16 __attribute__((ext_vector_type(16)));
typedef unsigned u32x4 __attribute__((ext_vector_type(4)));
typedef unsigned u32x2 __attribute__((ext_vector_type(2)));

constexpr int SEQ = 8192, DM = 1024, MTOK = 65536, NIN = 6144, QKVW = 1536;
constexpr size_t WS_WT = 0, WS_WOT = 13631488, WS_RS = 15728640, WS_LSE = 15990784, WS_BAR = 23068672, WS_GMT = 24117248, WS_XB = 33554432, WS_Z = 167772160, WS_G = 301989888,
                 WS_Q = 436207616, WS_K = 637534208, WS_V = 838860800, WS_END = 1040187392;
constexpr int LDS_BYTES = 162944;
constexpr float LOG2E = 1.4426950408889634f;

__device__ __forceinline__ unsigned f2bf(float f) { unsigned u = __builtin_bit_cast(unsigned, f); return (u + 0x7fffu + ((u >> 16) & 1u)) >> 16; }
typedef float f32x2_t __attribute__((ext_vector_type(2))); typedef __bf16 bf16x2_t __attribute__((ext_vector_type(2)));
__device__ __forceinline__ unsigned pk2(float lo, float hi) { f32x2_t v = {lo, hi}; bf16x2_t b = __builtin_convertvector(v, bf16x2_t); return __builtin_bit_cast(unsigned, b); }
__device__ __forceinline__ float bflo(unsigned w) { return __builtin_bit_cast(float, w << 16); }
__device__ __forceinline__ float bfhi(unsigned w) { return __builtin_bit_cast(float, w & 0xffff0000u); }
__device__ __forceinline__ int crow(int r, int hi) { return (r & 3) + 8 * (r >> 2) + 4 * hi; }
__device__ __forceinline__ float wave_sum(float v) {
#pragma unroll
    for (int o = 1; o < 64; o <<= 1) v += __shfl_xor(v, o);
    return v;
}
__device__ __forceinline__ s16x4 trrd(LAS const unsigned char* p) { return __builtin_bit_cast(s16x4, __builtin_amdgcn_ds_read_tr16_b64_v4i16((LAS v4i16_t*)p)); }
__device__ __forceinline__ float silu_f(float v) { return v * __builtin_amdgcn_rcpf(1.f + __builtin_amdgcn_exp2f(-v * LOG2E)); }
#define LDS_WAIT() asm volatile("s_waitcnt lgkmcnt(0)" ::: "memory")
template <int CTRL> __device__ __forceinline__ unsigned dpp_mov(unsigned v) { return (unsigned)__builtin_amdgcn_update_dpp(0, (int)v, CTRL, 0xF, 0xF, true); }
template <int CTRL> __device__ __forceinline__ float dpp_movf(float v) { return __builtin_bit_cast(float, dpp_mov<CTRL>(__builtin_bit_cast(unsigned, v))); }

struct Args { const float *x, *norm_w, *w_in, *qw, *kw, *wf, *w_out; float* out; unsigned char* ws; };

__device__ __forceinline__ void transpose_item(const float* W, int ldw, int ncol0, bf16_t* WT, int row_off, const float* kscale, LAS float* scr, int kb, int nb, int lane) {
    const int k0 = 64 * kb, n0 = 32 * nb;
#pragma unroll 8
    for (int i = 0; i < 32; ++i) { const int kk = 2 * i + (lane >> 5); float v = W[(size_t)(k0 + kk) * ldw + ncol0 + n0 + (lane & 31)]; if (kscale) v *= kscale[k0 + kk]; scr[kk * 33 + (lane & 31)] = v; }
    LDS_WAIT();
    const int c = lane & 7;
#pragma unroll
    for (int j = 0; j < 4; ++j) { const int n = (lane >> 3) + 8 * j; const LAS float* s = scr + (8 * c) * 33 + n;
        u32x4 o; o.x = pk2(s[0 * 33], s[1 * 33]); o.y = pk2(s[2 * 33], s[3 * 33]); o.z = pk2(s[4 * 33], s[5 * 33]); o.w = pk2(s[6 * 33], s[7 * 33]);
        *(u32x4*)(WT + (size_t)(row_off + n0 + n) * 1024 + k0 + 8 * c) = o; }
    LDS_WAIT();
}
__device__ __forceinline__ void gmt_unit(const Args& a, LAS unsigned char* lds, int unit, int tid) {
    bf16_t* GmT = (bf16_t*)(a.ws + WS_GMT);
    LAS float* tab = (LAS float*)lds;
    if (tid < 64) { float sn, cs; sincospif((float)tid * (1.f / 32.f), &sn, &cs); tab[2 * tid] = cs; tab[2 * tid + 1] = sn; }
    __syncthreads();
    const int g = unit >> 2, d = 16 * (unit & 3) + (tid >> 5), c32 = tid & 31;
    float acc[4] = {0.f, 0.f, 0.f, 0.f};
    for (int l = 0; l < 64; ++l) { const float w = a.wf[(size_t)(g * 64 + l) * 64 + d];
#pragma unroll
        for (int e = 0; e < 4; ++e) { const int cc = c32 * 4 + e, c = cc & 63, idx = (l * c) & 63; acc[e] += w * (cc < 64 ? tab[2 * idx] : -tab[2 * idx + 1]); } }
#pragma unroll
    for (int e = 0; e < 4; ++e) GmT[(size_t)(g * 64 + d) * 128 + c32 * 4 + e] = (bf16_t)f2bf(acc[e] * 0.125f);
    __syncthreads();
}
__device__ __forceinline__ void phase0(const Args& a, LAS unsigned char* lds, int tid, int lane, int wave) {
    bf16_t* Wt = (bf16_t*)(a.ws + WS_WT); bf16_t* WoT = (bf16_t*)(a.ws + WS_WOT); bf16_t* xb = (bf16_t*)(a.ws + WS_XB);
    const int G = gridDim.x, bx = blockIdx.x;
    for (int u = bx; u < 32; u += G) gmt_unit(a, lds, u, tid);
    if (bx == G - 1 && wave < 3) {
        for (int hd = wave * 8; hd < wave * 8 + 8; ++hd) {
            float gqm = fabsf(a.qw[hd * 64 + lane]), gkm = fabsf(a.kw[hd * 64 + lane]);
#pragma unroll
            for (int o = 1; o < 64; o <<= 1) { gqm = fmaxf(gqm, __shfl_xor(gqm, o)); gkm = fmaxf(gkm, __shfl_xor(gkm, o)); }
            if (lane == 0) ((float*)(a.ws + WS_RS))[hd] = 8.08f * LOG2E * gqm * gkm;
        }
    }
    LAS float* scr = (LAS float*)(lds + 32768 + wave * 8448);
    const int gw = bx * 8 + wave, NGW = G * 8;
    constexpr int I_IN = 16 * 192, I_OUT = 16 * 32;
    for (int it = gw; it < I_IN + I_OUT; it += NGW) {
        if (it < I_IN) transpose_item(a.w_in, 6144, 0, Wt, 0, a.norm_w, scr, it / 192, it % 192, lane);
        else { const int r = it - I_IN; transpose_item(a.w_out, 1024, 0, WoT, 0, nullptr, scr, r / 32, r % 32, lane); }
    }
    for (int row = gw; row < MTOK; row += 2 * NGW) {
        const int row2 = row + NGW; const bool has2 = row2 < MTOK;
        const f32x4* xr = (const f32x4*)(a.x + (size_t)row * DM) + lane; const f32x4* xr2 = (const f32x4*)(a.x + (size_t)(has2 ? row2 : row) * DM) + lane;
        f32x4 v[4], v2[4]; float s = 0.f, s2 = 0.f;
#pragma unroll
        for (int j = 0; j < 4; ++j) { v[j] = __builtin_nontemporal_load(xr + 64 * j); v2[j] = __builtin_nontemporal_load(xr2 + 64 * j); }
#pragma unroll
        for (int j = 0; j < 4; ++j) { s += (v[j].x * v[j].x + v[j].y * v[j].y) + (v[j].z * v[j].z + v[j].w * v[j].w); s2 += (v2[j].x * v2[j].x + v2[j].y * v2[j].y) + (v2[j].z * v2[j].z + v2[j].w * v2[j].w); }
        s = wave_sum(s); s2 = wave_sum(s2);
        const float r = 1.0f / sqrtf(s * (1.f / DM) + 1e-6f), r2 = 1.0f / sqrtf(s2 * (1.f / DM) + 1e-6f);
        u32x2* o = (u32x2*)(xb + (size_t)row * DM) + lane;
#pragma unroll
        for (int j = 0; j < 4; ++j) { u32x2 w; w.x = pk2(v[j].x * r, v[j].y * r); w.y = pk2(v[j].z * r, v[j].w * r); o[64 * j] = w; }
        if (has2) { u32x2* o2 = (u32x2*)(xb + (size_t)row2 * DM) + lane;
#pragma unroll
            for (int j = 0; j < 4; ++j) { u32x2 w; w.x = pk2(v2[j].x * r2, v2[j].y * r2); w.y = pk2(v2[j].z * r2, v2[j].w * r2); o2[64 * j] = w; } }
    }
}

struct Epi1 {
    static constexpr bool PERM = true, PERM2 = true, AFTER_DRAIN = false;
    bf16_t *Z, *G, *Q, *Kb, *V;
    __device__ __forceinline__ void operator()(const pg8::f32x4 (&acc)[2][2][4][2], const pg8::Unit& u, int wr, int wc, int fr, int fq) const {
        const int pn = u.pn; const int hi8 = (fr >> 3) & 1, fr7 = fr & 7; const int rbase = u.pm * 256 + wr * 64 + fr7;
        const bool qkv = (pn >= 4 && pn < 22);
        const bool act = !qkv && pn >= 2;
        const int ld = pn < 2 ? 512 : 1024;
        bf16_t* base; int dsh = 0; size_t rowstride_tok = 0; int ecol;
        if (qkv) { const int which = (pn - 4) / 6, ct = (pn - 4) % 6; dsh = 2 * (ct >> 1);
            base = Q + (size_t)which * ((WS_K - WS_Q) / 2) + (size_t)(ct * 4 + wc) * SEQ * 64; ecol = 32 * hi8 + 8 * fq; }
        else { const int c0 = pn < 2 ? pn * 256 : (pn < 4 ? (pn - 2) * 256 : 512 + (pn - 22) * 256); base = (pn < 2 ? Z : G) + c0 + wc * 64; ecol = 32 * hi8 + 8 * fq; }
        const int dmask = (1 << dsh) - 1, Lc = SEQ >> dsh;
#pragma unroll
        for (int ai = 0; ai < 2; ++ai)
#pragma unroll
            for (int m = 0; m < 4; ++m) {
                pg8::f32x4 a0 = acc[ai][0][m][0], a1 = acc[ai][0][m][1], b0 = acc[ai][1][m][0], b1 = acc[ai][1][m][1];
                if (act) {
#pragma unroll
                    for (int e = 0; e < 4; ++e) { a0[e] = silu_f(a0[e]); a1[e] = silu_f(a1[e]); b0[e] = silu_f(b0[e]); b1[e] = silu_f(b1[e]); } }
                u32x4 A, B; A.x = pk2(a0[0], a0[1]); A.y = pk2(a0[2], a0[3]); A.z = pk2(a1[0], a1[1]); A.w = pk2(a1[2], a1[3]);
                B.x = pk2(b0[0], b0[1]); B.y = pk2(b0[2], b0[3]); B.z = pk2(b1[0], b1[1]); B.w = pk2(b1[2], b1[3]);
                u32x4 snd, rcv;
#pragma unroll
                for (int e = 0; e < 4; ++e) { snd[e] = hi8 ? A[e] : B[e]; rcv[e] = dpp_mov<0x128>(snd[e]); }
                u32x4 d1, d2;
#pragma unroll
                for (int e = 0; e < 4; ++e) { d1[e] = hi8 ? rcv[e] : A[e]; d2[e] = hi8 ? B[e] : rcv[e]; }
                const int row1 = rbase + ai * 128 + m * 16, row2 = row1 + 8;
                if (qkv) {
                    const int bb = row1 >> 13, t1 = row1 & (SEQ - 1), t2 = row2 & (SEQ - 1);
                    const int p1 = (t1 & dmask) * Lc + (t1 >> dsh), p2 = (t2 & dmask) * Lc + (t2 >> dsh);
                    bf16_t* hb = base + (size_t)bb * 24 * SEQ * 64 + ecol;
                    *(u32x4*)(hb + (size_t)p1 * 64) = d1; *(u32x4*)(hb + (size_t)p2 * 64) = d2;
                } else {
                    *(u32x4*)(base + (size_t)row1 * ld + ecol) = d1; *(u32x4*)(base + (size_t)row2 * ld + ecol) = d2;
                }
            }
    }
};
struct Epi2 {
    static constexpr bool PERM = false, PERM2 = false, AFTER_DRAIN = false;
    const float* x; float* out;
    __device__ __forceinline__ void operator()(const pg8::f32x4 (&acc)[2][2][4][2], const pg8::Unit& u, int wr, int wc, int fr, int fq) const {
        const int row0 = u.pm * 256 + wr * 64 + fr, col0 = u.pn * 256 + wc * 32 + 4 * fq;
#pragma unroll
        for (int ai = 0; ai < 2; ++ai)
#pragma unroll
            for (int m = 0; m < 4; ++m) { const size_t off = (size_t)(row0 + ai * 128 + m * 16) * DM + col0;
#pragma unroll
                for (int bj = 0; bj < 2; ++bj)
#pragma unroll
                    for (int n = 0; n < 2; ++n) { const size_t o2 = off + bj * 128 + n * 16; *(pg8::f32x4*)(out + o2) = *(const pg8::f32x4*)(x + o2) + acc[ai][bj][m][n]; }
                if (m & 1) asm volatile("" ::: "memory"); }
    }
};

constexpr int TP = 192;
constexpr int TTP = 272;
template <int NROWS> __device__ __forceinline__ void load_tile(LAS unsigned char* lds, const bf16_t* src, size_t rstride, int tid) {
    u32x4 v[NROWS / 64];
#pragma unroll
    for (int i = 0; i < NROWS / 64; ++i) { const int ci = tid + 512 * i, row = ci >> 3, ch = ci & 7; v[i] = *(const u32x4*)(src + (size_t)row * rstride + ch * 8); }
#pragma unroll
    for (int i = 0; i < NROWS / 64; ++i) { const int ci = tid + 512 * i, row = ci >> 3, ch = ci & 7; *(LAS u32x4*)(lds + row * TP + ch * 16) = v[i]; }
}
__device__ __forceinline__ void dft1_phase(const Args& a, LAS unsigned char* lds, int tid, int lane, int wave) {
    asm volatile("" : "+v"(tid), "+v"(lane));
    const bf16_t* Z = (const bf16_t*)(a.ws + WS_Z); bf16_t* Y = (bf16_t*)(a.ws + WS_XB);
    const int h = lane >> 5, l31 = lane & 31, kb = wave & 3, nt = wave >> 2;
    bf16x8 af[8];
    { const int ri_row = l31 >> 4, k1 = 16 * kb + (l31 & 15);
#pragma unroll
      for (int ks = 0; ks < 8; ++ks) { unsigned pw[4];
#pragma unroll
        for (int jj = 0; jj < 4; ++jj) { float vv[2];
#pragma unroll
            for (int e = 0; e < 2; ++e) { const int s1 = 16 * ks + 8 * h + 2 * jj + e; float sn, cs; sincospif((float)((s1 * k1) & 127) * (1.f / 64.f), &sn, &cs);
                float val = ri_row == 0 ? cs : sn;
                if (ri_row == 1 && k1 == 0) val = (s1 & 1) ? -1.f : 1.f;
                vv[e] = val * 0.08838834764831845f; }
            pw[jj] = pk2(vv[0], vv[1]); }
        u32x4 t; t.x = pw[0]; t.y = pw[1]; t.z = pw[2]; t.w = pw[3]; af[ks] = __builtin_bit_cast(bf16x8, t); } }
    const int q = (lane & 15) >> 2, p = lane & 3, blk = (lane >> 4) & 1;
    LAS const unsigned char* rb = lds + (8 * h + q) * TP + 32 * blk + 8 * p + nt * 64;
    u32x4 pf[2];
#define DFT1_ISSUE(uu) do { const int dc_ = (uu) & 7, s2_ = ((uu) >> 3) & 63, b_ = (uu) >> 9; const bf16_t* src_ = Z + ((size_t)b_ * SEQ + s2_) * 512 + dc_ * 64; \
        _Pragma("unroll") for (int i_ = 0; i_ < 2; ++i_) { const int ci_ = tid + 512 * i_; pf[i_] = *(const u32x4*)(src_ + (size_t)(ci_ >> 3) * (64 * 512) + (ci_ & 7) * 8); } } while (0)
    if ((int)blockIdx.x < 4096) DFT1_ISSUE((int)blockIdx.x);
    for (int u = blockIdx.x; u < 4096; u += gridDim.x) {
        const int dc = u & 7, s2 = (u >> 3) & 63, b = u >> 9;
#pragma unroll
        for (int i = 0; i < 2; ++i) { const int ci = tid + 512 * i; *(LAS u32x4*)(lds + (ci >> 3) * TP + (ci & 7) * 16) = pf[i]; }
        __syncthreads();
        if (u + (int)gridDim.x < 4096) DFT1_ISSUE(u + (int)gridDim.x);
        f32x16 acc = f32x16{};
#pragma unroll
        for (int ks = 0; ks < 8; ++ks) { const s16x4 lo = trrd(rb + ks * 16 * TP), hi = trrd(rb + ks * 16 * TP + 4 * TP);
            const bf16x8 bfr = __builtin_shufflevector(lo, hi, 0, 1, 2, 3, 4, 5, 6, 7);
            acc = __builtin_amdgcn_mfma_f32_32x32x16_bf16(af[ks], bfr, acc, 0, 0, 0); }
        LAS bf16_t* yt = (LAS bf16_t*)(lds + 49152);
#pragma unroll
        for (int i = 0; i < 8; ++i) { const int k1 = 16 * kb + crow(i, h); const float re = acc[i], im = acc[i + 8]; const int col = 32 * nt + l31;
            if (k1 != 0) { float sn, cs; sincospif((float)(s2 * k1) * (1.f / 4096.f), &sn, &cs);
                yt[(2 * k1) * 64 + col] = (bf16_t)f2bf(cs * re - sn * im); yt[(2 * k1 + 1) * 64 + col] = (bf16_t)f2bf(sn * re + cs * im); }
            else { float sn, cs; sincospif((float)s2 * (1.f / 64.f), &sn, &cs);
                yt[col] = (bf16_t)f2bf(re); yt[64 + col] = (bf16_t)0; yt[128 * 64 + col] = (bf16_t)f2bf(cs * im); yt[129 * 64 + col] = (bf16_t)f2bf(sn * im); } }
        __syncthreads();
#pragma unroll
        for (int z = 0; z < 3; ++z) { const int ci = tid + 512 * z; if (ci < 130 * 8) { const int row = ci >> 3, ch = ci & 7, k1 = row < 128 ? (row >> 1) : 64, ri = row < 128 ? (row & 1) : (row - 128);
            *(u32x4*)(Y + ((size_t)((b * 128 + k1) * 2 + ri) * 64 + s2) * 512 + dc * 64 + ch * 8) = *(LAS const u32x4*)(yt + row * 64 + ch * 8); } }
        __syncthreads();
    }
}
__device__ __forceinline__ void dft2_phase(const Args& a, LAS unsigned char* lds, int tid, int lane, int wave) {
    asm volatile("" : "+v"(tid), "+v"(lane));
    const bf16_t* Y = (const bf16_t*)(a.ws + WS_XB); const bf16_t* Gb = (const bf16_t*)(a.ws + WS_G); bf16_t* ym = (bf16_t*)(a.ws + WS_Z); const bf16_t* GmT = (const bf16_t*)(a.ws + WS_GMT);
    const int h = lane >> 5, l31 = lane & 31, ksub = wave >> 2, mh = (wave >> 1) & 1, nt = wave & 1;
    bf16x8 af[2][8];
#pragma unroll
    for (int z = 0; z < 2; ++z) { const int m = 64 * mh + 32 * z + l31, k2 = m & 63, imrow = m >> 6;
#pragma unroll
      for (int ks = 0; ks < 8; ++ks) { unsigned pw[4];
#pragma unroll
        for (int jj = 0; jj < 4; ++jj) { float vv[2];
#pragma unroll
            for (int e = 0; e < 2; ++e) { const int kk = 16 * ks + 8 * h + 2 * jj + e, ri = kk >> 6, s2 = kk & 63; float sn, cs; sincospif((float)((s2 * k2) & 63) * (1.f / 32.f), &sn, &cs);
                vv[e] = (imrow == 0 ? (ri == 0 ? cs : -sn) : (ri == 0 ? sn : cs)) * 0.125f; }
            pw[jj] = pk2(vv[0], vv[1]); }
        u32x4 t; t.x = pw[0]; t.y = pw[1]; t.z = pw[2]; t.w = pw[3]; af[z][ks] = __builtin_bit_cast(bf16x8, t); } }
    const int q = (lane & 15) >> 2, p = lane & 3, blk = (lane >> 4) & 1;
    LAS const unsigned char* rb = lds + (ksub * 128 + 8 * h + q) * TP + 32 * blk + 8 * p + nt * 64;
    LAS unsigned char* tt = lds + 49152;
    LAS float* ot = (LAS float*)(lds + 83968);
    const int mt2 = wave >> 1, nt2 = wave & 1;
    u32x4 ld[4];
#define DFT2_ISSUE(uu) do { const int dc_ = (uu) & 7, k1p_ = ((uu) >> 3) & 63, b_ = (uu) >> 9; \
        if (k1p_ == 0) { _Pragma("unroll") for (int z_ = 0; z_ < 2; ++z_) { const int ci_ = tid + 512 * z_; const size_t o_ = (size_t)(ci_ >> 3) * 512 + dc_ * 64 + (ci_ & 7) * 8; \
                ld[z_] = __builtin_nontemporal_load((const u32x4*)(Y + ((size_t)(b_ * 128) * 128) * 512 + o_)); ld[2 + z_] = __builtin_nontemporal_load((const u32x4*)(Y + ((size_t)(b_ * 128 + 64) * 128) * 512 + o_)); } } \
        else { const bf16_t* src_ = Y + ((size_t)(b_ * 128 + k1p_) * 128 + (tid >> 3)) * 512 + dc_ * 64 + (tid & 7) * 8; ld[0] = __builtin_nontemporal_load((const u32x4*)src_); ld[1] = __builtin_nontemporal_load((const u32x4*)(src_ + (size_t)64 * 512)); } } while (0)
    if ((int)blockIdx.x < 4096) DFT2_ISSUE((int)blockIdx.x);
    for (int u = blockIdx.x; u < 4096; u += gridDim.x) {
        const int dc = u & 7, k1p = (u >> 3) & 63, b = u >> 9;
        bf16x8 gf[8];
#pragma unroll
        for (int ks = 0; ks < 8; ++ks) gf[ks] = *(const bf16x8*)(GmT + (size_t)(dc * 64 + 32 * nt2 + l31) * 128 + 16 * ks + 8 * h);
        const int k1a = k1p, k1b = k1p == 0 ? 64 : 128 - k1p;
        const int tr_e = tid >> 2, qt_e = tid & 3; const size_t tok_e = (size_t)b * SEQ + ((tr_e >> 6) ? k1b : k1a) + 128 * (tr_e & 63);
        const u32x4 g0 = __builtin_nontemporal_load((const u32x4*)(Gb + tok_e * 1024 + dc * 64 + qt_e * 16)), g1 = __builtin_nontemporal_load((const u32x4*)(Gb + tok_e * 1024 + dc * 64 + qt_e * 16 + 8));
        if (k1p == 0) {
#pragma unroll
            for (int z = 0; z < 2; ++z) { const int ci = tid + 512 * z, row = ci >> 3, ch = ci & 7; *(LAS u32x4*)(lds + row * TP + ch * 16) = ld[z]; *(LAS u32x4*)(lds + (128 + row) * TP + ch * 16) = ld[2 + z]; }
        } else {
            const int s2 = tid >> 3, ch = tid & 7;
            const u32x4 yr = ld[0], yi = ld[1];
            float sn, cs; sincospif((float)s2 * (1.f / 32.f), &sn, &cs);
            u32x4 zr, zi;
#pragma unroll
            for (int e = 0; e < 4; ++e) { const float rl = bflo(yr[e]), rh = bfhi(yr[e]), il = bflo(yi[e]), ih = bfhi(yi[e]);
                zr[e] = pk2(rl * cs + il * sn, rh * cs + ih * sn); zi[e] = pk2(rl * sn - il * cs, rh * sn - ih * cs); }
            *(LAS u32x4*)(lds + s2 * TP + ch * 16) = yr; *(LAS u32x4*)(lds + (64 + s2) * TP + ch * 16) = yi;
            *(LAS u32x4*)(lds + (128 + s2) * TP + ch * 16) = zr; *(LAS u32x4*)(lds + (192 + s2) * TP + ch * 16) = zi;
        }
        __syncthreads();
        if (u + (int)gridDim.x < 4096) DFT2_ISSUE(u + (int)gridDim.x);
        f32x16 acc[2]; acc[0] = f32x16{}; acc[1] = f32x16{};
#pragma unroll
        for (int ks = 0; ks < 8; ++ks) { const s16x4 lo = trrd(rb + ks * 16 * TP), hi = trrd(rb + ks * 16 * TP + 4 * TP);
            const bf16x8 bfr = __builtin_shufflevector(lo, hi, 0, 1, 2, 3, 4, 5, 6, 7);
            acc[0] = __builtin_amdgcn_mfma_f32_32x32x16_bf16(af[0][ks], bfr, acc[0], 0, 0, 0);
            acc[1] = __builtin_amdgcn_mfma_f32_32x32x16_bf16(af[1][ks], bfr, acc[1], 0, 0, 0); }
#pragma unroll
        for (int z = 0; z < 2; ++z)
#pragma unroll
            for (int i = 0; i < 16; ++i) *(LAS bf16_t*)(tt + (ksub * 64 + 32 * z + crow(i, h)) * TTP + (mh * 64 + 32 * nt + l31) * 2) = (bf16_t)f2bf(acc[z][i]);
        __syncthreads();
        f32x16 o2 = f32x16{};
#pragma unroll
        for (int ks = 0; ks < 8; ++ks) { const bf16x8 tf = *(LAS const bf16x8*)(tt + (32 * mt2 + l31) * TTP + (16 * ks + 8 * h) * 2);
            o2 = __builtin_amdgcn_mfma_f32_32x32x16_bf16(tf, gf[ks], o2, 0, 0, 0); }
#pragma unroll
        for (int i = 0; i < 16; ++i) ot[(32 * mt2 + crow(i, h)) * 64 + 32 * nt2 + l31] = o2[i];
        __syncthreads();
        {
            const int tr = tid >> 2, qt = tid & 3, ks2 = tr >> 6, k2 = tr & 63;
            const size_t tok = (size_t)b * SEQ + (ks2 ? k1b : k1a) + 128 * k2;
            const LAS f32x4* op = (const LAS f32x4*)(ot + tr * 64 + qt * 16);
            const f32x4 v0 = op[0], v1 = op[1], v2 = op[2], v3 = op[3];
            u32x4 w0, w1;
            w0.x = pk2(v0.x * bflo(g0.x), v0.y * bfhi(g0.x)); w0.y = pk2(v0.z * bflo(g0.y), v0.w * bfhi(g0.y)); w0.z = pk2(v1.x * bflo(g0.z), v1.y * bfhi(g0.z)); w0.w = pk2(v1.z * bflo(g0.w), v1.w * bfhi(g0.w));
            w1.x = pk2(v2.x * bflo(g1.x), v2.y * bfhi(g1.x)); w1.y = pk2(v2.z * bflo(g1.y), v2.w * bfhi(g1.y)); w1.z = pk2(v3.x * bflo(g1.z), v3.y * bfhi(g1.z)); w1.w = pk2(v3.z * bflo(g1.w), v3.w * bfhi(g1.w));
            *(u32x4*)(ym + tok * 1024 + dc * 64 + qt * 16) = w0; *(u32x4*)(ym + tok * 1024 + dc * 64 + qt * 16 + 8) = w1;
        }
        __syncthreads();
    }
}

constexpr int KP = 144, VP = 192, KROWS = 384, LDS_VOFF = KROWS * KP;
struct AUnit { int b, hd, dil, L, r, i0; };
__device__ __forceinline__ AUnit attn_decode(int u, int hd0, int nh) {
    AUnit w; const int blk32 = u & 31; w.hd = hd0 + (u >> 5) % nh; w.b = u / (32 * nh);
    const int dsh = 2 * (w.hd >> 3), nbr = 32 >> dsh; w.dil = 1 << dsh; w.L = SEQ >> dsh; w.r = blk32 / nbr; w.i0 = (blk32 % nbr) * 256; return w;
}
__device__ __forceinline__ void attn_issue(const AUnit& w, const bf16_t* Qb, const bf16_t* Kb, const bf16_t* Vb, int tid, int wave, int lane, u32x4 (&kv)[6], u32x4 (&vv)[6]) {
    const int ch = tid & 7;
#pragma unroll
    for (int i = 0; i < 6; ++i) { const int row = (tid + 512 * i) >> 3; int pk = w.i0 - 64 + row; pk = pk < 0 ? 0 : (pk >= w.L ? w.L - 1 : pk);
        const size_t off = ((size_t)(w.b * 24 + w.hd) * SEQ + (size_t)(w.r * w.L + pk)) * 64 + ch * 8; kv[i] = *(const u32x4*)(Kb + off); vv[i] = *(const u32x4*)(Vb + off); }
}
__device__ __forceinline__ float attn_tile_exp(f32x16& st, int j, float tlf, float bsl, float rlo, float rhi) {
    float sum = 0.f;
#pragma unroll
    for (int i = 0; i < 16; ++i) { const float tmp = (float)(32 * j - 64 + (i & 3) + 8 * (i >> 2)) + tlf;
        float arg = __builtin_fmaf(-bsl, __builtin_fabsf(tmp), st[i]);
        arg = (tmp >= rlo && tmp <= rhi) ? arg : -1.0e30f;
        const float pe = __builtin_amdgcn_exp2f(arg); st[i] = pe; sum += pe; }
    return sum;
}
template <bool FUSED> __device__ __forceinline__ void attn_phase(const Args& a, LAS unsigned char* lds, int tid, int lane, int wave) {
    constexpr int HD0 = FUSED ? 0 : 8, NH = FUSED ? 8 : 16, NU = 8 * NH * 32;
    asm volatile("" : "+v"(tid), "+v"(lane));
    bf16_t* Qb = (bf16_t*)(a.ws + WS_Q); const bf16_t* Kb = (const bf16_t*)(a.ws + WS_K); const bf16_t* Vb = (const bf16_t*)(a.ws + WS_V); float* LSE = (float*)(a.ws + WS_LSE);
    const int h = lane >> 5, l31 = lane & 31;
    const int q = (lane & 15) >> 2, p = lane & 3, blk = (lane >> 4) & 1;
    int u = blockIdx.x;
    u32x4 kv[6], vv[6], qv[4];
#define ATTN_QLOAD(W) do { const bf16_t* qr_ = Qb + ((size_t)((W).b * 24 + (W).hd) * SEQ + (size_t)((W).r * (W).L + (W).i0 + 32 * wave + l31)) * 64; \
        _Pragma("unroll") for (int ks_ = 0; ks_ < 4; ++ks_) qv[ks_] = *(const u32x4*)(qr_ + 16 * ks_ + 8 * h); } while (0)
    if (u < NU) { const AUnit w0 = attn_decode(u, HD0, NH); attn_issue(w0, Qb, Kb, Vb, tid, wave, lane, kv, vv); ATTN_QLOAD(w0); }
    while (u < NU) {
        const AUnit w = attn_decode(u, HD0, NH);
        const int hd = w.hd, slot = hd & 7, L = w.L, i0 = w.i0;
        const int iq = i0 + 32 * wave + l31; const size_t tq = (size_t)w.b * SEQ + (size_t)iq * w.dil + w.r;
        bf16_t* qrow = Qb + ((size_t)(w.b * 24 + hd) * SEQ + (size_t)(w.r * L + iq)) * 64;
        {
            const int ch = tid & 7;
            const f32x4 g0 = *(const f32x4*)(a.kw + hd * 64 + ch * 8), g1 = *(const f32x4*)(a.kw + hd * 64 + ch * 8 + 4);
#pragma unroll
            for (int i = 0; i < 6; ++i) { const int row = (tid + 512 * i) >> 3;
                const float e0 = bflo(kv[i].x), e1 = bfhi(kv[i].x), e2 = bflo(kv[i].y), e3 = bfhi(kv[i].y), e4 = bflo(kv[i].z), e5 = bfhi(kv[i].z), e6 = bflo(kv[i].w), e7 = bfhi(kv[i].w);
                float ss = (e0 * e0 + e1 * e1) + (e2 * e2 + e3 * e3) + (e4 * e4 + e5 * e5) + (e6 * e6 + e7 * e7);
                ss += dpp_movf<0xB1>(ss); ss += dpp_movf<0x4E>(ss); ss += dpp_movf<0x141>(ss);
                const float rk = __builtin_amdgcn_rsqf(ss * (1.f / 64.f) + 1e-6f);
                u32x4 wv; wv.x = pk2(e0 * rk * g0.x, e1 * rk * g0.y); wv.y = pk2(e2 * rk * g0.z, e3 * rk * g0.w); wv.z = pk2(e4 * rk * g1.x, e5 * rk * g1.y); wv.w = pk2(e6 * rk * g1.z, e7 * rk * g1.w);
                *(LAS u32x4*)(lds + row * KP + ch * 16) = wv;
                *(LAS u32x4*)(lds + LDS_VOFF + row * VP + ch * 16) = vv[i];
                if (i & 1) __builtin_amdgcn_sched_barrier(0); }
        }
        bf16x8 qf[4];
        {
            float ss = 0.f;
#pragma unroll
            for (int ks = 0; ks < 4; ++ks)
#pragma unroll
                for (int e = 0; e < 4; ++e) { const float lo = bflo(qv[ks][e]), hi = bfhi(qv[ks][e]); ss += lo * lo + hi * hi; }
            ss += __shfl_xor(ss, 32);
            const float rq = 0.125f * LOG2E * __builtin_amdgcn_rsqf(ss * (1.f / 64.f) + 1e-6f);
#pragma unroll
            for (int ks = 0; ks < 4; ++ks) { const f32x4 g0 = *(const f32x4*)(a.qw + hd * 64 + 16 * ks + 8 * h), g1 = *(const f32x4*)(a.qw + hd * 64 + 16 * ks + 8 * h + 4); u32x4 wv;
                wv.x = pk2(bflo(qv[ks].x) * rq * g0.x, bfhi(qv[ks].x) * rq * g0.y); wv.y = pk2(bflo(qv[ks].y) * rq * g0.z, bfhi(qv[ks].y) * rq * g0.w);
                wv.z = pk2(bflo(qv[ks].z) * rq * g1.x, bfhi(qv[ks].z) * rq * g1.y); wv.w = pk2(bflo(qv[ks].w) * rq * g1.z, bfhi(qv[ks].w) * rq * g1.w);
                qf[ks] = __builtin_bit_cast(bf16x8, wv); }
        }
        const float mb = ((const float*)(a.ws + WS_RS))[hd];
        __syncthreads();
        const int un = u + gridDim.x;
        if (un < NU) { const AUnit wn = attn_decode(un, HD0, NH); attn_issue(wn, Qb, Kb, Vb, tid, wave, lane, kv, vv); }
        const float bsl = __builtin_amdgcn_exp2f(-(float)(slot + 1)) * (float)w.dil * LOG2E;
        int tl = 4 * h - l31; asm volatile("" : "+v"(tl));
        const float tlf = (float)tl;
        const int lo_i = -iq > -64 ? -iq : -64, hi_i = (L - 1 - iq) < 64 ? (L - 1 - iq) : 64;
        const float rlo = (float)lo_i, rhi = (float)hi_i;
        const int wq0 = i0 + 32 * wave;
        const bool edge = (wq0 < 64) || (wq0 + 32 > L - 64);
        float sum = 0.f;
        f32x16 o[2]; o[0] = f32x16{}; o[1] = f32x16{};
#pragma unroll
        for (int j = 0; j < 5; ++j) {
            f32x16 st;
#pragma unroll
            for (int i = 0; i < 16; ++i) st[i] = -mb;
            LAS const unsigned char* kp = lds + (32 * wave + 32 * j + l31) * KP + 16 * h;
#pragma unroll
            for (int ks = 0; ks < 4; ++ks) { const bf16x8 kf = *(LAS const bf16x8*)(kp + 32 * ks); st = __builtin_amdgcn_mfma_f32_32x32x16_bf16(kf, qf[ks], st, 0, 0, 0); }
            sum += attn_tile_exp(st, j, tlf, bsl, rlo, rhi);
#pragma unroll
            for (int s2 = 0; s2 < 2; ++s2) { u32x4 pw; pw.x = pk2(st[8 * s2 + 0], st[8 * s2 + 1]); pw.y = pk2(st[8 * s2 + 2], st[8 * s2 + 3]); pw.z = pk2(st[8 * s2 + 4], st[8 * s2 + 5]); pw.w = pk2(st[8 * s2 + 6], st[8 * s2 + 7]);
                const bf16x8 pf = __builtin_bit_cast(bf16x8, pw);
                LAS const unsigned char* vp = lds + LDS_VOFF + (32 * wave + 32 * j + 16 * s2 + 4 * h + q) * VP + 32 * blk + 8 * p;
#pragma unroll
                for (int dt = 0; dt < 2; ++dt) { const s16x4 lo = trrd(vp + dt * 64), hi = trrd(vp + 8 * VP + dt * 64);
                    const bf16x8 vf = __builtin_shufflevector(lo, hi, 0, 1, 2, 3, 4, 5, 6, 7);
                    o[dt] = __builtin_amdgcn_mfma_f32_32x32x16_bf16(vf, pf, o[dt], 0, 0, 0); } }
            __builtin_amdgcn_sched_barrier(0);
        }
        sum += __shfl_xor(sum, 32);
        if (un < NU) { const AUnit wq = attn_decode(un, HD0, NH); ATTN_QLOAD(wq); }
        const float inv = __builtin_amdgcn_rcpf(sum);
        {
            u32x4 fo1[4], fo2[4], fg[4]; float fl1[4], fl2[4];
            if constexpr (FUSED) {
                const bf16_t* Gb = (const bf16_t*)(a.ws + WS_G);
#pragma unroll
                for (int it = 0; it < 4; ++it) { const int r = 8 * it + (lane >> 3), c16 = lane & 7, t = i0 + 32 * wave + r; const size_t tokg = (size_t)w.b * SEQ + t;
                    fl1[it] = LSE[tokg * 24 + 8 + slot]; fl2[it] = LSE[tokg * 24 + 16 + slot];
                    fo1[it] = __builtin_nontemporal_load((const u32x4*)(Qb + ((size_t)(w.b * 24 + 8 + slot) * SEQ + (t & 3) * 2048 + (t >> 2)) * 64 + c16 * 8));
                    fo2[it] = __builtin_nontemporal_load((const u32x4*)(Qb + ((size_t)(w.b * 24 + 16 + slot) * SEQ + (t & 15) * 512 + (t >> 4)) * 64 + c16 * 8));
                    fg[it] = __builtin_nontemporal_load((const u32x4*)(Gb + tokg * 1024 + 512 + slot * 64 + c16 * 8)); }
            }
            LAS unsigned char* ost = lds + 129024 + wave * 4096;
#pragma unroll
            for (int dt = 0; dt < 2; ++dt)
#pragma unroll
                for (int ig = 0; ig < 4; ++ig) { u32x2 wv; wv.x = pk2(o[dt][4 * ig] * inv, o[dt][4 * ig + 1] * inv); wv.y = pk2(o[dt][4 * ig + 2] * inv, o[dt][4 * ig + 3] * inv);
                    const int p8 = 8 * dt + 2 * ig + h; *(LAS u32x2*)(ost + l31 * 128 + 8 * (p8 ^ (l31 & 15))) = wv; }
            if constexpr (FUSED) { if (h == 0) ((LAS float*)(lds + 161808))[wave * 32 + l31] = mb + __builtin_amdgcn_logf(sum); }
            asm volatile("s_waitcnt lgkmcnt(0)" ::: "memory");
            if constexpr (!FUSED) {
                bf16_t* obase = qrow - l31 * 64;
#pragma unroll
                for (int it = 0; it < 4; ++it) { const int r = 8 * it + (lane >> 3), c16 = lane & 7;
                    u32x4 v = *(LAS const u32x4*)(ost + r * 128 + 16 * (c16 ^ ((r & 15) >> 1)));
                    if (r & 1) { const unsigned t0 = v.x, t1 = v.y; v.x = v.z; v.y = v.w; v.z = t0; v.w = t1; }
                    *(u32x4*)(obase + (size_t)r * 64 + c16 * 8) = v; asm volatile("" ::: "memory"); }
            } else {
                bf16_t* ym = (bf16_t*)(a.ws + WS_Z);
#pragma unroll
                for (int it = 0; it < 4; ++it) { const int r = 8 * it + (lane >> 3), c16 = lane & 7;
                    u32x4 v = *(LAS const u32x4*)(ost + r * 128 + 16 * (c16 ^ ((r & 15) >> 1)));
                    if (r & 1) { const unsigned t0 = v.x, t1 = v.y; v.x = v.z; v.y = v.w; v.z = t0; v.w = t1; }
                    const int t = i0 + 32 * wave + r; const size_t tokg = (size_t)w.b * SEQ + t;
                    const float l0 = ((LAS const float*)(lds + 161808))[wave * 32 + r], l1 = fl1[it], l2 = fl2[it];
                    const float mxl = fmaxf(l0, fmaxf(l1, l2));
                    float w0 = __builtin_amdgcn_exp2f(l0 - mxl), w1 = __builtin_amdgcn_exp2f(l1 - mxl), w2 = __builtin_amdgcn_exp2f(l2 - mxl);
                    const float iw = 1.0f / (w0 + w1 + w2); w0 *= iw; w1 *= iw; w2 *= iw;
                    u32x4 ov;
#pragma unroll
                    for (int e = 0; e < 4; ++e) { const float lo = (bflo(v[e]) * w0 + bflo(fo1[it][e]) * w1 + bflo(fo2[it][e]) * w2) * bflo(fg[it][e]); const float hi = (bfhi(v[e]) * w0 + bfhi(fo1[it][e]) * w1 + bfhi(fo2[it][e]) * w2) * bfhi(fg[it][e]); ov[e] = pk2(lo, hi); }
                    *(u32x4*)(ym + tokg * 1024 + 512 + slot * 64 + c16 * 8) = ov; }
            }
        }
        if constexpr (!FUSED) { if (h == 0) LSE[tq * 24 + hd] = mb + __builtin_amdgcn_logf(sum); }
        __syncthreads();
        u = un;
    }
}
__device__ __forceinline__ void merge_phase(const Args& a, int lane, int wave) {
    asm volatile("" : "+v"(lane));
    const bf16_t* Ob = (const bf16_t*)(a.ws + WS_Q); const bf16_t* Gb = (const bf16_t*)(a.ws + WS_G); const float* LSE = (const float*)(a.ws + WS_LSE); bf16_t* ym = (bf16_t*)(a.ws + WS_Z);
    const int gw = blockIdx.x * 8 + wave, NGW = gridDim.x * 8, slot = lane >> 3;
    for (int tok0 = gw; tok0 < MTOK; tok0 += 2 * NGW) {
        u32x4 o0[2], o1[2], o2[2], g[2]; float l0[2], l1[2], l2[2];
#pragma unroll
        for (int z = 0; z < 2; ++z) { int tok = tok0 + z * NGW; tok = tok < MTOK ? tok : tok0;
            l0[z] = LSE[(size_t)tok * 24 + slot]; l1[z] = LSE[(size_t)tok * 24 + 8 + slot]; l2[z] = LSE[(size_t)tok * 24 + 16 + slot];
            const int b = tok >> 13, t = tok & (SEQ - 1), part = lane & 7;
            o0[z] = __builtin_nontemporal_load((const u32x4*)(Ob + ((size_t)(b * 24 + slot) * SEQ + t) * 64 + part * 8));
            o1[z] = __builtin_nontemporal_load((const u32x4*)(Ob + ((size_t)(b * 24 + 8 + slot) * SEQ + (t & 3) * 2048 + (t >> 2)) * 64 + part * 8));
            o2[z] = __builtin_nontemporal_load((const u32x4*)(Ob + ((size_t)(b * 24 + 16 + slot) * SEQ + (t & 15) * 512 + (t >> 4)) * 64 + part * 8));
            g[z] = __builtin_nontemporal_load((const u32x4*)(Gb + (size_t)tok * 1024 + 512 + lane * 8)); }
#pragma unroll
        for (int z = 0; z < 2; ++z) { const int tok = tok0 + z * NGW; if (tok >= MTOK) break;
            const float mx = fmaxf(l0[z], fmaxf(l1[z], l2[z]));
            float w0 = __builtin_amdgcn_exp2f(l0[z] - mx), w1 = __builtin_amdgcn_exp2f(l1[z] - mx), w2 = __builtin_amdgcn_exp2f(l2[z] - mx);
            const float inv = 1.0f / (w0 + w1 + w2); w0 *= inv; w1 *= inv; w2 *= inv;
            u32x4 w;
#pragma unroll
            for (int e = 0; e < 4; ++e) { const float lo = (bflo(o0[z][e]) * w0 + bflo(o1[z][e]) * w1 + bflo(o2[z][e]) * w2) * bflo(g[z][e]); const float hi = (bfhi(o0[z][e]) * w0 + bfhi(o1[z][e]) * w1 + bfhi(o2[z][e]) * w2) * bfhi(g[z][e]); w[e] = pk2(lo, hi); }
            *(u32x4*)(ym + (size_t)tok * 1024 + 512 + lane * 8) = w; }
    }
}

#define XB_TMO      128
#define XB_XCNT(j)  (256  + 64 * (j))
#define XB_XSUB(j)  (1280 + 64 * (j))
#define XB_XGEN(j)  (2304 + 64 * (j))
#define XB_TOP      3328
#define XB_TOPGEN   3392
#define XCD_BAR_WORDS 3456
#define XB_SPIN_CAP (1u << 18)

__device__ __forceinline__ unsigned xb_ld(unsigned* p)              { return __hip_atomic_load(p, __ATOMIC_RELAXED, __HIP_MEMORY_SCOPE_AGENT); }
__device__ __forceinline__ unsigned xb_add(unsigned* p, unsigned v) { return __hip_atomic_fetch_add(p, v, __ATOMIC_RELAXED, __HIP_MEMORY_SCOPE_AGENT); }
__device__ __forceinline__ unsigned xb_xcc_id() { return (unsigned)__builtin_amdgcn_s_getreg((3 << 11) | 20) & 0xFu; }
#define XB_SPIN(cond, bar) do { unsigned _sp = 0; while (cond) { __builtin_amdgcn_s_sleep(1); \
    if ((++_sp & 255u) == 0u) { if (xb_ld(&(bar)[XB_TMO])) break; if (_sp > XB_SPIN_CAP) { atomicAdd(&(bar)[XB_TMO], 1u); break; } } } } while (0)

struct XcdBarrier {
    unsigned* bar; unsigned x;
    volatile LAS unsigned* st;
};

__device__ __forceinline__ XcdBarrier xcd_barrier_post(unsigned* bar, volatile LAS unsigned* st) {
    XcdBarrier b; b.bar = bar; b.x = xb_xcc_id(); b.st = st;
    if (threadIdx.x == 0) (void)xb_add(&bar[XB_XCNT(b.x)], 1u);
    return b;
}
__device__ __forceinline__ void xcd_barrier_complete(unsigned* bar, unsigned x, unsigned& nloc, unsigned& nx) {
    const unsigned G = gridDim.x * gridDim.y * gridDim.z;
    unsigned sum, cnt, mine, sp = 0u;
    for (;;) {
        sum = 0u; cnt = 0u; mine = 0u;
#pragma unroll
        for (unsigned j = 0; j < 16; ++j) { const unsigned c = xb_ld(&bar[XB_XCNT(j)]); sum += c; cnt += (c > 0u) ? 1u : 0u; mine = (j == x) ? c : mine; }
        if (sum == G) break;
        __builtin_amdgcn_s_sleep(1);
        if ((++sp & 255u) == 0u) { if (xb_ld(&bar[XB_TMO])) break; if (sp > XB_SPIN_CAP) { atomicAdd(&bar[XB_TMO], 1u); break; } }
    }
    nloc = mine > 0u ? mine : 1u; nx = cnt > 0u ? cnt : 1u;
}

__device__ __forceinline__ void xcd_barrier(const XcdBarrier& b) {
    asm volatile("s_waitcnt vmcnt(0)" ::: "memory");
    __syncthreads();
    if (threadIdx.x == 0) {
        unsigned* bar = b.bar;
        __builtin_amdgcn_s_waitcnt(0);
        unsigned nloc = b.st[0], nx = b.st[1];
        if (nloc == 0u) { xcd_barrier_complete(bar, b.x, nloc, nx); b.st[0] = nloc; b.st[1] = nx; }
        const unsigned old = xb_add(&bar[XB_XSUB(b.x)], 1u);
        const unsigned gen = old / nloc;
        if (old + 1u == (gen + 1u) * nloc) {
            __builtin_amdgcn_fence(__ATOMIC_RELEASE, "agent");
            asm volatile("s_waitcnt vmcnt(0)" ::: "memory");
            const unsigned og = xb_add(&bar[XB_TOP], 1u);
            const unsigned tg = og / nx;
            if (og + 1u == (tg + 1u) * nx) xb_add(&bar[XB_TOPGEN], 1u);
            else XB_SPIN(xb_ld(&bar[XB_TOPGEN]) == tg, bar);
            __builtin_amdgcn_fence(__ATOMIC_ACQUIRE, "agent");
            xb_add(&bar[XB_XGEN(b.x)], 1u);
            asm volatile("s_waitcnt vmcnt(0)" ::: "memory");
        } else {
            XB_SPIN(xb_ld(&bar[XB_XGEN(b.x)]) == gen, bar);
            __builtin_amdgcn_fence(__ATOMIC_ACQUIRE, "agent");
            asm volatile("s_waitcnt vmcnt(0)" ::: "memory");
        }
    }
    __syncthreads();
}

__global__ void __launch_bounds__(512, 2) mega_fwd(Args a) {
    extern __shared__ __attribute__((aligned(16))) unsigned char lds_raw[];
    LAS unsigned char* lds = (LAS unsigned char*)lds_raw;
    cg::grid_group grid = cg::this_grid();
    const int tid = threadIdx.x, lane = tid & 63, wave = __builtin_amdgcn_readfirstlane(tid >> 6);
    volatile LAS unsigned* bst = (volatile LAS unsigned*)(lds + 161792);
    if (tid < 2) bst[tid] = 0u;
    __syncthreads();
    XcdBarrier bar = xcd_barrier_post((unsigned*)(a.ws + WS_BAR), bst);
    if (a.ws == nullptr) grid.sync();
#ifndef REP0
#define REP0 1
#define REP1 1
#define REPD1 1
#define REPD2 1
#define REPM 1
#define REP4 1
#endif
    for (int rep = 0; rep < REP0; ++rep) phase0(a, lds, tid, lane, wave);
    xcd_barrier(bar);
    {
        pg8::Gemm g{(const pg8::bf16_t*)(a.ws + WS_XB), (const pg8::bf16_t*)(a.ws + WS_WT), MTOK, NIN, DM}; pg8::StaticOrder S; S.init(MTOK, NIN, gridDim.x, (int)blockIdx.x, REP1);
        Epi1 E{(bf16_t*)(a.ws + WS_Z), (bf16_t*)(a.ws + WS_G), (bf16_t*)(a.ws + WS_Q), (bf16_t*)(a.ws + WS_K), (bf16_t*)(a.ws + WS_V)};
        pg8::gemm_phase<Epi1, pg8::StaticOrder, true, true>(lds, g, S, E);
    }
    xcd_barrier(bar);
    attn_phase<false>(a, lds, tid, lane, wave);
    for (int rep = 0; rep < REPD1; ++rep) dft1_phase(a, lds, tid, lane, wave);
    xcd_barrier(bar);
    attn_phase<true>(a, lds, tid, lane, wave);
    for (int rep = 0; rep < REPD2; ++rep) dft2_phase(a, lds, tid, lane, wave);
    xcd_barrier(bar);
    {
        pg8::Gemm g{(const pg8::bf16_t*)(a.ws + WS_Z), (const pg8::bf16_t*)(a.ws + WS_WOT), MTOK, DM, DM}; pg8::StaticOrder S; S.init(MTOK, DM, gridDim.x, (int)blockIdx.x, REP4);
        Epi2 E{a.x, a.out};
        pg8::gemm_phase<Epi2, pg8::StaticOrder, true, true>(lds, g, S, E);
    }
}

extern "C" void kernel_launch(void* const* d_in, const int* in_sizes, int n_in, void* d_out, int out_size, void* d_ws, size_t ws_size, hipStream_t stream) {
    static int grid = 0;
    if (grid == 0) {
        if (n_in != 7 || in_sizes[0] != MTOK * DM || out_size != MTOK * DM || ws_size < WS_END) { fprintf(stderr, "kernel_launch: unexpected shapes / workspace (%d inputs, ws %zu)\n", n_in, ws_size); grid = -1; return; }
        int dev = 0, cus = 0, per_cu = 0;
        hipGetDevice(&dev); hipDeviceGetAttribute(&cus, hipDeviceAttributeMultiprocessorCount, dev);
        hipFuncSetAttribute((const void*)mega_fwd, hipFuncAttributeMaxDynamicSharedMemorySize, LDS_BYTES);
        hipOccupancyMaxActiveBlocksPerMultiprocessor(&per_cu, (const void*)mega_fwd, 512, LDS_BYTES);
        if (per_cu < 1) { fprintf(stderr, "kernel_launch: occupancy query says %d blocks per CU\n", per_cu); per_cu = 1; }
        grid = cus;
        (void)hipGetLastError();
    }
    if (grid < 0) return;
    Args a{};
    a.x = (const float*)d_in[0]; a.norm_w = (const float*)d_in[1]; a.w_in = (const float*)d_in[2]; a.qw = (const float*)d_in[3]; a.kw = (const float*)d_in[4];
    a.wf = (const float*)d_in[5]; a.w_out = (const float*)d_in[6]; a.out = (float*)d_out; a.ws = (unsigned char*)d_ws;
    if (hipMemsetAsync((char*)d_ws + WS_BAR, 0, 16384, stream) != hipSuccess) { fprintf(stderr, "kernel_launch: memset of the barrier words failed\n"); return; }
    void* args[] = {&a};
    hipError_t e = hipLaunchCooperativeKernel((const void*)mega_fwd, dim3(grid), dim3(512), args, LDS_BYTES, stream);
    if (e != hipSuccess) fprintf(stderr, "cooperative launch failed: %s (grid %d)\n", hipGetErrorString(e), grid);
}
```

```cpp
#include <hip/hip_runtime.h>
#include <hip/hip_cooperative_groups.h>
#include <cstdio>
#include <cstdint>
namespace cg = cooperative_groups;
namespace pg8 {
#define PG8_LAS __attribute__((address_space(3)))
typedef unsigned short bf16_t;
typedef short bf16x8 __attribute__((ext_vector_type(8)));
typedef float f32x4 __attribute__((ext_vector_type(4)));
typedef unsigned u32x4 __attribute__((ext_vector_type(4)));
constexpr int BM = 256, BK = 64, HALF = 128, HTB = HALF * BK * 2  , STAGE_BYTES = 8 * HTB, NXCD = 8, WGM = 8;

__host__ __device__ __forceinline__ int lds_byte(int r, int c) { const int st = (r >> 4) * 2 + (c >> 5), rr = r & 15, cc = c & 31, ob = rr * 64 + cc * 2; return st * 1024 + (ob ^ (((ob >> 9) & 1) << 5)); }
__host__ __device__ __forceinline__ void stage_rc(int b, int& R, int& C) { const int st = b / 1024, sb = b % 1024, swz = sb ^ (((sb >> 9) & 1) << 5); R = (st >> 1) * 16 + swz / 64; C = (st & 1) * 32 + (swz % 64) / 2; }
__host__ __device__ __forceinline__ int perm32(int rho) { const int n = rho >> 4, i = rho & 15; return 8 * (i >> 2) + 4 * n + (i & 3); }

struct Unit { int pm, pn; };
struct Gemm { const bf16_t* A; const bf16_t* Bt; int M, N, K; };

struct StaticOrder {
    int nM, nN, nwg, G, c, rep;
    __host__ __device__ void init(int M, int N, int G_, int c_, int rep_ = 1) { nM = M / BM; nN = N / BM; nwg = nM * nN; G = G_; c = c_; rep = rep_; }
    __host__ __device__ bool next(int i, Unit& u) const {
        const int per = (nwg + G - 1) / G; if (i >= per * rep) return false; const long L = (long)(i % per) * G + c; if (L >= nwg) return false;
        int wgid = (int)L; { const int q = nwg / NXCD, r = nwg % NXCD, xcd = wgid % NXCD, off = wgid / NXCD; wgid = (xcd < r ? xcd * (q + 1) : r * (q + 1) + (xcd - r) * q) + off; }
        const int nig = WGM * nN, gid = wgid / nig, fm = gid * WGM, gsz = (nM - fm) < WGM ? (nM - fm) : WGM;
        u.pm = fm + ((wgid % nig) % gsz); u.pn = (wgid % nig) / gsz; return true;
    }
    __device__ __forceinline__ void a_ready(const Unit&) const {}
    __device__ __forceinline__ void done(const Unit&) const {}
};

__device__ __forceinline__ unsigned cvt_pk_bf16(float lo, float hi) { unsigned r; asm volatile("v_cvt_pk_bf16_f32 %0, %1, %2" : "=v"(r) : "v"(lo), "v"(hi)); return r; }
typedef float f32x2 __attribute__((ext_vector_type(2)));
template <class Epi, class Sched, bool ALIGN_EPI = false, bool SP2 = false>
__device__ __forceinline__ void gemm_phase(PG8_LAS unsigned char* lds, const Gemm g, const Sched& S, const Epi& E) {
    const int tid = threadIdx.x, wid = __builtin_amdgcn_readfirstlane(tid >> 6), lane = tid & 63, wr = wid >> 2, wc = wid & 3, fr = lane & 15, fq = lane >> 4;
    const int K = g.K, nt = K / BK;
    unsigned voffA[2], voffB[2];
#pragma unroll
    for (int i = 0; i < 2; ++i) { int R, C; stage_rc(tid * 16 + i * 8192, R, C); const int Rb = Epi::PERM2 ? (64 * (R >> 5) + perm32(R & 31)) : (Epi::PERM ? ((R & ~31) + perm32(R & 31)) : R);
        voffA[i] = (unsigned)(R * K + C) * 2u; voffB[i] = (unsigned)(Rb * K + C) * 2u; }
    const size_t kstep = (size_t)(BK * 2);
    const size_t hstep = (size_t)HALF * K * 2;
    const size_t hstepB = Epi::PERM2 ? (size_t)32 * K * 2 : hstep;
    const size_t tstep = 2 * hstep;
    const unsigned ldsw = (unsigned)wid * 1024u;
    const int aoff = lds_byte(wr * 64 + fr, fq * 8), boff = lds_byte(wc * 32 + fr, fq * 8);
#define PG8_SA(b, h) (((b) * 2 + (h)) * HTB)
#define PG8_SB(b, h) ((4 + (b) * 2 + (h)) * HTB)
#define PG8_STAGE(bufoff, gbase, voff) do { _Pragma("unroll") for (int _i = 0; _i < 2; ++_i) \
        __builtin_amdgcn_global_load_lds((const unsigned*)((const char*)(gbase) + (voff)[_i]), (PG8_LAS unsigned*)(lds + (bufoff) + ldsw + _i * 8192), 16, 0, 0); } while (0)
#define PG8_LDA(dst, b, h) do { _Pragma("unroll") for (int m = 0; m < 4; ++m) _Pragma("unroll") for (int k = 0; k < 2; ++k) dst[m][k] = *(const PG8_LAS bf16x8*)(lds + PG8_SA(b, h) + aoff + m * 2048 + k * 1024); } while (0)
#define PG8_LDB(dst, b, h) do { _Pragma("unroll") for (int n = 0; n < 2; ++n) _Pragma("unroll") for (int k = 0; k < 2; ++k) dst[n][k] = *(const PG8_LAS bf16x8*)(lds + PG8_SB(b, h) + boff + n * 2048 + k * 1024); } while (0)
#define PG8_MMA(ai, bj, At, Bt) do { __builtin_amdgcn_s_setprio(1); _Pragma("unroll") for (int m = 0; m < 4; ++m) _Pragma("unroll") for (int n = 0; n < 2; ++n) _Pragma("unroll") for (int k = 0; k < 2; ++k) \
        acc[ai][bj][m][n] = __builtin_amdgcn_mfma_f32_16x16x32_bf16(Bt[n][k], At[m][k], acc[ai][bj][m][n], 0, 0, 0); __builtin_amdgcn_s_setprio(0); } while (0)
#define PG8_WAIT_V(n) asm volatile("s_waitcnt vmcnt(" #n ")" ::: "memory")
#define PG8_WAIT_L(n) asm volatile("s_waitcnt lgkmcnt(" #n ")" ::: "memory")
#define PG8_BAR __builtin_amdgcn_s_barrier()
#define PG8_SCHED __builtin_amdgcn_sched_barrier(0)
    Unit cur, nxt; int ui = 0;
    if (!S.next(0, cur)) return;
    f32x4 acc[2][2][4][2];
#pragma unroll
    for (int a = 0; a < 2; ++a)
#pragma unroll
        for (int b = 0; b < 2; ++b)
#pragma unroll
            for (int m = 0; m < 4; ++m)
#pragma unroll
                for (int n = 0; n < 2; ++n) acc[a][b][m][n] = (f32x4){0.f, 0.f, 0.f, 0.f};
    bf16x8 At[4][2], B0[2][2], B1[2][2];
    const char* cA = (const char*)g.A + (size_t)cur.pm * tstep; const char* cB = (const char*)g.Bt + (size_t)cur.pn * tstep;
    S.a_ready(cur);
    if constexpr (SP2) {
        PG8_STAGE(PG8_SB(0, 0), cB, voffB); PG8_STAGE(PG8_SB(0, 1), cB + hstepB, voffB); PG8_STAGE(PG8_SA(0, 0), cA, voffA); PG8_STAGE(PG8_SA(0, 1), cA + hstep, voffA);
        if (wr == 1) PG8_BAR;
        PG8_WAIT_V(2); PG8_BAR;
        PG8_STAGE(PG8_SB(1, 0), cB + kstep, voffB); PG8_STAGE(PG8_SA(1, 0), cA + kstep, voffA); PG8_STAGE(PG8_SB(1, 1), cB + hstepB + kstep, voffB);
        PG8_WAIT_V(6); PG8_BAR;
    } else {
        PG8_STAGE(PG8_SB(0, 0), cB, voffB); PG8_STAGE(PG8_SA(0, 0), cA, voffA); PG8_STAGE(PG8_SB(0, 1), cB + hstepB, voffB); PG8_STAGE(PG8_SA(0, 1), cA + hstep, voffA);
        if (wr == 1) PG8_BAR;
        PG8_WAIT_V(4); PG8_BAR;
        PG8_STAGE(PG8_SB(1, 0), cB + kstep, voffB); PG8_STAGE(PG8_SA(1, 0), cA + kstep, voffA); PG8_STAGE(PG8_SB(1, 1), cB + hstepB + kstep, voffB);
        PG8_WAIT_V(6); PG8_BAR;
    }
    for (;;) {
        const bool has_next = S.next(ui + 1, nxt);
        const char* nA = has_next ? (const char*)g.A + (size_t)nxt.pm * tstep : cA; const char* nB = has_next ? (const char*)g.Bt + (size_t)nxt.pn * tstep : cB;
        for (int t = 0; t < nt; t += 2) {
            const bool last = (t == nt - 2);
            const char* a1 = cA + (size_t)(t + 1) * kstep;
            const char* a2 = last ? nA : cA + (size_t)(t + 2) * kstep; const char* b2 = last ? nB : cB + (size_t)(t + 2) * kstep;
            const char* a3 = a2 + kstep; const char* b3 = b2 + kstep;
            if (last && has_next) S.a_ready(nxt);
            if constexpr (SP2) {
            PG8_LDB(B0, 0, 0); PG8_LDB(B1, 0, 1); PG8_SCHED; PG8_LDA(At, 0, 0); PG8_STAGE(PG8_SA(1, 1), a1 + hstep, voffA);
            PG8_WAIT_V(8); PG8_WAIT_L(0); PG8_BAR; PG8_MMA(0, 0, At, B0); PG8_MMA(0, 1, At, B1); PG8_BAR; PG8_SCHED;
            PG8_LDA(At, 0, 1); PG8_STAGE(PG8_SB(0, 0), b2, voffB); PG8_STAGE(PG8_SB(0, 1), b2 + hstepB, voffB); PG8_STAGE(PG8_SA(0, 0), a2, voffA);
            PG8_WAIT_V(8); PG8_WAIT_L(0); PG8_BAR; PG8_MMA(1, 0, At, B0); PG8_MMA(1, 1, At, B1); PG8_BAR; PG8_SCHED;
            PG8_LDB(B0, 1, 0); PG8_LDB(B1, 1, 1); PG8_SCHED; PG8_LDA(At, 1, 0); PG8_STAGE(PG8_SA(0, 1), a2 + hstep, voffA);
            PG8_WAIT_V(8); PG8_WAIT_L(0); PG8_BAR; PG8_MMA(0, 0, At, B0); PG8_MMA(0, 1, At, B1); PG8_BAR; PG8_SCHED;
            PG8_LDA(At, 1, 1); PG8_STAGE(PG8_SB(1, 0), b3, voffB); PG8_STAGE(PG8_SB(1, 1), b3 + hstepB, voffB); PG8_STAGE(PG8_SA(1, 0), a3, voffA);
            PG8_WAIT_V(8); PG8_WAIT_L(0); PG8_BAR; PG8_MMA(1, 0, At, B0); PG8_MMA(1, 1, At, B1); PG8_BAR; PG8_SCHED;
            } else {
            PG8_LDB(B0, 0, 0); PG8_SCHED; PG8_LDA(At, 0, 0); PG8_STAGE(PG8_SA(1, 1), a1 + hstep, voffA);
            PG8_WAIT_L(8); PG8_BAR; PG8_WAIT_L(0); PG8_MMA(0, 0, At, B0); PG8_BAR; PG8_SCHED;
            PG8_LDB(B1, 0, 1); PG8_STAGE(PG8_SB(0, 0), b2, voffB);
            PG8_BAR; PG8_WAIT_L(0); PG8_MMA(0, 1, At, B1); PG8_BAR;
            PG8_LDA(At, 0, 1); PG8_STAGE(PG8_SA(0, 0), a2, voffA);
            PG8_BAR; PG8_WAIT_L(0); PG8_MMA(1, 0, At, B0); PG8_BAR; PG8_SCHED;
            PG8_STAGE(PG8_SB(0, 1), b2 + hstepB, voffB);
            PG8_WAIT_V(6); PG8_BAR; PG8_MMA(1, 1, At, B1); PG8_BAR;
            PG8_LDB(B0, 1, 0); PG8_SCHED; PG8_LDA(At, 1, 0); PG8_STAGE(PG8_SA(0, 1), a2 + hstep, voffA);
            PG8_WAIT_L(8); PG8_BAR; PG8_WAIT_L(0); PG8_MMA(0, 0, At, B0); PG8_BAR; PG8_SCHED;
            PG8_LDB(B1, 1, 1); PG8_STAGE(PG8_SB(1, 0), b3, voffB);
            PG8_BAR; PG8_WAIT_L(0); PG8_MMA(0, 1, At, B1); PG8_BAR;
            PG8_LDA(At, 1, 1); PG8_STAGE(PG8_SA(1, 0), a3, voffA);
            PG8_BAR; PG8_WAIT_L(0); PG8_MMA(1, 0, At, B0); PG8_BAR; PG8_SCHED;
            PG8_STAGE(PG8_SB(1, 1), b3 + hstepB, voffB);
            PG8_WAIT_V(6); PG8_BAR; PG8_MMA(1, 1, At, B1); PG8_BAR;
            }
        }
        if constexpr (ALIGN_EPI) { if (wr == 0) PG8_BAR; }
        if constexpr (!Epi::AFTER_DRAIN) { E(acc, cur, wr, wc, fr, fq); S.done(cur); }
        if (!has_next) break;
#pragma unroll
        for (int a = 0; a < 2; ++a)
#pragma unroll
            for (int b = 0; b < 2; ++b)
#pragma unroll
                for (int m = 0; m < 4; ++m)
#pragma unroll
                    for (int n = 0; n < 2; ++n) acc[a][b][m][n] = (f32x4){0.f, 0.f, 0.f, 0.f};
        cur = nxt; cA = nA; cB = nB; ++ui;
        if constexpr (ALIGN_EPI) { if (wr == 1) PG8_BAR; }
    }
    PG8_WAIT_V(0);
    if constexpr (!ALIGN_EPI) { if (wr == 0) PG8_BAR; }
    PG8_BAR;
    if constexpr (Epi::AFTER_DRAIN) { E.fused(acc, cur, wr, wc, fr, fq, lds, wid, lane); S.done(cur); }
#undef PG8_SA
#undef PG8_SB
#undef PG8_STAGE
#undef PG8_LDA
#undef PG8_LDB
#undef PG8_MMA
#undef PG8_WAIT_V
#undef PG8_WAIT_L
#undef PG8_BAR
#undef PG8_SCHED
}
}
#define LAS __attribute__((address_space(3)))
typedef unsigned short bf16_t;
typedef short bf16x8 __attribute__((ext_vector_type(8)));
typedef short s16x4 __attribute__((ext_vector_type(4)));
typedef short v4i16_t __attribute__((ext_vector_type(4)));
typedef float f32x4 __attribute__((ext_vector_type(4)));
typedef float f32x16 __attribute__((ext_vector_type(16)));
typedef unsigned u32x4 __attribute__((ext_vector_type(4)));
typedef unsigned u32x2 __attribute__((ext_vector_type(2)));

constexpr int SEQ = 8192, DM = 1024, MTOK = 65536, NIN = 6144, QKVW = 1536;
constexpr size_t WS_WT = 0, WS_WOT = 13631488, WS_RS = 15728640, WS_LSE = 15990784, WS_BAR = 23068672, WS_GMT = 24117248, WS_XB = 33554432, WS_Z = 167772160, WS_G = 301989888,
                 WS_Q = 436207616, WS_K = 637534208, WS_V = 838860800, WS_END = 1040187392;
constexpr int LDS_BYTES = 162944;
constexpr float LOG2E = 1.4426950408889634f;

__device__ __forceinline__ unsigned f2bf(float f) { unsigned u = __builtin_bit_cast(unsigned, f); return (u + 0x7fffu + ((u >> 16) & 1u)) >> 16; }
typedef float f32x2_t __attribute__((ext_vector_type(2))); typedef __bf16 bf16x2_t __attribute__((ext_vector_type(2)));
__device__ __forceinline__ unsigned pk2(float lo, float hi) { f32x2_t v = {lo, hi}; bf16x2_t b = __builtin_convertvector(v, bf16x2_t); return __builtin_bit_cast(unsigned, b); }
__device__ __forceinline__ float bflo(unsigned w) { return __builtin_bit_cast(float, w << 16); }
__device__ __forceinline__ float bfhi(unsigned w) { return __builtin_bit_cast(float, w & 0xffff0000u); }
__device__ __forceinline__ int crow(int r, int hi) { return (r & 3) + 8 * (r >> 2) + 4 * hi; }
__device__ __forceinline__ float wave_sum(float v) {
#pragma unroll
    for (int o = 1; o < 64; o <<= 1) v += __shfl_xor(v, o);
    return v;
}
__device__ __forceinline__ s16x4 trrd(LAS const unsigned char* p) { return __builtin_bit_cast(s16x4, __builtin_amdgcn_ds_read_tr16_b64_v4i16((LAS v4i16_t*)p)); }
__device__ __forceinline__ float silu_f(float v) { return v * __builtin_amdgcn_rcpf(1.f + __builtin_amdgcn_exp2f(-v * LOG2E)); }
#define LDS_WAIT() asm volatile("s_waitcnt lgkmcnt(0)" ::: "memory")
template <int CTRL> __device__ __forceinline__ unsigned dpp_mov(unsigned v) { return (unsigned)__builtin_amdgcn_update_dpp(0, (int)v, CTRL, 0xF, 0xF, true); }
template <int CTRL> __device__ __forceinline__ float dpp_movf(float v) { return __builtin_bit_cast(float, dpp_mov<CTRL>(__builtin_bit_cast(unsigned, v))); }

struct Args { const float *x, *norm_w, *w_in, *qw, *kw, *wf, *w_out; float* out; unsigned char* ws; };

__device__ __forceinline__ void transpose_item(const float* W, int ldw, int ncol0, bf16_t* WT, int row_off, const float* kscale, LAS float* scr, int kb, int nb, int lane) {
    const int k0 = 64 * kb, n0 = 32 * nb;
#pragma unroll 8
    for (int i = 0; i < 32; ++i) { const int kk = 2 * i + (lane >> 5); float v = W[(size_t)(k0 + kk) * ldw + ncol0 + n0 + (lane & 31)]; if (kscale) v *= kscale[k0 + kk]; scr[kk * 33 + (lane & 31)] = v; }
    LDS_WAIT();
    const int c = lane & 7;
#pragma unroll
    for (int j = 0; j < 4; ++j) { const int n = (lane >> 3) + 8 * j; const LAS float* s = scr + (8 * c) * 33 + n;
        u32x4 o; o.x = pk2(s[0 * 33], s[1 * 33]); o.y = pk2(s[2 * 33], s[3 * 33]); o.z = pk2(s[4 * 33], s[5 * 33]); o.w = pk2(s[6 * 33], s[7 * 33]);
        *(u32x4*)(WT + (size_t)(row_off + n0 + n) * 1024 + k0 + 8 * c) = o; }
    LDS_WAIT();
}
__device__ __forceinline__ void gmt_unit(const Args& a, LAS unsigned char* lds, int unit, int tid) {
    bf16_t* GmT = (bf16_t*)(a.ws + WS_GMT);
    LAS float* tab = (LAS float*)lds;
    if (tid < 64) { float sn, cs; sincospif((float)tid * (1.f / 32.f), &sn, &cs); tab[2 * tid] = cs; tab[2 * tid + 1] = sn; }
    __syncthreads();
    const int g = unit >> 2, d = 16 * (unit & 3) + (tid >> 5), c32 = tid & 31;
    float acc[4] = {0.f, 0.f, 0.f, 0.f};
    for (int l = 0; l < 64; ++l) { const float w = a.wf[(size_t)(g * 64 + l) * 64 + d];
#pragma unroll
        for (int e = 0; e < 4; ++e) { const int cc = c32 * 4 + e, c = cc & 63, idx = (l * c) & 63; acc[e] += w * (cc < 64 ? tab[2 * idx] : -tab[2 * idx + 1]); } }
#pragma unroll
    for (int e = 0; e < 4; ++e) GmT[(size_t)(g * 64 + d) * 128 + c32 * 4 + e] = (bf16_t)f2bf(acc[e] * 0.125f);
    __syncthreads();
}
__device__ __forceinline__ void phase0(const Args& a, LAS unsigned char* lds, int tid, int lane, int wave) {
    bf16_t* Wt = (bf16_t*)(a.ws + WS_WT); bf16_t* WoT = (bf16_t*)(a.ws + WS_WOT); bf16_t* xb = (bf16_t*)(a.ws + WS_XB);
    const int G = gridDim.x, bx = blockIdx.x;
    for (int u = bx; u < 32; u += G) gmt_unit(a, lds, u, tid);
    if (bx == G - 1 && wave < 3) {
        for (int hd = wave * 8; hd < wave * 8 + 8; ++hd) {
            float gqm = fabsf(a.qw[hd * 64 + lane]), gkm = fabsf(a.kw[hd * 64 + lane]);
#pragma unroll
            for (int o = 1; o < 64; o <<= 1) { gqm = fmaxf(gqm, __shfl_xor(gqm, o)); gkm = fmaxf(gkm, __shfl_xor(gkm, o)); }
            if (lane == 0) ((float*)(a.ws + WS_RS))[hd] = 8.08f * LOG2E * gqm * gkm;
        }
    }
    LAS float* scr = (LAS float*)(lds + 32768 + wave * 8448);
    const int gw = bx * 8 + wave, NGW = G * 8;
    constexpr int I_IN = 16 * 192, I_OUT = 16 * 32;
    for (int it = gw; it < I_IN + I_OUT; it += NGW) {
        if (it < I_IN) transpose_item(a.w_in, 6144, 0, Wt, 0, a.norm_w, scr, it / 192, it % 192, lane);
        else { const int r = it - I_IN; transpose_item(a.w_out, 1024, 0, WoT, 0, nullptr, scr, r / 32, r % 32, lane); }
    }
    for (int row = gw; row < MTOK; row += 2 * NGW) {
        const int row2 = row + NGW; const bool has2 = row2 < MTOK;
        const f32x4* xr = (const f32x4*)(a.x + (size_t)row * DM) + lane; const f32x4* xr2 = (const f32x4*)(a.x + (size_t)(has2 ? row2 : row) * DM) + lane;
        f32x4 v[4], v2[4]; float s = 0.f, s2 = 0.f;
#pragma unroll
        for (int j = 0; j < 4; ++j) { v[j] = __builtin_nontemporal_load(xr + 64 * j); v2[j] = __builtin_nontemporal_load(xr2 + 64 * j); }
#pragma unroll
        for (int j = 0; j < 4; ++j) { s += (v[j].x * v[j].x + v[j].y * v[j].y) + (v[j].z * v[j].z + v[j].w * v[j].w); s2 += (v2[j].x * v2[j].x + v2[j].y * v2[j].y) + (v2[j].z * v2[j].z + v2[j].w * v2[j].w); }
        s = wave_sum(s); s2 = wave_sum(s2);
        const float r = 1.0f / sqrtf(s * (1.f / DM) + 1e-6f), r2 = 1.0f / sqrtf(s2 * (1.f / DM) + 1e-6f);
        u32x2* o = (u32x2*)(xb + (size_t)row * DM) + lane;
#pragma unroll
        for (int j = 0; j < 4; ++j) { u32x2 w; w.x = pk2(v[j].x * r, v[j].y * r); w.y = pk2(v[j].z * r, v[j].w * r); o[64 * j] = w; }
        if (has2) { u32x2* o2 = (u32x2*)(xb + (size_t)row2 * DM) + lane;
#pragma unroll
            for (int j = 0; j < 4; ++j) { u32x2 w; w.x = pk2(v2[j].x * r2, v2[j].y * r2); w.y = pk2(v2[j].z * r2, v2[j].w * r2); o2[64 * j] = w; } }
    }
}

struct Epi1 {
    static constexpr bool PERM = true, PERM2 = true, AFTER_DRAIN = false;
    bf16_t *Z, *G, *Q, *Kb, *V;
    __device__ __forceinline__ void operator()(const pg8::f32x4 (&acc)[2][2][4][2], const pg8::Unit& u, int wr, int wc, int fr, int fq) const {
        const int pn = u.pn; const int hi8 = (fr >> 3) & 1, fr7 = fr & 7; const int rbase = u.pm * 256 + wr * 64 + fr7;
        const bool qkv = (pn >= 4 && pn < 22);
        const bool act = !qkv && pn >= 2;
        const int ld = pn < 2 ? 512 : 1024;
        bf16_t* base; int dsh = 0; size_t rowstride_tok = 0; int ecol;
        if (qkv) { const int which = (pn - 4) / 6, ct = (pn - 4) % 6; dsh = 2 * (ct >> 1);
            base = Q + (size_t)which * ((WS_K - WS_Q) / 2) + (size_t)(ct * 4 + wc) * SEQ * 64; ecol = 32 * hi8 + 8 * fq; }
        else { const int c0 = pn < 2 ? pn * 256 : (pn < 4 ? (pn - 2) * 256 : 512 + (pn - 22) * 256); base = (pn < 2 ? Z : G) + c0 + wc * 64; ecol = 32 * hi8 + 8 * fq; }
        const int dmask = (1 << dsh) - 1, Lc = SEQ >> dsh;
#pragma unroll
        for (int ai = 0; ai < 2; ++ai)
#pragma unroll
            for (int m = 0; m < 4; ++m) {
                pg8::f32x4 a0 = acc[ai][0][m][0], a1 = acc[ai][0][m][1], b0 = acc[ai][1][m][0], b1 = acc[ai][1][m][1];
                if (act) {
#pragma unroll
                    for (int e = 0; e < 4; ++e) { a0[e] = silu_f(a0[e]); a1[e] = silu_f(a1[e]); b0[e] = silu_f(b0[e]); b1[e] = silu_f(b1[e]); } }
                u32x4 A, B; A.x = pk2(a0[0], a0[1]); A.y = pk2(a0[2], a0[3]); A.z = pk2(a1[0], a1[1]); A.w = pk2(a1[2], a1[3]);
                B.x = pk2(b0[0], b0[1]); B.y = pk2(b0[2], b0[3]); B.z = pk2(b1[0], b1[1]); B.w = pk2(b1[2], b1[3]);
                u32x4 snd, rcv;
#pragma unroll
                for (int e = 0; e < 4; ++e) { snd[e] = hi8 ? A[e] : B[e]; rcv[e] = dpp_mov<0x128>(snd[e]); }
                u32x4 d1, d2;
#pragma unroll
                for (int e = 0; e < 4; ++e) { d1[e] = hi8 ? rcv[e] : A[e]; d2[e] = hi8 ? B[e] : rcv[e]; }
                const int row1 = rbase + ai * 128 + m * 16, row2 = row1 + 8;
                if (qkv) {
                    const int bb = row1 >> 13, t1 = row1 & (SEQ - 1), t2 = row2 & (SEQ - 1);
                    const int p1 = (t1 & dmask) * Lc + (t1 >> dsh), p2 = (t2 & dmask) * Lc + (t2 >> dsh);
                    bf16_t* hb = base + (size_t)bb * 24 * SEQ * 64 + ecol;
                    *(u32x4*)(hb + (size_t)p1 * 64) = d1; *(u32x4*)(hb + (size_t)p2 * 64) = d2;
                } else {
                    *(u32x4*)(base + (size_t)row1 * ld + ecol) = d1; *(u32x4*)(base + (size_t)row2 * ld + ecol) = d2;
                }
            }
    }
};
struct Epi2 {
    static constexpr bool PERM = false, PERM2 = false, AFTER_DRAIN = false;
    const float* x; float* out;
    __device__ __forceinline__ void operator()(const pg8::f32x4 (&acc)[2][2][4][2], const pg8::Unit& u, int wr, int wc, int fr, int fq) const {
        const int row0 = u.pm * 256 + wr * 64 + fr, col0 = u.pn * 256 + wc * 32 + 4 * fq;
#pragma unroll
        for (int ai = 0; ai < 2; ++ai)
#pragma unroll
            for (int m = 0; m < 4; ++m) { const size_t off = (size_t)(row0 + ai * 128 + m * 16) * DM + col0;
#pragma unroll
                for (int bj = 0; bj < 2; ++bj)
#pragma unroll
                    for (int n = 0; n < 2; ++n) { const size_t o2 = off + bj * 128 + n * 16; *(pg8::f32x4*)(out + o2) = *(const pg8::f32x4*)(x + o2) + acc[ai][bj][m][n]; }
                if (m & 1) asm volatile("" ::: "memory"); }
    }
};

constexpr int TP = 192;
constexpr int TTP = 272;
template <int NROWS> __device__ __forceinline__ void load_tile(LAS unsigned char* lds, const bf16_t* src, size_t rstride, int tid) {
    u32x4 v[NROWS / 64];
#pragma unroll
    for (int i = 0; i < NROWS / 64; ++i) { const int ci = tid + 512 * i, row = ci >> 3, ch = ci & 7; v[i] = *(const u32x4*)(src + (size_t)row * rstride + ch * 8); }
#pragma unroll
    for (int i = 0; i < NROWS / 64; ++i) { const int ci = tid + 512 * i, row = ci >> 3, ch = ci & 7; *(LAS u32x4*)(lds + row * TP + ch * 16) = v[i]; }
}
__device__ __forceinline__ void dft1_phase(const Args& a, LAS unsigned char* lds, int tid, int lane, int wave) {
    asm volatile("" : "+v"(tid), "+v"(lane));
    const bf16_t* Z = (const bf16_t*)(a.ws + WS_Z); bf16_t* Y = (bf16_t*)(a.ws + WS_XB);
    const int h = lane >> 5, l31 = lane & 31, kb = wave & 3, nt = wave >> 2;
    bf16x8 af[8];
    { const int ri_row = l31 >> 4, k1 = 16 * kb + (l31 & 15);
#pragma unroll
      for (int ks = 0; ks < 8; ++ks) { unsigned pw[4];
#pragma unroll
        for (int jj = 0; jj < 4; ++jj) { float vv[2];
#pragma unroll
            for (int e = 0; e < 2; ++e) { const int s1 = 16 * ks + 8 * h + 2 * jj + e; float sn, cs; sincospif((float)((s1 * k1) & 127) * (1.f / 64.f), &sn, &cs);
                float val = ri_row == 0 ? cs : sn;
                if (ri_row == 1 && k1 == 0) val = (s1 & 1) ? -1.f : 1.f;
                vv[e] = val * 0.08838834764831845f; }
            pw[jj] = pk2(vv[0], vv[1]); }
        u32x4 t; t.x = pw[0]; t.y = pw[1]; t.z = pw[2]; t.w = pw[3]; af[ks] = __builtin_bit_cast(bf16x8, t); } }
    const int q = (lane & 15) >> 2, p = lane & 3, blk = (lane >> 4) & 1;
    LAS const unsigned char* rb = lds + (8 * h + q) * TP + 32 * blk + 8 * p + nt * 64;
    u32x4 pf[2];
#define DFT1_ISSUE(uu) do { const int dc_ = (uu) & 7, s2_ = ((uu) >> 3) & 63, b_ = (uu) >> 9; const bf16_t* src_ = Z + ((size_t)b_ * SEQ + s2_) * 512 + dc_ * 64; \
        _Pragma("unroll") for (int i_ = 0; i_ < 2; ++i_) { const int ci_ = tid + 512 * i_; pf[i_] = *(const u32x4*)(src_ + (size_t)(ci_ >> 3) * (64 * 512) + (ci_ & 7) * 8); } } while (0)
    if ((int)blockIdx.x < 4096) DFT1_ISSUE((int)blockIdx.x);
    for (int u = blockIdx.x; u < 4096; u += gridDim.x) {
        const int dc = u & 7, s2 = (u >> 3) & 63, b = u >> 9;
#pragma unroll
        for (int i = 0; i < 2; ++i) { const int ci = tid + 512 * i; *(LAS u32x4*)(lds + (ci >> 3) * TP + (ci & 7) * 16) = pf[i]; }
        __syncthreads();
        if (u + (int)gridDim.x < 4096) DFT1_ISSUE(u + (int)gridDim.x);
        f32x16 acc = f32x16{};
#pragma unroll
        for (int ks = 0; ks < 8; ++ks) { const s16x4 lo = trrd(rb + ks * 16 * TP), hi = trrd(rb + ks * 16 * TP + 4 * TP);
            const bf16x8 bfr = __builtin_shufflevector(lo, hi, 0, 1, 2, 3, 4, 5, 6, 7);
            acc = __builtin_amdgcn_mfma_f32_32x32x16_bf16(af[ks], bfr, acc, 0, 0, 0); }
        LAS bf16_t* yt = (LAS bf16_t*)(lds + 49152);
#pragma unroll
        for (int i = 0; i < 8; ++i) { const int k1 = 16 * kb + crow(i, h); const float re = acc[i], im = acc[i + 8]; const int col = 32 * nt + l31;
            if (k1 != 0) { float sn, cs; sincospif((float)(s2 * k1) * (1.f / 4096.f), &sn, &cs);
                yt[(2 * k1) * 64 + col] = (bf16_t)f2bf(cs * re - sn * im); yt[(2 * k1 + 1) * 64 + col] = (bf16_t)f2bf(sn * re + cs * im); }
            else { float sn, cs; sincospif((float)s2 * (1.f / 64.f), &sn, &cs);
                yt[col] = (bf16_t)f2bf(re); yt[64 + col] = (bf16_t)0; yt[128 * 64 + col] = (bf16_t)f2bf(cs * im); yt[129 * 64 + col] = (bf16_t)f2bf(sn * im); } }
        __syncthreads();
#pragma unroll
        for (int z = 0; z < 3; ++z) { const int ci = tid + 512 * z; if (ci < 130 * 8) { const int row = ci >> 3, ch = ci & 7, k1 = row < 128 ? (row >> 1) : 64, ri = row < 128 ? (row & 1) : (row - 128);
            *(u32x4*)(Y + ((size_t)((b * 128 + k1) * 2 + ri) * 64 + s2) * 512 + dc * 64 + ch * 8) = *(LAS const u32x4*)(yt + row * 64 + ch * 8); } }
        __syncthreads();
    }
}
__device__ __forceinline__ void dft2_phase(const Args& a, LAS unsigned char* lds, int tid, int lane, int wave) {
    asm volatile("" : "+v"(tid), "+v"(lane));
    const bf16_t* Y = (const bf16_t*)(a.ws + WS_XB); const bf16_t* Gb = (const bf16_t*)(a.ws + WS_G); bf16_t* ym = (bf16_t*)(a.ws + WS_Z); const bf16_t* GmT = (const bf16_t*)(a.ws + WS_GMT);
    const int h = lane >> 5, l31 = lane & 31, ksub = wave >> 2, mh = (wave >> 1) & 1, nt = wave & 1;
    bf16x8 af[2][8];
#pragma unroll
    for (int z = 0; z < 2; ++z) { const int m = 64 * mh + 32 * z + l31, k2 = m & 63, imrow = m >> 6;
#pragma unroll
      for (int ks = 0; ks < 8; ++ks) { unsigned pw[4];
#pragma unroll
        for (int jj = 0; jj < 4; ++jj) { float vv[2];
#pragma unroll
            for (int e = 0; e < 2; ++e) { const int kk = 16 * ks + 8 * h + 2 * jj + e, ri = kk >> 6, s2 = kk & 63; float sn, cs; sincospif((float)((s2 * k2) & 63) * (1.f / 32.f), &sn, &cs);
                vv[e] = (imrow == 0 ? (ri == 0 ? cs : -sn) : (ri == 0 ? sn : cs)) * 0.125f; }
            pw[jj] = pk2(vv[0], vv[1]); }
        u32x4 t; t.x = pw[0]; t.y = pw[1]; t.z = pw[2]; t.w = pw[3]; af[z][ks] = __builtin_bit_cast(bf16x8, t); } }
    const int q = (lane & 15) >> 2, p = lane & 3, blk = (lane >> 4) & 1;
    LAS const unsigned char* rb = lds + (ksub * 128 + 8 * h + q) * TP + 32 * blk + 8 * p + nt * 64;
    LAS unsigned char* tt = lds + 49152;
    LAS float* ot = (LAS float*)(lds + 83968);
    const int mt2 = wave >> 1, nt2 = wave & 1;
    u32x4 ld[4];
#define DFT2_ISSUE(uu) do { const int dc_ = (uu) & 7, k1p_ = ((uu) >> 3) & 63, b_ = (uu) >> 9; \
        if (k1p_ == 0) { _Pragma("unroll") for (int z_ = 0; z_ < 2; ++z_) { const int ci_ = tid + 512 * z_; const size_t o_ = (size_t)(ci_ >> 3) * 512 + dc_ * 64 + (ci_ & 7) * 8; \
                ld[z_] = __builtin_nontemporal_load((const u32x4*)(Y + ((size_t)(b_ * 128) * 128) * 512 + o_)); ld[2 + z_] = __builtin_nontemporal_load((const u32x4*)(Y + ((size_t)(b_ * 128 + 64) * 128) * 512 + o_)); } } \
        else { const bf16_t* src_ = Y + ((size_t)(b_ * 128 + k1p_) * 128 + (tid >> 3)) * 512 + dc_ * 64 + (tid & 7) * 8; ld[0] = __builtin_nontemporal_load((const u32x4*)src_); ld[1] = __builtin_nontemporal_load((const u32x4*)(src_ + (size_t)64 * 512)); } } while (0)
    if ((int)blockIdx.x < 4096) DFT2_ISSUE((int)blockIdx.x);
    for (int u = blockIdx.x; u < 4096; u += gridDim.x) {
        const int dc = u & 7, k1p = (u >> 3) & 63, b = u >> 9;
        bf16x8 gf[8];
#pragma unroll
        for (int ks = 0; ks < 8; ++ks) gf[ks] = *(const bf16x8*)(GmT + (size_t)(dc * 64 + 32 * nt2 + l31) * 128 + 16 * ks + 8 * h);
        const int k1a = k1p, k1b = k1p == 0 ? 64 : 128 - k1p;
        const int tr_e = tid >> 2, qt_e = tid & 3; const size_t tok_e = (size_t)b * SEQ + ((tr_e >> 6) ? k1b : k1a) + 128 * (tr_e & 63);
        const u32x4 g0 = __builtin_nontemporal_load((const u32x4*)(Gb + tok_e * 1024 + dc * 64 + qt_e * 16)), g1 = __builtin_nontemporal_load((const u32x4*)(Gb + tok_e * 1024 + dc * 64 + qt_e * 16 + 8));
        if (k1p == 0) {
#pragma unroll
            for (int z = 0; z < 2; ++z) { const int ci = tid + 512 * z, row = ci >> 3, ch = ci & 7; *(LAS u32x4*)(lds + row * TP + ch * 16) = ld[z]; *(LAS u32x4*)(lds + (128 + row) * TP + ch * 16) = ld[2 + z]; }
        } else {
            const int s2 = tid >> 3, ch = tid & 7;
            const u32x4 yr = ld[0], yi = ld[1];
            float sn, cs; sincospif((float)s2 * (1.f / 32.f), &sn, &cs);
            u32x4 zr, zi;
#pragma unroll
            for (int e = 0; e < 4; ++e) { const float rl = bflo(yr[e]), rh = bfhi(yr[e]), il = bflo(yi[e]), ih = bfhi(yi[e]);
                zr[e] = pk2(rl * cs + il * sn, rh * cs + ih * sn); zi[e] = pk2(rl * sn - il * cs, rh * sn - ih * cs); }
            *(LAS u32x4*)(lds + s2 * TP + ch * 16) = yr; *(LAS u32x4*)(lds + (64 + s2) * TP + ch * 16) = yi;
            *(LAS u32x4*)(lds + (128 + s2) * TP + ch * 16) = zr; *(LAS u32x4*)(lds + (192 + s2) * TP + ch * 16) = zi;
        }
        __syncthreads();
        if (u + (int)gridDim.x < 4096) DFT2_ISSUE(u + (int)gridDim.x);
        f32x16 acc[2]; acc[0] = f32x16{}; acc[1] = f32x16{};
#pragma unroll
        for (int ks = 0; ks < 8; ++ks) { const s16x4 lo = trrd(rb + ks * 16 * TP), hi = trrd(rb + ks * 16 * TP + 4 * TP);
            const bf16x8 bfr = __builtin_shufflevector(lo, hi, 0, 1, 2, 3, 4, 5, 6, 7);
            acc[0] = __builtin_amdgcn_mfma_f32_32x32x16_bf16(af[0][ks], bfr, acc[0], 0, 0, 0);
            acc[1] = __builtin_amdgcn_mfma_f32_32x32x16_bf16(af[1][ks], bfr, acc[1], 0, 0, 0); }
#pragma unroll
        for (int z = 0; z < 2; ++z)
#pragma unroll
            for (int i = 0; i < 16; ++i) *(LAS bf16_t*)(tt + (ksub * 64 + 32 * z + crow(i, h)) * TTP + (mh * 64 + 32 * nt + l31) * 2) = (bf16_t)f2bf(acc[z][i]);
        __syncthreads();
        f32x16 o2 = f32x16{};
#pragma unroll
        for (int ks = 0; ks < 8; ++ks) { const bf16x8 tf = *(LAS const bf16x8*)(tt + (32 * mt2 + l31) * TTP + (16 * ks + 8 * h) * 2);
            o2 = __builtin_amdgcn_mfma_f32_32x32x16_bf16(tf, gf[ks], o2, 0, 0, 0); }
#pragma unroll
        for (int i = 0; i < 16; ++i) ot[(32 * mt2 + crow(i, h)) * 64 + 32 * nt2 + l31] = o2[i];
        __syncthreads();
        {
            const int tr = tid >> 2, qt = tid & 3, ks2 = tr >> 6, k2 = tr & 63;
            const size_t tok = (size_t)b * SEQ + (ks2 ? k1b : k1a) + 128 * k2;
            const LAS f32x4* op = (const LAS f32x4*)(ot + tr * 64 + qt * 16);
            const f32x4 v0 = op[0], v1 = op[1], v2 = op[2], v3 = op[3];
            u32x4 w0, w1;
            w0.x = pk2(v0.x * bflo(g0.x), v0.y * bfhi(g0.x)); w0.y = pk2(v0.z * bflo(g0.y), v0.w * bfhi(g0.y)); w0.z = pk2(v1.x * bflo(g0.z), v1.y * bfhi(g0.z)); w0.w = pk2(v1.z * bflo(g0.w), v1.w * bfhi(g0.w));
            w1.x = pk2(v2.x * bflo(g1.x), v2.y * bfhi(g1.x)); w1.y = pk2(v2.z * bflo(g1.y), v2.w * bfhi(g1.y)); w1.z = pk2(v3.x * bflo(g1.z), v3.y * bfhi(g1.z)); w1.w = pk2(v3.z * bflo(g1.w), v3.w * bfhi(g1.w));
            *(u32x4*)(ym + tok * 1024 + dc * 64 + qt * 16) = w0; *(u32x4*)(ym + tok * 1024 + dc * 64 + qt * 16 + 8) = w1;
        }
        __syncthreads();
    }
}

constexpr int KP = 144, VP = 192, KROWS = 384, LDS_VOFF = KROWS * KP;
struct AUnit { int b, hd, dil, L, r, i0; };
__device__ __forceinline__ AUnit attn_decode(int u, int hd0, int nh) {
    AUnit w; const int blk32 = u & 31; w.hd = hd0 + (u >> 5) % nh; w.b = u / (32 * nh);
    const int dsh = 2 * (w.hd >> 3), nbr = 32 >> dsh; w.dil = 1 << dsh; w.L = SEQ >> dsh; w.r = blk32 / nbr; w.i0 = (blk32 % nbr) * 256; return w;
}
__device__ __forceinline__ void attn_issue(const AUnit& w, const bf16_t* Qb, const bf16_t* Kb, const bf16_t* Vb, int tid, int wave, int lane, u32x4 (&kv)[6], u32x4 (&vv)[6]) {
    const int ch = tid & 7;
#pragma unroll
    for (int i = 0; i < 6; ++i) { const int row = (tid + 512 * i) >> 3; int pk = w.i0 - 64 + row; pk = pk < 0 ? 0 : (pk >= w.L ? w.L - 1 : pk);
        const size_t off = ((size_t)(w.b * 24 + w.hd) * SEQ + (size_t)(w.r * w.L + pk)) * 64 + ch * 8; kv[i] = *(const u32x4*)(Kb + off); vv[i] = *(const u32x4*)(Vb + off); }
}
__device__ __forceinline__ float attn_tile_exp(f32x16& st, int j, float tlf, float bsl, float rlo, float rhi) {
    float sum = 0.f;
#pragma unroll
    for (int i = 0; i < 16; ++i) { const float tmp = (float)(32 * j - 64 + (i & 3) + 8 * (i >> 2)) + tlf;
        float arg = __builtin_fmaf(-bsl, __builtin_fabsf(tmp), st[i]);
        arg = (tmp >= rlo && tmp <= rhi) ? arg : -1.0e30f;
        const float pe = __builtin_amdgcn_exp2f(arg); st[i] = pe; sum += pe; }
    return sum;
}
template <bool FUSED> __device__ __forceinline__ void attn_phase(const Args& a, LAS unsigned char* lds, int tid, int lane, int wave) {
    constexpr int HD0 = FUSED ? 0 : 8, NH = FUSED ? 8 : 16, NU = 8 * NH * 32;
    asm volatile("" : "+v"(tid), "+v"(lane));
    bf16_t* Qb = (bf16_t*)(a.ws + WS_Q); const bf16_t* Kb = (const bf16_t*)(a.ws + WS_K); const bf16_t* Vb = (const bf16_t*)(a.ws + WS_V); float* LSE = (float*)(a.ws + WS_LSE);
    const int h = lane >> 5, l31 = lane & 31;
    const int q = (lane & 15) >> 2, p = lane & 3, blk = (lane >> 4) & 1;
    int u = blockIdx.x;
    u32x4 kv[6], vv[6], qv[4];
#define ATTN_QLOAD(W) do { const bf16_t* qr_ = Qb + ((size_t)((W).b * 24 + (W).hd) * SEQ + (size_t)((W).r * (W).L + (W).i0 + 32 * wave + l31)) * 64; \
        _Pragma("unroll") for (int ks_ = 0; ks_ < 4; ++ks_) qv[ks_] = *(const u32x4*)(qr_ + 16 * ks_ + 8 * h); } while (0)
    if (u < NU) { const AUnit w0 = attn_decode(u, HD0, NH); attn_issue(w0, Qb, Kb, Vb, tid, wave, lane, kv, vv); ATTN_QLOAD(w0); }
    while (u < NU) {
        const AUnit w = attn_decode(u, HD0, NH);
        const int hd = w.hd, slot = hd & 7, L = w.L, i0 = w.i0;
        const int iq = i0 + 32 * wave + l31; const size_t tq = (size_t)w.b * SEQ + (size_t)iq * w.dil + w.r;
        bf16_t* qrow = Qb + ((size_t)(w.b * 24 + hd) * SEQ + (size_t)(w.r * L + iq)) * 64;
        {
            const int ch = tid & 7;
            const f32x4 g0 = *(const f32x4*)(a.kw + hd * 64 + ch * 8), g1 = *(const f32x4*)(a.kw + hd * 64 + ch * 8 + 4);
#pragma unroll
            for (int i = 0; i < 6; ++i) { const int row = (tid + 512 * i) >> 3;
                const float e0 = bflo(kv[i].x), e1 = bfhi(kv[i].x), e2 = bflo(kv[i].y), e3 = bfhi(kv[i].y), e4 = bflo(kv[i].z), e5 = bfhi(kv[i].z), e6 = bflo(kv[i].w), e7 = bfhi(kv[i].w);
                float ss = (e0 * e0 + e1 * e1) + (e2 * e2 + e3 * e3) + (e4 * e4 + e5 * e5) + (e6 * e6 + e7 * e7);
                ss += dpp_movf<0xB1>(ss); ss += dpp_movf<0x4E>(ss); ss += dpp_movf<0x141>(ss);
                const float rk = __builtin_amdgcn_rsqf(ss * (1.f / 64.f) + 1e-6f);
                u32x4 wv; wv.x = pk2(e0 * rk * g0.x, e1 * rk * g0.y); wv.y = pk2(e2 * rk * g0.z, e3 * rk * g0.w); wv.z = pk2(e4 * rk * g1.x, e5 * rk * g1.y); wv.w = pk2(e6 * rk * g1.z, e7 * rk * g1.w);
                *(LAS u32x4*)(lds + row * KP + ch * 16) = wv;
                *(LAS u32x4*)(lds + LDS_VOFF + row * VP + ch * 16) = vv[i];
                if (i & 1) __builtin_amdgcn_sched_barrier(0); }
        }
        bf16x8 qf[4];
        {
            float ss = 0.f;
#pragma unroll
            for (int ks = 0; ks < 4; ++ks)
#pragma unroll
                for (int e = 0; e < 4; ++e) { const float lo = bflo(qv[ks][e]), hi = bfhi(qv[ks][e]); ss += lo * lo + hi * hi; }
            ss += __shfl_xor(ss, 32);
            const float rq = 0.125f * LOG2E * __builtin_amdgcn_rsqf(ss * (1.f / 64.f) + 1e-6f);
#pragma unroll
            for (int ks = 0; ks < 4; ++ks) { const f32x4 g0 = *(const f32x4*)(a.qw + hd * 64 + 16 * ks + 8 * h), g1 = *(const f32x4*)(a.qw + hd * 64 + 16 * ks + 8 * h + 4); u32x4 wv;
                wv.x = pk2(bflo(qv[ks].x) * rq * g0.x, bfhi(qv[ks].x) * rq * g0.y); wv.y = pk2(bflo(qv[ks].y) * rq * g0.z, bfhi(qv[ks].y) * rq * g0.w);
                wv.z = pk2(bflo(qv[ks].z) * rq * g1.x, bfhi(qv[ks].z) * rq * g1.y); wv.w = pk2(bflo(qv[ks].w) * rq * g1.z, bfhi(qv[ks].w) * rq * g1.w);
                qf[ks] = __builtin_bit_cast(bf16x8, wv); }
        }
        const float mb = ((const float*)(a.ws + WS_RS))[hd];
        __syncthreads();
        const int un = u + gridDim.x;
        if (un < NU) { const AUnit wn = attn_decode(un, HD0, NH); attn_issue(wn, Qb, Kb, Vb, tid, wave, lane, kv, vv); }
        const float bsl = __builtin_amdgcn_exp2f(-(float)(slot + 1)) * (float)w.dil * LOG2E;
        int tl = 4 * h - l31; asm volatile("" : "+v"(tl));
        const float tlf = (float)tl;
        const int lo_i = -iq > -64 ? -iq : -64, hi_i = (L - 1 - iq) < 64 ? (L - 1 - iq) : 64;
        const float rlo = (float)lo_i, rhi = (float)hi_i;
        const int wq0 = i0 + 32 * wave;
        const bool edge = (wq0 < 64) || (wq0 + 32 > L - 64);
        float sum = 0.f;
        f32x16 o[2]; o[0] = f32x16{}; o[1] = f32x16{};
#pragma unroll
        for (int j = 0; j < 5; ++j) {
            f32x16 st;
#pragma unroll
            for (int i = 0; i < 16; ++i) st[i] = -mb;
            LAS const unsigned char* kp = lds + (32 * wave + 32 * j + l31) * KP + 16 * h;
#pragma unroll
            for (int ks = 0; ks < 4; ++ks) { const bf16x8 kf = *(LAS const bf16x8*)(kp + 32 * ks); st = __builtin_amdgcn_mfma_f32_32x32x16_bf16(kf, qf[ks], st, 0, 0, 0); }
            sum += attn_tile_exp(st, j, tlf, bsl, rlo, rhi);
#pragma unroll
            for (int s2 = 0; s2 < 2; ++s2) { u32x4 pw; pw.x = pk2(st[8 * s2 + 0], st[8 * s2 + 1]); pw.y = pk2(st[8 * s2 + 2], st[8 * s2 + 3]); pw.z = pk2(st[8 * s2 + 4], st[8 * s2 + 5]); pw.w = pk2(st[8 * s2 + 6], st[8 * s2 + 7]);
                const bf16x8 pf = __builtin_bit_cast(bf16x8, pw);
                LAS const unsigned char* vp = lds + LDS_VOFF + (32 * wave + 32 * j + 16 * s2 + 4 * h + q) * VP + 32 * blk + 8 * p;
#pragma unroll
                for (int dt = 0; dt < 2; ++dt) { const s16x4 lo = trrd(vp + dt * 64), hi = trrd(vp + 8 * VP + dt * 64);
                    const bf16x8 vf = __builtin_shufflevector(lo, hi, 0, 1, 2, 3, 4, 5, 6, 7);
                    o[dt] = __builtin_amdgcn_mfma_f32_32x32x16_bf16(vf, pf, o[dt], 0, 0, 0); } }
            __builtin_amdgcn_sched_barrier(0);
        }
        sum += __shfl_xor(sum, 32);
        if (un < NU) { const AUnit wq = attn_decode(un, HD0, NH); ATTN_QLOAD(wq); }
        const float inv = __builtin_amdgcn_rcpf(sum);
        {
            u32x4 fo1[4], fo2[4], fg[4]; float fl1[4], fl2[4];
            if constexpr (FUSED) {
                const bf16_t* Gb = (const bf16_t*)(a.ws + WS_G);
#pragma unroll
                for (int it = 0; it < 4; ++it) { const int r = 8 * it + (lane >> 3), c16 = lane & 7, t = i0 + 32 * wave + r; const size_t tokg = (size_t)w.b * SEQ + t;
                    fl1[it] = LSE[tokg * 24 + 8 + slot]; fl2[it] = LSE[tokg * 24 + 16 + slot];
                    fo1[it] = __builtin_nontemporal_load((const u32x4*)(Qb + ((size_t)(w.b * 24 + 8 + slot) * SEQ + (t & 3) * 2048 + (t >> 2)) * 64 + c16 * 8));
                    fo2[it] = __builtin_nontemporal_load((const u32x4*)(Qb + ((size_t)(w.b * 24 + 16 + slot) * SEQ + (t & 15) * 512 + (t >> 4)) * 64 + c16 * 8));
                    fg[it] = __builtin_nontemporal_load((const u32x4*)(Gb + tokg * 1024 + 512 + slot * 64 + c16 * 8)); }
            }
            LAS unsigned char* ost = lds + 129024 + wave * 4096;
#pragma unroll
            for (int dt = 0; dt < 2; ++dt)
#pragma unroll
                for (int ig = 0; ig < 4; ++ig) { u32x2 wv; wv.x = pk2(o[dt][4 * ig] * inv, o[dt][4 * ig + 1] * inv); wv.y = pk2(o[dt][4 * ig + 2] * inv, o[dt][4 * ig + 3] * inv);
                    const int p8 = 8 * dt + 2 * ig + h; *(LAS u32x2*)(ost + l31 * 128 + 8 * (p8 ^ (l31 & 15))) = wv; }
            if constexpr (FUSED) { if (h == 0) ((LAS float*)(lds + 161808))[wave * 32 + l31] = mb + __builtin_amdgcn_logf(sum); }
            asm volatile("s_waitcnt lgkmcnt(0)" ::: "memory");
            if constexpr (!FUSED) {
                bf16_t* obase = qrow - l31 * 64;
#pragma unroll
                for (int it = 0; it < 4; ++it) { const int r = 8 * it + (lane >> 3), c16 = lane & 7;
                    u32x4 v = *(LAS const u32x4*)(ost + r * 128 + 16 * (c16 ^ ((r & 15) >> 1)));
                    if (r & 1) { const unsigned t0 = v.x, t1 = v.y; v.x = v.z; v.y = v.w; v.z = t0; v.w = t1; }
                    *(u32x4*)(obase + (size_t)r * 64 + c16 * 8) = v; asm volatile("" ::: "memory"); }
            } else {
                bf16_t* ym = (bf16_t*)(a.ws + WS_Z);
#pragma unroll
                for (int it = 0; it < 4; ++it) { const int r = 8 * it + (lane >> 3), c16 = lane & 7;
                    u32x4 v = *(LAS const u32x4*)(ost + r * 128 + 16 * (c16 ^ ((r & 15) >> 1)));
                    if (r & 1) { const unsigned t0 = v.x, t1 = v.y; v.x = v.z; v.y = v.w; v.z = t0; v.w = t1; }
                    const int t = i0 + 32 * wave + r; const size_t tokg = (size_t)w.b * SEQ + t;
                    const float l0 = ((LAS const float*)(lds + 161808))[wave * 32 + r], l1 = fl1[it], l2 = fl2[it];
                    const float mxl = fmaxf(l0, fmaxf(l1, l2));
                    float w0 = __builtin_amdgcn_exp2f(l0 - mxl), w1 = __builtin_amdgcn_exp2f(l1 - mxl), w2 = __builtin_amdgcn_exp2f(l2 - mxl);
                    const float iw = 1.0f / (w0 + w1 + w2); w0 *= iw; w1 *= iw; w2 *= iw;
                    u32x4 ov;
#pragma unroll
                    for (int e = 0; e < 4; ++e) { const float lo = (bflo(v[e]) * w0 + bflo(fo1[it][e]) * w1 + bflo(fo2[it][e]) * w2) * bflo(fg[it][e]); const float hi = (bfhi(v[e]) * w0 + bfhi(fo1[it][e]) * w1 + bfhi(fo2[it][e]) * w2) * bfhi(fg[it][e]); ov[e] = pk2(lo, hi); }
                    *(u32x4*)(ym + tokg * 1024 + 512 + slot * 64 + c16 * 8) = ov; }
            }
        }
        if constexpr (!FUSED) { if (h == 0) LSE[tq * 24 + hd] = mb + __builtin_amdgcn_logf(sum); }
        __syncthreads();
        u = un;
    }
}
__device__ __forceinline__ void merge_phase(const Args& a, int lane, int wave) {
    asm volatile("" : "+v"(lane));
    const bf16_t* Ob = (const bf16_t*)(a.ws + WS_Q); const bf16_t* Gb = (const bf16_t*)(a.ws + WS_G); const float* LSE = (const float*)(a.ws + WS_LSE); bf16_t* ym = (bf16_t*)(a.ws + WS_Z);
    const int gw = blockIdx.x * 8 + wave, NGW = gridDim.x * 8, slot = lane >> 3;
    for (int tok0 = gw; tok0 < MTOK; tok0 += 2 * NGW) {
        u32x4 o0[2], o1[2], o2[2], g[2]; float l0[2], l1[2], l2[2];
#pragma unroll
        for (int z = 0; z < 2; ++z) { int tok = tok0 + z * NGW; tok = tok < MTOK ? tok : tok0;
            l0[z] = LSE[(size_t)tok * 24 + slot]; l1[z] = LSE[(size_t)tok * 24 + 8 + slot]; l2[z] = LSE[(size_t)tok * 24 + 16 + slot];
            const int b = tok >> 13, t = tok & (SEQ - 1), part = lane & 7;
            o0[z] = __builtin_nontemporal_load((const u32x4*)(Ob + ((size_t)(b * 24 + slot) * SEQ + t) * 64 + part * 8));
            o1[z] = __builtin_nontemporal_load((const u32x4*)(Ob + ((size_t)(b * 24 + 8 + slot) * SEQ + (t & 3) * 2048 + (t >> 2)) * 64 + part * 8));
            o2[z] = __builtin_nontemporal_load((const u32x4*)(Ob + ((size_t)(b * 24 + 16 + slot) * SEQ + (t & 15) * 512 + (t >> 4)) * 64 + part * 8));
            g[z] = __builtin_nontemporal_load((const u32x4*)(Gb + (size_t)tok * 1024 + 512 + lane * 8)); }
#pragma unroll
        for (int z = 0; z < 2; ++z) { const int tok = tok0 + z * NGW; if (tok >= MTOK) break;
            const float mx = fmaxf(l0[z], fmaxf(l1[z], l2[z]));
            float w0 = __builtin_amdgcn_exp2f(l0[z] - mx), w1 = __builtin_amdgcn_exp2f(l1[z] - mx), w2 = __builtin_amdgcn_exp2f(l2[z] - mx);
            const float inv = 1.0f / (w0 + w1 + w2); w0 *= inv; w1 *= inv; w2 *= inv;
            u32x4 w;
#pragma unroll
            for (int e = 0; e < 4; ++e) { const float lo = (bflo(o0[z][e]) * w0 + bflo(o1[z][e]) * w1 + bflo(o2[z][e]) * w2) * bflo(g[z][e]); const float hi = (bfhi(o0[z][e]) * w0 + bfhi(o1[z][e]) * w1 + bfhi(o2[z][e]) * w2) * bfhi(g[z][e]); w[e] = pk2(lo, hi); }
            *(u32x4*)(ym + (size_t)tok * 1024 + 512 + lane * 8) = w; }
    }
}

#define XB_TMO      128
#define XB_XCNT(j)  (256  + 64 * (j))
#define XB_XSUB(j)  (1280 + 64 * (j))
#define XB_XGEN(j)  (2304 + 64 * (j))
#define XB_TOP      3328
#define XB_TOPGEN   3392
#define XCD_BAR_WORDS 3456
#define XB_SPIN_CAP (1u << 18)

__device__ __forceinline__ unsigned xb_ld(unsigned* p)              { return __hip_atomic_load(p, __ATOMIC_RELAXED, __HIP_MEMORY_SCOPE_AGENT); }
__device__ __forceinline__ unsigned xb_add(unsigned* p, unsigned v) { return __hip_atomic_fetch_add(p, v, __ATOMIC_RELAXED, __HIP_MEMORY_SCOPE_AGENT); }
__device__ __forceinline__ unsigned xb_xcc_id() { return (unsigned)__builtin_amdgcn_s_getreg((3 << 11) | 20) & 0xFu; }
#define XB_SPIN(cond, bar) do { unsigned _sp = 0; while (cond) { __builtin_amdgcn_s_sleep(1); \
    if ((++_sp & 255u) == 0u) { if (xb_ld(&(bar)[XB_TMO])) break; if (_sp > XB_SPIN_CAP) { atomicAdd(&(bar)[XB_TMO], 1u); break; } } } } while (0)

struct XcdBarrier {
    unsigned* bar; unsigned x;
    volatile LAS unsigned* st;
};

__device__ __forceinline__ XcdBarrier xcd_barrier_post(unsigned* bar, volatile LAS unsigned* st) {
    XcdBarrier b; b.bar = bar; b.x = xb_xcc_id(); b.st = st;
    if (threadIdx.x == 0) (void)xb_add(&bar[XB_XCNT(b.x)], 1u);
    return b;
}
__device__ __forceinline__ void xcd_barrier_complete(unsigned* bar, unsigned x, unsigned& nloc, unsigned& nx) {
    const unsigned G = gridDim.x * gridDim.y * gridDim.z;
    unsigned sum, cnt, mine, sp = 0u;
    for (;;) {
        sum = 0u; cnt = 0u; mine = 0u;
#pragma unroll
        for (unsigned j = 0; j < 16; ++j) { const unsigned c = xb_ld(&bar[XB_XCNT(j)]); sum += c; cnt += (c > 0u) ? 1u : 0u; mine = (j == x) ? c : mine; }
        if (sum == G) break;
        __builtin_amdgcn_s_sleep(1);
        if ((++sp & 255u) == 0u) { if (xb_ld(&bar[XB_TMO])) break; if (sp > XB_SPIN_CAP) { atomicAdd(&bar[XB_TMO], 1u); break; } }
    }
    nloc = mine > 0u ? mine : 1u; nx = cnt > 0u ? cnt : 1u;
}

__device__ __forceinline__ void xcd_barrier(const XcdBarrier& b) {
    asm volatile("s_waitcnt vmcnt(0)" ::: "memory");
    __syncthreads();
    if (threadIdx.x == 0) {
        unsigned* bar = b.bar;
        __builtin_amdgcn_s_waitcnt(0);
        unsigned nloc = b.st[0], nx = b.st[1];
        if (nloc == 0u) { xcd_barrier_complete(bar, b.x, nloc, nx); b.st[0] = nloc; b.st[1] = nx; }
        const unsigned old = xb_add(&bar[XB_XSUB(b.x)], 1u);
        const unsigned gen = old / nloc;
        if (old + 1u == (gen + 1u) * nloc) {
            __builtin_amdgcn_fence(__ATOMIC_RELEASE, "agent");
            asm volatile("s_waitcnt vmcnt(0)" ::: "memory");
            const unsigned og = xb_add(&bar[XB_TOP], 1u);
            const unsigned tg = og / nx;
            if (og + 1u == (tg + 1u) * nx) xb_add(&bar[XB_TOPGEN], 1u);
            else XB_SPIN(xb_ld(&bar[XB_TOPGEN]) == tg, bar);
            __builtin_amdgcn_fence(__ATOMIC_ACQUIRE, "agent");
            xb_add(&bar[XB_XGEN(b.x)], 1u);
            asm volatile("s_waitcnt vmcnt(0)" ::: "memory");
        } else {
            XB_SPIN(xb_ld(&bar[XB_XGEN(b.x)]) == gen, bar);
            __builtin_amdgcn_fence(__ATOMIC_ACQUIRE, "agent");
            asm volatile("s_waitcnt vmcnt(0)" ::: "memory");
        }
    }
    __syncthreads();
}

__global__ void __launch_bounds__(512, 2) mega_fwd(Args a) {
    extern __shared__ __attribute__((aligned(16))) unsigned char lds_raw[];
    LAS unsigned char* lds = (LAS unsigned char*)lds_raw;
    cg::grid_group grid = cg::this_grid();
    const int tid = threadIdx.x, lane = tid & 63, wave = __builtin_amdgcn_readfirstlane(tid >> 6);
    volatile LAS unsigned* bst = (volatile LAS unsigned*)(lds + 161792);
    if (tid < 2) bst[tid] = 0u;
    __syncthreads();
    XcdBarrier bar = xcd_barrier_post((unsigned*)(a.ws + WS_BAR), bst);
    if (a.ws == nullptr) grid.sync();
#ifndef REP0
#define REP0 1
#define REP1 1
#define REPD1 1
#define REPD2 1
#define REPM 1
#define REP4 1
#endif
    for (int rep = 0; rep < REP0; ++rep) phase0(a, lds, tid, lane, wave);
    xcd_barrier(bar);
    {
        pg8::Gemm g{(const pg8::bf16_t*)(a.ws + WS_XB), (const pg8::bf16_t*)(a.ws + WS_WT), MTOK, NIN, DM}; pg8::StaticOrder S; S.init(MTOK, NIN, gridDim.x, (int)blockIdx.x, REP1);
        Epi1 E{(bf16_t*)(a.ws + WS_Z), (bf16_t*)(a.ws + WS_G), (bf16_t*)(a.ws + WS_Q), (bf16_t*)(a.ws + WS_K), (bf16_t*)(a.ws + WS_V)};
        pg8::gemm_phase<Epi1, pg8::StaticOrder, true, true>(lds, g, S, E);
    }
    xcd_barrier(bar);
    attn_phase<false>(a, lds, tid, lane, wave);
    for (int rep = 0; rep < REPD1; ++rep) dft1_phase(a, lds, tid, lane, wave);
    xcd_barrier(bar);
    for (int rep = 0; rep < REPD2; ++rep) dft2_phase(a, lds, tid, lane, wave);
    attn_phase<true>(a, lds, tid, lane, wave);
    xcd_barrier(bar);
    {
        pg8::Gemm g{(const pg8::bf16_t*)(a.ws + WS_Z), (const pg8::bf16_t*)(a.ws + WS_WOT), MTOK, DM, DM}; pg8::StaticOrder S; S.init(MTOK, DM, gridDim.x, (int)blockIdx.x, REP4);
        Epi2 E{a.x, a.out};
        pg8::gemm_phase<Epi2, pg8::StaticOrder, true, true>(lds, g, S, E);
    }
}

extern "C" void kernel_launch(void* const* d_in, const int* in_sizes, int n_in, void* d_out, int out_size, void* d_ws, size_t ws_size, hipStream_t stream) {
    static int grid = 0;
    if (grid == 0) {
        if (n_in != 7 || in_sizes[0] != MTOK * DM || out_size != MTOK * DM || ws_size < WS_END) { fprintf(stderr, "kernel_launch: unexpected shapes / workspace (%d inputs, ws %zu)\n", n_in, ws_size); grid = -1; return; }
        int dev = 0, cus = 0, per_cu = 0;
        hipGetDevice(&dev); hipDeviceGetAttribute(&cus, hipDeviceAttributeMultiprocessorCount, dev);
        hipFuncSetAttribute((const void*)mega_fwd, hipFuncAttributeMaxDynamicSharedMemorySize, LDS_BYTES);
        hipOccupancyMaxActiveBlocksPerMultiprocessor(&per_cu, (const void*)mega_fwd, 512, LDS_BYTES);
        if (per_cu < 1) { fprintf(stderr, "kernel_launch: occupancy query says %d blocks per CU\n", per_cu); per_cu = 1; }
        grid = cus;
        (void)hipGetLastError();
    }
    if (grid < 0) return;
    Args a{};
    a.x = (const float*)d_in[0]; a.norm_w = (const float*)d_in[1]; a.w_in = (const float*)d_in[2]; a.qw = (const float*)d_in[3]; a.kw = (const float*)d_in[4];
    a.wf = (const float*)d_in[5]; a.w_out = (const float*)d_in[6]; a.out = (float*)d_out; a.ws = (unsigned char*)d_ws;
    if (hipMemsetAsync((char*)d_ws + WS_BAR, 0, 16384, stream) != hipSuccess) { fprintf(stderr, "kernel_launch: memset of the barrier words failed\n"); return; }
    void* args[] = {&a};
    hipError_t e = hipLaunchCooperativeKernel((const void*)mega_fwd, dim3(grid), dim3(512), args, LDS_BYTES, stream);
    if (e != hipSuccess) fprintf(stderr, "cooperative launch failed: %s (grid %d)\n", hipGetErrorString(e), grid);
}
```

```cpp
#include <hip/hip_runtime.h>
#include <hip/hip_cooperative_groups.h>
#include <cstdio>
#include <cstdint>
namespace cg = cooperative_groups;
namespace pg8 {
#define PG8_LAS __attribute__((address_space(3)))
typedef unsigned short bf16_t;
typedef short bf16x8 __attribute__((ext_vector_type(8)));
typedef float f32x4 __attribute__((ext_vector_type(4)));
typedef unsigned u32x4 __attribute__((ext_vector_type(4)));
constexpr int BM = 256, BK = 64, HALF = 128, HTB = HALF * BK * 2  , STAGE_BYTES = 8 * HTB, NXCD = 8, WGM = 8;

__host__ __device__ __forceinline__ int lds_byte(int r, int c) { const int st = (r >> 4) * 2 + (c >> 5), rr = r & 15, cc = c & 31, ob = rr * 64 + cc * 2; return st * 1024 + (ob ^ (((ob >> 9) & 1) << 5)); }
__host__ __device__ __forceinline__ void stage_rc(int b, int& R, int& C) { const int st = b / 1024, sb = b % 1024, swz = sb ^ (((sb >> 9) & 1) << 5); R = (st >> 1) * 16 + swz / 64; C = (st & 1) * 32 + (swz % 64) / 2; }
__host__ __device__ __forceinline__ int perm32(int rho) { const int n = rho >> 4, i = rho & 15; return 8 * (i >> 2) + 4 * n + (i & 3); }

struct Unit { int pm, pn; };
struct Gemm { const bf16_t* A; const bf16_t* Bt; int M, N, K; };

struct StaticOrder {
    int nM, nN, nwg, G, c, rep;
    __host__ __device__ void init(int M, int N, int G_, int c_, int rep_ = 1) { nM = M / BM; nN = N / BM; nwg = nM * nN; G = G_; c = c_; rep = rep_; }
    __host__ __device__ bool next(int i, Unit& u) const {
        const int per = (nwg + G - 1) / G; if (i >= per * rep) return false; const long L = (long)(i % per) * G + c; if (L >= nwg) return false;
        int wgid = (int)L; { const int q = nwg / NXCD, r = nwg % NXCD, xcd = wgid % NXCD, off = wgid / NXCD; wgid = (xcd < r ? xcd * (q + 1) : r * (q + 1) + (xcd - r) * q) + off; }
        const int nig = WGM * nN, gid = wgid / nig, fm = gid * WGM, gsz = (nM - fm) < WGM ? (nM - fm) : WGM;
        u.pm = fm + ((wgid % nig) % gsz); u.pn = (wgid % nig) / gsz; return true;
    }
    __device__ __forceinline__ void a_ready(const Unit&) const {}
    __device__ __forceinline__ void done(const Unit&) const {}
};

__device__ __forceinline__ unsigned cvt_pk_bf16(float lo, float hi) { unsigned r; asm volatile("v_cvt_pk_bf16_f32 %0, %1, %2" : "=v"(r) : "v"(lo), "v"(hi)); return r; }
typedef float f32x2 __attribute__((ext_vector_type(2)));
template <class Epi, class Sched, bool ALIGN_EPI = false, bool SP2 = false>
__device__ __forceinline__ void gemm_phase(PG8_LAS unsigned char* lds, const Gemm g, const Sched& S, const Epi& E) {
    const int tid = threadIdx.x, wid = __builtin_amdgcn_readfirstlane(tid >> 6), lane = tid & 63, wr = wid >> 2, wc = wid & 3, fr = lane & 15, fq = lane >> 4;
    const int K = g.K, nt = K / BK;
    unsigned voffA[2], voffB[2];
#pragma unroll
    for (int i = 0; i < 2; ++i) { int R, C; stage_rc(tid * 16 + i * 8192, R, C); const int Rb = Epi::PERM2 ? (64 * (R >> 5) + perm32(R & 31)) : (Epi::PERM ? ((R & ~31) + perm32(R & 31)) : R);
        voffA[i] = (unsigned)(R * K + C) * 2u; voffB[i] = (unsigned)(Rb * K + C) * 2u; }
    const size_t kstep = (size_t)(BK * 2);
    const size_t hstep = (size_t)HALF * K * 2;
    const size_t hstepB = Epi::PERM2 ? (size_t)32 * K * 2 : hstep;
    const size_t tstep = 2 * hstep;
    const unsigned ldsw = (unsigned)wid * 1024u;
    const int aoff = lds_byte(wr * 64 + fr, fq * 8), boff = lds_byte(wc * 32 + fr, fq * 8);
#define PG8_SA(b, h) (((b) * 2 + (h)) * HTB)
#define PG8_SB(b, h) ((4 + (b) * 2 + (h)) * HTB)
#define PG8_STAGE(bufoff, gbase, voff) do { _Pragma("unroll") for (int _i = 0; _i < 2; ++_i) \
        __builtin_amdgcn_global_load_lds((const unsigned*)((const char*)(gbase) + (voff)[_i]), (PG8_LAS unsigned*)(lds + (bufoff) + ldsw + _i * 8192), 16, 0, 0); } while (0)
#define PG8_LDA(dst, b, h) do { _Pragma("unroll") for (int m = 0; m < 4; ++m) _Pragma("unroll") for (int k = 0; k < 2; ++k) dst[m][k] = *(const PG8_LAS bf16x8*)(lds + PG8_SA(b, h) + aoff + m * 2048 + k * 1024); } while (0)
#define PG8_LDB(dst, b, h) do { _Pragma("unroll") for (int n = 0; n < 2; ++n) _Pragma("unroll") for (int k = 0; k < 2; ++k) dst[n][k] = *(const PG8_LAS bf16x8*)(lds + PG8_SB(b, h) + boff + n * 2048 + k * 1024); } while (0)
#define PG8_MMA(ai, bj, At, Bt) do { __builtin_amdgcn_s_setprio(1); _Pragma("unroll") for (int m = 0; m < 4; ++m) _Pragma("unroll") for (int n = 0; n < 2; ++n) _Pragma("unroll") for (int k = 0; k < 2; ++k) \
        acc[ai][bj][m][n] = __builtin_amdgcn_mfma_f32_16x16x32_bf16(Bt[n][k], At[m][k], acc[ai][bj][m][n], 0, 0, 0); __builtin_amdgcn_s_setprio(0); } while (0)
#define PG8_WAIT_V(n) asm volatile("s_waitcnt vmcnt(" #n ")" ::: "memory")
#define PG8_WAIT_L(n) asm volatile("s_waitcnt lgkmcnt(" #n ")" ::: "memory")
#define PG8_BAR __builtin_amdgcn_s_barrier()
#define PG8_SCHED __builtin_amdgcn_sched_barrier(0)
    Unit cur, nxt; int ui = 0;
    if (!S.next(0, cur)) return;
    f32x4 acc[2][2][4][2];
#pragma unroll
    for (int a = 0; a < 2; ++a)
#pragma unroll
        for (int b = 0; b < 2; ++b)
#pragma unroll
            for (int m = 0; m < 4; ++m)
#pragma unroll
                for (int n = 0; n < 2; ++n) acc[a][b][m][n] = (f32x4){0.f, 0.f, 0.f, 0.f};
    bf16x8 At[4][2], B0[2][2], B1[2][2];
    const char* cA = (const char*)g.A + (size_t)cur.pm * tstep; const char* cB = (const char*)g.Bt + (size_t)cur.pn * tstep;
    S.a_ready(cur);
    if constexpr (SP2) {
        PG8_STAGE(PG8_SB(0, 0), cB, voffB); PG8_STAGE(PG8_SB(0, 1), cB + hstepB, voffB); PG8_STAGE(PG8_SA(0, 0), cA, voffA); PG8_STAGE(PG8_SA(0, 1), cA + hstep, voffA);
        if (wr == 1) PG8_BAR;
        PG8_WAIT_V(2); PG8_BAR;
        PG8_STAGE(PG8_SB(1, 0), cB + kstep, voffB); PG8_STAGE(PG8_SA(1, 0), cA + kstep, voffA); PG8_STAGE(PG8_SB(1, 1), cB + hstepB + kstep, voffB);
        PG8_WAIT_V(6); PG8_BAR;
    } else {
        PG8_STAGE(PG8_SB(0, 0), cB, voffB); PG8_STAGE(PG8_SA(0, 0), cA, voffA); PG8_STAGE(PG8_SB(0, 1), cB + hstepB, voffB); PG8_STAGE(PG8_SA(0, 1), cA + hstep, voffA);
        if (wr == 1) PG8_BAR;
        PG8_WAIT_V(4); PG8_BAR;
        PG8_STAGE(PG8_SB(1, 0), cB + kstep, voffB); PG8_STAGE(PG8_SA(1, 0), cA + kstep, voffA); PG8_STAGE(PG8_SB(1, 1), cB + hstepB + kstep, voffB);
        PG8_WAIT_V(6); PG8_BAR;
    }
    for (;;) {
        const bool has_next = S.next(ui + 1, nxt);
        const char* nA = has_next ? (const char*)g.A + (size_t)nxt.pm * tstep : cA; const char* nB = has_next ? (const char*)g.Bt + (size_t)nxt.pn * tstep : cB;
        for (int t = 0; t < nt; t += 2) {
            const bool last = (t == nt - 2);
            const char* a1 = cA + (size_t)(t + 1) * kstep;
            const char* a2 = last ? nA : cA + (size_t)(t + 2) * kstep; const char* b2 = last ? nB : cB + (size_t)(t + 2) * kstep;
            const char* a3 = a2 + kstep; const char* b3 = b2 + kstep;
            if (last && has_next) S.a_ready(nxt);
            if constexpr (SP2) {
            PG8_LDB(B0, 0, 0); PG8_LDB(B1, 0, 1); PG8_SCHED; PG8_LDA(At, 0, 0); PG8_STAGE(PG8_SA(1, 1), a1 + hstep, voffA);
            PG8_WAIT_V(8); PG8_WAIT_L(0); PG8_BAR; PG8_MMA(0, 0, At, B0); PG8_MMA(0, 1, At, B1); PG8_BAR; PG8_SCHED;
            PG8_LDA(At, 0, 1); PG8_STAGE(PG8_SB(0, 0), b2, voffB); PG8_STAGE(PG8_SB(0, 1), b2 + hstepB, voffB); PG8_STAGE(PG8_SA(0, 0), a2, voffA);
            PG8_WAIT_V(8); PG8_WAIT_L(0); PG8_BAR; PG8_MMA(1, 0, At, B0); PG8_MMA(1, 1, At, B1); PG8_BAR; PG8_SCHED;
            PG8_LDB(B0, 1, 0); PG8_LDB(B1, 1, 1); PG8_SCHED; PG8_LDA(At, 1, 0); PG8_STAGE(PG8_SA(0, 1), a2 + hstep, voffA);
            PG8_WAIT_V(8); PG8_WAIT_L(0); PG8_BAR; PG8_MMA(0, 0, At, B0); PG8_MMA(0, 1, At, B1); PG8_BAR; PG8_SCHED;
            PG8_LDA(At, 1, 1); PG8_STAGE(PG8_SB(1, 0), b3, voffB); PG8_STAGE(PG8_SB(1, 1), b3 + hstepB, voffB); PG8_STAGE(PG8_SA(1, 0), a3, voffA);
            PG8_WAIT_V(8); PG8_WAIT_L(0); PG8_BAR; PG8_MMA(1, 0, At, B0); PG8_MMA(1, 1, At, B1); PG8_BAR; PG8_SCHED;
            } else {
            PG8_LDB(B0, 0, 0); PG8_SCHED; PG8_LDA(At, 0, 0); PG8_STAGE(PG8_SA(1, 1), a1 + hstep, voffA);
            PG8_WAIT_L(8); PG8_BAR; PG8_WAIT_L(0); PG8_MMA(0, 0, At, B0); PG8_BAR; PG8_SCHED;
            PG8_LDB(B1, 0, 1); PG8_STAGE(PG8_SB(0, 0), b2, voffB);
            PG8_BAR; PG8_WAIT_L(0); PG8_MMA(0, 1, At, B1); PG8_BAR;
            PG8_LDA(At, 0, 1); PG8_STAGE(PG8_SA(0, 0), a2, voffA);
            PG8_BAR; PG8_WAIT_L(0); PG8_MMA(1, 0, At, B0); PG8_BAR; PG8_SCHED;
            PG8_STAGE(PG8_SB(0, 1), b2 + hstepB, voffB);
            PG8_WAIT_V(6); PG8_BAR; PG8_MMA(1, 1, At, B1); PG8_BAR;
            PG8_LDB(B0, 1, 0); PG8_SCHED; PG8_LDA(At, 1, 0); PG8_STAGE(PG8_SA(0, 1), a2 + hstep, voffA);
            PG8_WAIT_L(8); PG8_BAR; PG8_WAIT_L(0); PG8_MMA(0, 0, At, B0); PG8_BAR; PG8_SCHED;
            PG8_LDB(B1, 1, 1); PG8_STAGE(PG8_SB(1, 0), b3, voffB);
            PG8_BAR; PG8_WAIT_L(0); PG8_MMA(0, 1, At, B1); PG8_BAR;
            PG8_LDA(At, 1, 1); PG8_STAGE(PG8_SA(1, 0), a3, voffA);
            PG8_BAR; PG8_WAIT_L(0); PG8_MMA(1, 0, At, B0); PG8_BAR; PG8_SCHED;
            PG8_STAGE(PG8_SB(1, 1), b3 + hstepB, voffB);
            PG8_WAIT_V(6); PG8_BAR; PG8_MMA(1, 1, At, B1); PG8_BAR;
            }
        }
        if constexpr (ALIGN_EPI) { if (wr == 0) PG8_BAR; }
        if constexpr (!Epi::AFTER_DRAIN) { E(acc, cur, wr, wc, fr, fq); S.done(cur); }
        if (!has_next) break;
#pragma unroll
        for (int a = 0; a < 2; ++a)
#pragma unroll
            for (int b = 0; b < 2; ++b)
#pragma unroll
                for (int m = 0; m < 4; ++m)
#pragma unroll
                    for (int n = 0; n < 2; ++n) acc[a][b][m][n] = (f32x4){0.f, 0.f, 0.f, 0.f};
        cur = nxt; cA = nA; cB = nB; ++ui;
        if constexpr (ALIGN_EPI) { if (wr == 1) PG8_BAR; }
    }
    PG8_WAIT_V(0);
    if constexpr (!ALIGN_EPI) { if (wr == 0) PG8_BAR; }
    PG8_BAR;
    if constexpr (Epi::AFTER_DRAIN) { E.fused(acc, cur, wr, wc, fr, fq, lds, wid, lane); S.done(cur); }
#undef PG8_SA
#undef PG8_SB
#undef PG8_STAGE
#undef PG8_LDA
#undef PG8_LDB
#undef PG8_MMA
#undef PG8_WAIT_V
#undef PG8_WAIT_L
#undef PG8_BAR
#undef PG8_SCHED
}
}
#define LAS __attribute__((address_space(3)))
typedef unsigned short bf16_t;
typedef short bf16x8 __attribute__((ext_vector_type(8)));
typedef short s16x4 __attribute__((ext_vector_type(4)));
typedef short v4i16_t __attribute__((ext_vector_type(4)));
typedef float f32x4 __attribute__((ext_vector_type(4)));
typedef float f32x16 __attribute__((ext_vector_type(16)));
typedef unsigned u32x4 __attribute__((ext_vector_type(4)));
typedef unsigned u32x2 __attribute__((ext_vector_type(2)));

constexpr int SEQ = 8192, DM = 1024, MTOK = 65536, NIN = 6144, QKVW = 1536;
constexpr size_t WS_WT = 0, WS_WOT = 13631488, WS_RS = 15728640, WS_LSE = 15990784, WS_BAR = 23068672, WS_GMT = 24117248, WS_XB = 33554432, WS_Z = 167772160, WS_G = 301989888,
                 WS_Q = 436207616, WS_K = 637534208, WS_V = 838860800, WS_END = 1040187392;
constexpr int LDS_BYTES = 162944;
constexpr float LOG2E = 1.4426950408889634f;

__device__ __forceinline__ unsigned f2bf(float f) { unsigned u = __builtin_bit_cast(unsigned, f); return (u + 0x7fffu + ((u >> 16) & 1u)) >> 16; }
typedef float f32x2_t __attribute__((ext_vector_type(2))); typedef __bf16 bf16x2_t __attribute__((ext_vector_type(2)));
__device__ __forceinline__ unsigned pk2(float lo, float hi) { f32x2_t v = {lo, hi}; bf16x2_t b = __builtin_convertvector(v, bf16x2_t); return __builtin_bit_cast(unsigned, b); }
__device__ __forceinline__ float bflo(unsigned w) { return __builtin_bit_cast(float, w << 16); }
__device__ __forceinline__ float bfhi(unsigned w) { return __builtin_bit_cast(float, w & 0xffff0000u); }
__device__ __forceinline__ int crow(int r, int hi) { return (r & 3) + 8 * (r >> 2) + 4 * hi; }
__device__ __forceinline__ float wave_sum(float v) {
#pragma unroll
    for (int o = 1; o < 64; o <<= 1) v += __shfl_xor(v, o);
    return v;
}
__device__ __forceinline__ s16x4 trrd(LAS const unsigned char* p) { return __builtin_bit_cast(s16x4, __builtin_amdgcn_ds_read_tr16_b64_v4i16((LAS v4i16_t*)p)); }
__device__ __forceinline__ float silu_f(float v) { return v * __builtin_amdgcn_rcpf(1.f + __builtin_amdgcn_exp2f(-v * LOG2E)); }
#define LDS_WAIT() asm volatile("s_waitcnt lgkmcnt(0)" ::: "memory")
template <int CTRL> __device__ __forceinline__ unsigned dpp_mov(unsigned v) { return (unsigned)__builtin_amdgcn_update_dpp(0, (int)v, CTRL, 0xF, 0xF, true); }
template <int CTRL> __device__ __forceinline__ float dpp_movf(float v) { return __builtin_bit_cast(float, dpp_mov<CTRL>(__builtin_bit_cast(unsigned, v))); }

struct Args { const float *x, *norm_w, *w_in, *qw, *kw, *wf, *w_out; float* out; unsigned char* ws; };

__device__ __forceinline__ void transpose_item(const float* W, int ldw, int ncol0, bf16_t* WT, int row_off, const float* kscale, LAS float* scr, int kb, int nb, int lane) {
    const int k0 = 64 * kb, n0 = 32 * nb;
#pragma unroll 8
    for (int i = 0; i < 32; ++i) { const int kk = 2 * i + (lane >> 5); float v = W[(size_t)(k0 + kk) * ldw + ncol0 + n0 + (lane & 31)]; if (kscale) v *= kscale[k0 + kk]; scr[kk * 33 + (lane & 31)] = v; }
    LDS_WAIT();
    const int c = lane & 7;
#pragma unroll
    for (int j = 0; j < 4; ++j) { const int n = (lane >> 3) + 8 * j; const LAS float* s = scr + (8 * c) * 33 + n;
        u32x4 o; o.x = pk2(s[0 * 33], s[1 * 33]); o.y = pk2(s[2 * 33], s[3 * 33]); o.z = pk2(s[4 * 33], s[5 * 33]); o.w = pk2(s[6 * 33], s[7 * 33]);
        *(u32x4*)(WT + (size_t)(row_off + n0 + n) * 1024 + k0 + 8 * c) = o; }
    LDS_WAIT();
}
__device__ __forceinline__ void gmt_unit(const Args& a, LAS unsigned char* lds, int unit, int tid) {
    bf16_t* GmT = (bf16_t*)(a.ws + WS_GMT);
    LAS float* tab = (LAS float*)lds;
    if (tid < 64) { float sn, cs; sincospif((float)tid * (1.f / 32.f), &sn, &cs); tab[2 * tid] = cs; tab[2 * tid + 1] = sn; }
    __syncthreads();
    const int g = unit >> 2, d = 16 * (unit & 3) + (tid >> 5), c32 = tid & 31;
    float acc[4] = {0.f, 0.f, 0.f, 0.f};
    for (int l = 0; l < 64; ++l) { const float w = a.wf[(size_t)(g * 64 + l) * 64 + d];
#pragma unroll
        for (int e = 0; e < 4; ++e) { const int cc = c32 * 4 + e, c = cc & 63, idx = (l * c) & 63; acc[e] += w * (cc < 64 ? tab[2 * idx] : -tab[2 * idx + 1]); } }
#pragma unroll
    for (int e = 0; e < 4; ++e) GmT[(size_t)(g * 64 + d) * 128 + c32 * 4 + e] = (bf16_t)f2bf(acc[e] * 0.125f);
    __syncthreads();
}
__device__ __forceinline__ void phase0(const Args& a, LAS unsigned char* lds, int tid, int lane, int wave) {
    bf16_t* Wt = (bf16_t*)(a.ws + WS_WT); bf16_t* WoT = (bf16_t*)(a.ws + WS_WOT); bf16_t* xb = (bf16_t*)(a.ws + WS_XB);
    const int G = gridDim.x, bx = blockIdx.x;
    for (int u = bx; u < 32; u += G) gmt_unit(a, lds, u, tid);
    if (bx == G - 1 && wave < 3) {
        for (int hd = wave * 8; hd < wave * 8 + 8; ++hd) {
            float gqm = fabsf(a.qw[hd * 64 + lane]), gkm = fabsf(a.kw[hd * 64 + lane]);
#pragma unroll
            for (int o = 1; o < 64; o <<= 1) { gqm = fmaxf(gqm, __shfl_xor(gqm, o)); gkm = fmaxf(gkm, __shfl_xor(gkm, o)); }
            if (lane == 0) ((float*)(a.ws + WS_RS))[hd] = 8.08f * LOG2E * gqm * gkm;
        }
    }
    LAS float* scr = (LAS float*)(lds + 32768 + wave * 8448);
    const int gw = bx * 8 + wave, NGW = G * 8;
    constexpr int I_IN = 16 * 192, I_OUT = 16 * 32;
    for (int it = gw; it < I_IN + I_OUT; it += NGW) {
        if (it < I_IN) transpose_item(a.w_in, 6144, 0, Wt, 0, a.norm_w, scr, it / 192, it % 192, lane);
        else { const int r = it - I_IN; transpose_item(a.w_out, 1024, 0, WoT, 0, nullptr, scr, r / 32, r % 32, lane); }
    }
    for (int row = gw; row < MTOK; row += 2 * NGW) {
        const int row2 = row + NGW; const bool has2 = row2 < MTOK;
        const f32x4* xr = (const f32x4*)(a.x + (size_t)row * DM) + lane; const f32x4* xr2 = (const f32x4*)(a.x + (size_t)(has2 ? row2 : row) * DM) + lane;
        f32x4 v[4], v2[4]; float s = 0.f, s2 = 0.f;
#pragma unroll
        for (int j = 0; j < 4; ++j) { v[j] = __builtin_nontemporal_load(xr + 64 * j); v2[j] = __builtin_nontemporal_load(xr2 + 64 * j); }
#pragma unroll
        for (int j = 0; j < 4; ++j) { s += (v[j].x * v[j].x + v[j].y * v[j].y) + (v[j].z * v[j].z + v[j].w * v[j].w); s2 += (v2[j].x * v2[j].x + v2[j].y * v2[j].y) + (v2[j].z * v2[j].z + v2[j].w * v2[j].w); }
        s = wave_sum(s); s2 = wave_sum(s2);
        const float r = 1.0f / sqrtf(s * (1.f / DM) + 1e-6f), r2 = 1.0f / sqrtf(s2 * (1.f / DM) + 1e-6f);
        u32x2* o = (u32x2*)(xb + (size_t)row * DM) + lane;
#pragma unroll
        for (int j = 0; j < 4; ++j) { u32x2 w; w.x = pk2(v[j].x * r, v[j].y * r); w.y = pk2(v[j].z * r, v[j].w * r); o[64 * j] = w; }
        if (has2) { u32x2* o2 = (u32x2*)(xb + (size_t)row2 * DM) + lane;
#pragma unroll
            for (int j = 0; j < 4; ++j) { u32x2 w; w.x = pk2(v2[j].x * r2, v2[j].y * r2); w.y = pk2(v2[j].z * r2, v2[j].w * r2); o2[64 * j] = w; } }
    }
}

struct Epi1 {
    static constexpr bool PERM = true, PERM2 = true, AFTER_DRAIN = false;
    bf16_t *Z, *G, *Q, *Kb, *V;
    __device__ __forceinline__ void operator()(const pg8::f32x4 (&acc)[2][2][4][2], const pg8::Unit& u, int wr, int wc, int fr, int fq) const {
        const int pn = u.pn; const int hi8 = (fr >> 3) & 1, fr7 = fr & 7; const int rbase = u.pm * 256 + wr * 64 + fr7;
        const bool qkv = (pn >= 4 && pn < 22);
        const bool act = !qkv && pn >= 2;
        const int ld = pn < 2 ? 512 : 1024;
        bf16_t* base; int dsh = 0; size_t rowstride_tok = 0; int ecol;
        if (qkv) { const int which = (pn - 4) / 6, ct = (pn - 4) % 6; dsh = 2 * (ct >> 1);
            base = Q + (size_t)which * ((WS_K - WS_Q) / 2) + (size_t)(ct * 4 + wc) * SEQ * 64; ecol = 32 * hi8 + 8 * fq; }
        else { const int c0 = pn < 2 ? pn * 256 : (pn < 4 ? (pn - 2) * 256 : 512 + (pn - 22) * 256); base = (pn < 2 ? Z : G) + c0 + wc * 64; ecol = 32 * hi8 + 8 * fq; }
        const int dmask = (1 << dsh) - 1, Lc = SEQ >> dsh;
#pragma unroll
        for (int ai = 0; ai < 2; ++ai)
#pragma unroll
            for (int m = 0; m < 4; ++m) {
                pg8::f32x4 a0 = acc[ai][0][m][0], a1 = acc[ai][0][m][1], b0 = acc[ai][1][m][0], b1 = acc[ai][1][m][1];
                if (act) {
#pragma unroll
                    for (int e = 0; e < 4; ++e) { a0[e] = silu_f(a0[e]); a1[e] = silu_f(a1[e]); b0[e] = silu_f(b0[e]); b1[e] = silu_f(b1[e]); } }
                u32x4 A, B; A.x = pk2(a0[0], a0[1]); A.y = pk2(a0[2], a0[3]); A.z = pk2(a1[0], a1[1]); A.w = pk2(a1[2], a1[3]);
                B.x = pk2(b0[0], b0[1]); B.y = pk2(b0[2], b0[3]); B.z = pk2(b1[0], b1[1]); B.w = pk2(b1[2], b1[3]);
                u32x4 snd, rcv;
#pragma unroll
                for (int e = 0; e < 4; ++e) { snd[e] = hi8 ? A[e] : B[e]; rcv[e] = dpp_mov<0x128>(snd[e]); }
                u32x4 d1, d2;
#pragma unroll
                for (int e = 0; e < 4; ++e) { d1[e] = hi8 ? rcv[e] : A[e]; d2[e] = hi8 ? B[e] : rcv[e]; }
                const int row1 = rbase + ai * 128 + m * 16, row2 = row1 + 8;
                if (qkv) {
                    const int bb = row1 >> 13, t1 = row1 & (SEQ - 1), t2 = row2 & (SEQ - 1);
                    const int p1 = (t1 & dmask) * Lc + (t1 >> dsh), p2 = (t2 & dmask) * Lc + (t2 >> dsh);
                    bf16_t* hb = base + (size_t)bb * 24 * SEQ * 64 + ecol;
                    *(u32x4*)(hb + (size_t)p1 * 64) = d1; *(u32x4*)(hb + (size_t)p2 * 64) = d2;
                } else {
                    *(u32x4*)(base + (size_t)row1 * ld + ecol) = d1; *(u32x4*)(base + (size_t)row2 * ld + ecol) = d2;
                }
            }
    }
};
struct Epi2 {
    static constexpr bool PERM = false, PERM2 = false, AFTER_DRAIN = false;
    const float* x; float* out;
    __device__ __forceinline__ void operator()(const pg8::f32x4 (&acc)[2][2][4][2], const pg8::Unit& u, int wr, int wc, int fr, int fq) const {
        const int row0 = u.pm * 256 + wr * 64 + fr, col0 = u.pn * 256 + wc * 32 + 4 * fq;
#pragma unroll
        for (int ai = 0; ai < 2; ++ai)
#pragma unroll
            for (int m = 0; m < 4; ++m) { const size_t off = (size_t)(row0 + ai * 128 + m * 16) * DM + col0;
#pragma unroll
                for (int bj = 0; bj < 2; ++bj)
#pragma unroll
                    for (int n = 0; n < 2; ++n) { const size_t o2 = off + bj * 128 + n * 16; *(pg8::f32x4*)(out + o2) = *(const pg8::f32x4*)(x + o2) + acc[ai][bj][m][n]; }
                if (m & 1) asm volatile("" ::: "memory"); }
    }
};

constexpr int TP = 192;
constexpr int TTP = 272;
template <int NROWS> __device__ __forceinline__ void load_tile(LAS unsigned char* lds, const bf16_t* src, size_t rstride, int tid) {
    u32x4 v[NROWS / 64];
#pragma unroll
    for (int i = 0; i < NROWS / 64; ++i) { const int ci = tid + 512 * i, row = ci >> 3, ch = ci & 7; v[i] = *(const u32x4*)(src + (size_t)row * rstride + ch * 8); }
#pragma unroll
    for (int i = 0; i < NROWS / 64; ++i) { const int ci = tid + 512 * i, row = ci >> 3, ch = ci & 7; *(LAS u32x4*)(lds + row * TP + ch * 16) = v[i]; }
}
__device__ __forceinline__ void dft1_phase(const Args& a, LAS unsigned char* lds, int tid, int lane, int wave) {
    asm volatile("" : "+v"(tid), "+v"(lane));
    const bf16_t* Z = (const bf16_t*)(a.ws + WS_Z); bf16_t* Y = (bf16_t*)(a.ws + WS_XB);
    const int h = lane >> 5, l31 = lane & 31, kb = wave & 3, nt = wave >> 2;
    bf16x8 af[8];
    { const int ri_row = l31 >> 4, k1 = 16 * kb + (l31 & 15);
#pragma unroll
      for (int ks = 0; ks < 8; ++ks) { unsigned pw[4];
#pragma unroll
        for (int jj = 0; jj < 4; ++jj) { float vv[2];
#pragma unroll
            for (int e = 0; e < 2; ++e) { const int s1 = 16 * ks + 8 * h + 2 * jj + e; float sn, cs; sincospif((float)((s1 * k1) & 127) * (1.f / 64.f), &sn, &cs);
                float val = ri_row == 0 ? cs : sn;
                if (ri_row == 1 && k1 == 0) val = (s1 & 1) ? -1.f : 1.f;
                vv[e] = val * 0.08838834764831845f; }
            pw[jj] = pk2(vv[0], vv[1]); }
        u32x4 t; t.x = pw[0]; t.y = pw[1]; t.z = pw[2]; t.w = pw[3]; af[ks] = __builtin_bit_cast(bf16x8, t); } }
    const int q = (lane & 15) >> 2, p = lane & 3, blk = (lane >> 4) & 1;
    LAS const unsigned char* rb = lds + (8 * h + q) * TP + 32 * blk + 8 * p + nt * 64;
    u32x4 pf[2][2];
#define DFT1_ISSUE(zz, uu) do { const int dc_ = (uu) & 7, s2_ = ((uu) >> 3) & 63, b_ = (uu) >> 9; const bf16_t* src_ = Z + ((size_t)b_ * SEQ + s2_) * 512 + dc_ * 64; \
        _Pragma("unroll") for (int i_ = 0; i_ < 2; ++i_) { const int ci_ = tid + 512 * i_; pf[zz][i_] = *(const u32x4*)(src_ + (size_t)(ci_ >> 3) * (64 * 512) + (ci_ & 7) * 8); } } while (0)
    const int G2 = 2 * (int)gridDim.x;
    { const int u0 = blockIdx.x; if (u0 < 4096) DFT1_ISSUE(0, u0); if (u0 + (int)gridDim.x < 4096) DFT1_ISSUE(1, u0 + (int)gridDim.x); }
    for (int u = blockIdx.x; u < 4096; u += G2) {
        const bool has1 = u + (int)gridDim.x < 4096;
#pragma unroll
        for (int z = 0; z < 2; ++z)
#pragma unroll
            for (int i = 0; i < 2; ++i) { const int ci = tid + 512 * i; *(LAS u32x4*)(lds + z * 24576 + (ci >> 3) * TP + (ci & 7) * 16) = pf[z][i]; }
        __syncthreads();
        { const int un = u + G2; if (un < 4096) DFT1_ISSUE(0, un); if (un + (int)gridDim.x < 4096) DFT1_ISSUE(1, un + (int)gridDim.x); }
        f32x16 acc[2]; acc[0] = f32x16{}; acc[1] = f32x16{};
#pragma unroll
        for (int ks = 0; ks < 8; ++ks)
#pragma unroll
            for (int z = 0; z < 2; ++z) { const s16x4 lo = trrd(rb + z * 24576 + ks * 16 * TP), hi = trrd(rb + z * 24576 + ks * 16 * TP + 4 * TP);
                const bf16x8 bfr = __builtin_shufflevector(lo, hi, 0, 1, 2, 3, 4, 5, 6, 7);
                acc[z] = __builtin_amdgcn_mfma_f32_32x32x16_bf16(af[ks], bfr, acc[z], 0, 0, 0); }
#pragma unroll
        for (int z = 0; z < 2; ++z) { const int uz = u + z * (int)gridDim.x, s2 = (uz >> 3) & 63;
            LAS bf16_t* yt = (LAS bf16_t*)(lds + 49152 + z * 16640);
#pragma unroll
            for (int i = 0; i < 8; ++i) { const int k1 = 16 * kb + crow(i, h); const float re = acc[z][i], im = acc[z][i + 8]; const int col = 32 * nt + l31;
                if (k1 != 0) { float sn, cs; sincospif((float)(s2 * k1) * (1.f / 4096.f), &sn, &cs);
                    yt[(2 * k1) * 64 + col] = (bf16_t)f2bf(cs * re - sn * im); yt[(2 * k1 + 1) * 64 + col] = (bf16_t)f2bf(sn * re + cs * im); }
                else { float sn, cs; sincospif((float)s2 * (1.f / 64.f), &sn, &cs);
                    yt[col] = (bf16_t)f2bf(re); yt[64 + col] = (bf16_t)0; yt[128 * 64 + col] = (bf16_t)f2bf(cs * im); yt[129 * 64 + col] = (bf16_t)f2bf(sn * im); } } }
        __syncthreads();
#pragma unroll
        for (int z = 0; z < 2; ++z) { if (z == 1 && !has1) break;
            const int uz = u + z * (int)gridDim.x, dc = uz & 7, s2 = (uz >> 3) & 63, b = uz >> 9;
            LAS const bf16_t* yt = (LAS const bf16_t*)(lds + 49152 + z * 16640);
#pragma unroll
            for (int zz = 0; zz < 3; ++zz) { const int ci = tid + 512 * zz; if (ci < 130 * 8) { const int row = ci >> 3, ch = ci & 7, k1 = row < 128 ? (row >> 1) : 64, ri = row < 128 ? (row & 1) : (row - 128);
                *(u32x4*)(Y + ((size_t)((b * 128 + k1) * 2 + ri) * 64 + s2) * 512 + dc * 64 + ch * 8) = *(LAS const u32x4*)(yt + row * 64 + ch * 8); } } }
        __syncthreads();
    }
}
__device__ __forceinline__ void dft2_phase(const Args& a, LAS unsigned char* lds, int tid, int lane, int wave) {
    asm volatile("" : "+v"(tid), "+v"(lane));
    const bf16_t* Y = (const bf16_t*)(a.ws + WS_XB); const bf16_t* Gb = (const bf16_t*)(a.ws + WS_G); bf16_t* ym = (bf16_t*)(a.ws + WS_Z); const bf16_t* GmT = (const bf16_t*)(a.ws + WS_GMT);
    const int h = lane >> 5, l31 = lane & 31, ksub = wave >> 2, mh = (wave >> 1) & 1, nt = wave & 1;
    bf16x8 af[2][8];
#pragma unroll
    for (int z = 0; z < 2; ++z) { const int m = 64 * mh + 32 * z + l31, k2 = m & 63, imrow = m >> 6;
#pragma unroll
      for (int ks = 0; ks < 8; ++ks) { unsigned pw[4];
#pragma unroll
        for (int jj = 0; jj < 4; ++jj) { float vv[2];
#pragma unroll
            for (int e = 0; e < 2; ++e) { const int kk = 16 * ks + 8 * h + 2 * jj + e, ri = kk >> 6, s2 = kk & 63; float sn, cs; sincospif((float)((s2 * k2) & 63) * (1.f / 32.f), &sn, &cs);
                vv[e] = (imrow == 0 ? (ri == 0 ? cs : -sn) : (ri == 0 ? sn : cs)) * 0.125f; }
            pw[jj] = pk2(vv[0], vv[1]); }
        u32x4 t; t.x = pw[0]; t.y = pw[1]; t.z = pw[2]; t.w = pw[3]; af[z][ks] = __builtin_bit_cast(bf16x8, t); } }
    const int q = (lane & 15) >> 2, p = lane & 3, blk = (lane >> 4) & 1;
    LAS const unsigned char* rb = lds + (ksub * 128 + 8 * h + q) * TP + 32 * blk + 8 * p + nt * 64;
    LAS unsigned char* tt = lds + 49152;
    LAS float* ot = (LAS float*)(lds + 83968);
    const int mt2 = wave >> 1, nt2 = wave & 1;
    u32x4 ld[4];
#define DFT2_ISSUE(uu) do { const int dc_ = (uu) & 7, k1p_ = ((uu) >> 3) & 63, b_ = (uu) >> 9; \
        if (k1p_ == 0) { _Pragma("unroll") for (int z_ = 0; z_ < 2; ++z_) { const int ci_ = tid + 512 * z_; const size_t o_ = (size_t)(ci_ >> 3) * 512 + dc_ * 64 + (ci_ & 7) * 8; \
                ld[z_] = __builtin_nontemporal_load((const u32x4*)(Y + ((size_t)(b_ * 128) * 128) * 512 + o_)); ld[2 + z_] = __builtin_nontemporal_load((const u32x4*)(Y + ((size_t)(b_ * 128 + 64) * 128) * 512 + o_)); } } \
        else { const bf16_t* src_ = Y + ((size_t)(b_ * 128 + k1p_) * 128 + (tid >> 3)) * 512 + dc_ * 64 + (tid & 7) * 8; ld[0] = __builtin_nontemporal_load((const u32x4*)src_); ld[1] = __builtin_nontemporal_load((const u32x4*)(src_ + (size_t)64 * 512)); } } while (0)
    if ((int)blockIdx.x < 4096) DFT2_ISSUE((int)blockIdx.x);
    for (int u = blockIdx.x; u < 4096; u += gridDim.x) {
        const int dc = u & 7, k1p = (u >> 3) & 63, b = u >> 9;
        bf16x8 gf[8];
#pragma unroll
        for (int ks = 0; ks < 8; ++ks) gf[ks] = *(const bf16x8*)(GmT + (size_t)(dc * 64 + 32 * nt2 + l31) * 128 + 16 * ks + 8 * h);
        const int k1a = k1p, k1b = k1p == 0 ? 64 : 128 - k1p;
        const int tr_e = tid >> 2, qt_e = tid & 3; const size_t tok_e = (size_t)b * SEQ + ((tr_e >> 6) ? k1b : k1a) + 128 * (tr_e & 63);
        const u32x4 g0 = __builtin_nontemporal_load((const u32x4*)(Gb + tok_e * 1024 + dc * 64 + qt_e * 16)), g1 = __builtin_nontemporal_load((const u32x4*)(Gb + tok_e * 1024 + dc * 64 + qt_e * 16 + 8));
        if (k1p == 0) {
#pragma unroll
            for (int z = 0; z < 2; ++z) { const int ci = tid + 512 * z, row = ci >> 3, ch = ci & 7; *(LAS u32x4*)(lds + row * TP + ch * 16) = ld[z]; *(LAS u32x4*)(lds + (128 + row) * TP + ch * 16) = ld[2 + z]; }
        } else {
            const int s2 = tid >> 3, ch = tid & 7;
            const u32x4 yr = ld[0], yi = ld[1];
            float sn, cs; sincospif((float)s2 * (1.f / 32.f), &sn, &cs);
            u32x4 zr, zi;
#pragma unroll
            for (int e = 0; e < 4; ++e) { const float rl = bflo(yr[e]), rh = bfhi(yr[e]), il = bflo(yi[e]), ih = bfhi(yi[e]);
                zr[e] = pk2(rl * cs + il * sn, rh * cs + ih * sn); zi[e] = pk2(rl * sn - il * cs, rh * sn - ih * cs); }
            *(LAS u32x4*)(lds + s2 * TP + ch * 16) = yr; *(LAS u32x4*)(lds + (64 + s2) * TP + ch * 16) = yi;
            *(LAS u32x4*)(lds + (128 + s2) * TP + ch * 16) = zr; *(LAS u32x4*)(lds + (192 + s2) * TP + ch * 16) = zi;
        }
        __syncthreads();
        if (u + (int)gridDim.x < 4096) DFT2_ISSUE(u + (int)gridDim.x);
        f32x16 acc[2]; acc[0] = f32x16{}; acc[1] = f32x16{};
#pragma unroll
        for (int ks = 0; ks < 8; ++ks) { const s16x4 lo = trrd(rb + ks * 16 * TP), hi = trrd(rb + ks * 16 * TP + 4 * TP);
            const bf16x8 bfr = __builtin_shufflevector(lo, hi, 0, 1, 2, 3, 4, 5, 6, 7);
            acc[0] = __builtin_amdgcn_mfma_f32_32x32x16_bf16(af[0][ks], bfr, acc[0], 0, 0, 0);
            acc[1] = __builtin_amdgcn_mfma_f32_32x32x16_bf16(af[1][ks], bfr, acc[1], 0, 0, 0); }
#pragma unroll
        for (int z = 0; z < 2; ++z)
#pragma unroll
            for (int i = 0; i < 16; ++i) *(LAS bf16_t*)(tt + (ksub * 64 + 32 * z + crow(i, h)) * TTP + (mh * 64 + 32 * nt + l31) * 2) = (bf16_t)f2bf(acc[z][i]);
        __syncthreads();
        f32x16 o2 = f32x16{};
#pragma unroll
        for (int ks = 0; ks < 8; ++ks) { const bf16x8 tf = *(LAS const bf16x8*)(tt + (32 * mt2 + l31) * TTP + (16 * ks + 8 * h) * 2);
            o2 = __builtin_amdgcn_mfma_f32_32x32x16_bf16(tf, gf[ks], o2, 0, 0, 0); }
#pragma unroll
        for (int i = 0; i < 16; ++i) ot[(32 * mt2 + crow(i, h)) * 64 + 32 * nt2 + l31] = o2[i];
        __syncthreads();
        {
            const int tr = tid >> 2, qt = tid & 3, ks2 = tr >> 6, k2 = tr & 63;
            const size_t tok = (size_t)b * SEQ + (ks2 ? k1b : k1a) + 128 * k2;
            const LAS f32x4* op = (const LAS f32x4*)(ot + tr * 64 + qt * 16);
            const f32x4 v0 = op[0], v1 = op[1], v2 = op[2], v3 = op[3];
            u32x4 w0, w1;
            w0.x = pk2(v0.x * bflo(g0.x), v0.y * bfhi(g0.x)); w0.y = pk2(v0.z * bflo(g0.y), v0.w * bfhi(g0.y)); w0.z = pk2(v1.x * bflo(g0.z), v1.y * bfhi(g0.z)); w0.w = pk2(v1.z * bflo(g0.w), v1.w * bfhi(g0.w));
            w1.x = pk2(v2.x * bflo(g1.x), v2.y * bfhi(g1.x)); w1.y = pk2(v2.z * bflo(g1.y), v2.w * bfhi(g1.y)); w1.z = pk2(v3.x * bflo(g1.z), v3.y * bfhi(g1.z)); w1.w = pk2(v3.z * bflo(g1.w), v3.w * bfhi(g1.w));
            *(u32x4*)(ym + tok * 1024 + dc * 64 + qt * 16) = w0; *(u32x4*)(ym + tok * 1024 + dc * 64 + qt * 16 + 8) = w1;
        }
        __syncthreads();
    }
}

constexpr int KP = 144, VP = 192, KROWS = 384, LDS_VOFF = KROWS * KP;
struct AUnit { int b, hd, dil, L, r, i0; };
__device__ __forceinline__ AUnit attn_decode(int u, int hd0, int nh) {
    AUnit w; const int blk32 = u & 31; w.hd = hd0 + (u >> 5) % nh; w.b = u / (32 * nh);
    const int dsh = 2 * (w.hd >> 3), nbr = 32 >> dsh; w.dil = 1 << dsh; w.L = SEQ >> dsh; w.r = blk32 / nbr; w.i0 = (blk32 % nbr) * 256; return w;
}
__device__ __forceinline__ void attn_issue(const AUnit& w, const bf16_t* Qb, const bf16_t* Kb, const bf16_t* Vb, int tid, int wave, int lane, u32x4 (&kv)[6], u32x4 (&vv)[6]) {
    const int ch = tid & 7;
#pragma unroll
    for (int i = 0; i < 6; ++i) { const int row = (tid + 512 * i) >> 3; int pk = w.i0 - 64 + row; pk = pk < 0 ? 0 : (pk >= w.L ? w.L - 1 : pk);
        const size_t off = ((size_t)(w.b * 24 + w.hd) * SEQ + (size_t)(w.r * w.L + pk)) * 64 + ch * 8; kv[i] = *(const u32x4*)(Kb + off); vv[i] = *(const u32x4*)(Vb + off); }
}
__device__ __forceinline__ float attn_tile_exp(f32x16& st, int j, float tlf, float bsl, float rlo, float rhi) {
    float sum = 0.f;
#pragma unroll
    for (int i = 0; i < 16; ++i) { const float tmp = (float)(32 * j - 64 + (i & 3) + 8 * (i >> 2)) + tlf;
        float arg = __builtin_fmaf(-bsl, __builtin_fabsf(tmp), st[i]);
        arg = (tmp >= rlo && tmp <= rhi) ? arg : -1.0e30f;
        const float pe = __builtin_amdgcn_exp2f(arg); st[i] = pe; sum += pe; }
    return sum;
}
template <bool FUSED> __device__ __forceinline__ void attn_phase(const Args& a, LAS unsigned char* lds, int tid, int lane, int wave) {
    constexpr int HD0 = FUSED ? 0 : 8, NH = FUSED ? 8 : 16, NU = 8 * NH * 32;
    asm volatile("" : "+v"(tid), "+v"(lane));
    bf16_t* Qb = (bf16_t*)(a.ws + WS_Q); const bf16_t* Kb = (const bf16_t*)(a.ws + WS_K); const bf16_t* Vb = (const bf16_t*)(a.ws + WS_V); float* LSE = (float*)(a.ws + WS_LSE);
    const int h = lane >> 5, l31 = lane & 31;
    const int q = (lane & 15) >> 2, p = lane & 3, blk = (lane >> 4) & 1;
    int u = blockIdx.x;
    u32x4 kv[6], vv[6], qv[4];
#define ATTN_QLOAD(W) do { const bf16_t* qr_ = Qb + ((size_t)((W).b * 24 + (W).hd) * SEQ + (size_t)((W).r * (W).L + (W).i0 + 32 * wave + l31)) * 64; \
        _Pragma("unroll") for (int ks_ = 0; ks_ < 4; ++ks_) qv[ks_] = *(const u32x4*)(qr_ + 16 * ks_ + 8 * h); } while (0)
    if (u < NU) { const AUnit w0 = attn_decode(u, HD0, NH); attn_issue(w0, Qb, Kb, Vb, tid, wave, lane, kv, vv); ATTN_QLOAD(w0); }
    while (u < NU) {
        const AUnit w = attn_decode(u, HD0, NH);
        const int hd = w.hd, slot = hd & 7, L = w.L, i0 = w.i0;
        const int iq = i0 + 32 * wave + l31; const size_t tq = (size_t)w.b * SEQ + (size_t)iq * w.dil + w.r;
        bf16_t* qrow = Qb + ((size_t)(w.b * 24 + hd) * SEQ + (size_t)(w.r * L + iq)) * 64;
        {
            const int ch = tid & 7;
            const f32x4 g0 = *(const f32x4*)(a.kw + hd * 64 + ch * 8), g1 = *(const f32x4*)(a.kw + hd * 64 + ch * 8 + 4);
#pragma unroll
            for (int i = 0; i < 6; ++i) { const int row = (tid + 512 * i) >> 3;
                const float e0 = bflo(kv[i].x), e1 = bfhi(kv[i].x), e2 = bflo(kv[i].y), e3 = bfhi(kv[i].y), e4 = bflo(kv[i].z), e5 = bfhi(kv[i].z), e6 = bflo(kv[i].w), e7 = bfhi(kv[i].w);
                float ss = (e0 * e0 + e1 * e1) + (e2 * e2 + e3 * e3) + (e4 * e4 + e5 * e5) + (e6 * e6 + e7 * e7);
                ss += dpp_movf<0xB1>(ss); ss += dpp_movf<0x4E>(ss); ss += dpp_movf<0x141>(ss);
                const float rk = __builtin_amdgcn_rsqf(ss * (1.f / 64.f) + 1e-6f);
                u32x4 wv; wv.x = pk2(e0 * rk * g0.x, e1 * rk * g0.y); wv.y = pk2(e2 * rk * g0.z, e3 * rk * g0.w); wv.z = pk2(e4 * rk * g1.x, e5 * rk * g1.y); wv.w = pk2(e6 * rk * g1.z, e7 * rk * g1.w);
                *(LAS u32x4*)(lds + row * KP + ch * 16) = wv;
                *(LAS u32x4*)(lds + LDS_VOFF + row * VP + ch * 16) = vv[i];
                if (i & 1) __builtin_amdgcn_sched_barrier(0); }
        }
        bf16x8 qf[4];
        {
            float ss = 0.f;
#pragma unroll
            for (int ks = 0; ks < 4; ++ks)
#pragma unroll
                for (int e = 0; e < 4; ++e) { const float lo = bflo(qv[ks][e]), hi = bfhi(qv[ks][e]); ss += lo * lo + hi * hi; }
            ss += __shfl_xor(ss, 32);
            const float rq = 0.125f * LOG2E * __builtin_amdgcn_rsqf(ss * (1.f / 64.f) + 1e-6f);
#pragma unroll
            for (int ks = 0; ks < 4; ++ks) { const f32x4 g0 = *(const f32x4*)(a.qw + hd * 64 + 16 * ks + 8 * h), g1 = *(const f32x4*)(a.qw + hd * 64 + 16 * ks + 8 * h + 4); u32x4 wv;
                wv.x = pk2(bflo(qv[ks].x) * rq * g0.x, bfhi(qv[ks].x) * rq * g0.y); wv.y = pk2(bflo(qv[ks].y) * rq * g0.z, bfhi(qv[ks].y) * rq * g0.w);
                wv.z = pk2(bflo(qv[ks].z) * rq * g1.x, bfhi(qv[ks].z) * rq * g1.y); wv.w = pk2(bflo(qv[ks].w) * rq * g1.z, bfhi(qv[ks].w) * rq * g1.w);
                qf[ks] = __builtin_bit_cast(bf16x8, wv); }
        }
        const float mb = ((const float*)(a.ws + WS_RS))[hd];
        __syncthreads();
        const int un = u + gridDim.x;
        if (un < NU) { const AUnit wn = attn_decode(un, HD0, NH); attn_issue(wn, Qb, Kb, Vb, tid, wave, lane, kv, vv); }
        const float bsl = __builtin_amdgcn_exp2f(-(float)(slot + 1)) * (float)w.dil * LOG2E;
        int tl = 4 * h - l31; asm volatile("" : "+v"(tl));
        const float tlf = (float)tl;
        const int lo_i = -iq > -64 ? -iq : -64, hi_i = (L - 1 - iq) < 64 ? (L - 1 - iq) : 64;
        const float rlo = (float)lo_i, rhi = (float)hi_i;
        const int wq0 = i0 + 32 * wave;
        const bool edge = (wq0 < 64) || (wq0 + 32 > L - 64);
        float sum = 0.f;
        f32x16 o[2]; o[0] = f32x16{}; o[1] = f32x16{};
#pragma unroll
        for (int j = 0; j < 5; ++j) {
            f32x16 st;
#pragma unroll
            for (int i = 0; i < 16; ++i) st[i] = -mb;
            LAS const unsigned char* kp = lds + (32 * wave + 32 * j + l31) * KP + 16 * h;
#pragma unroll
            for (int ks = 0; ks < 4; ++ks) { const bf16x8 kf = *(LAS const bf16x8*)(kp + 32 * ks); st = __builtin_amdgcn_mfma_f32_32x32x16_bf16(kf, qf[ks], st, 0, 0, 0); }
            sum += attn_tile_exp(st, j, tlf, bsl, rlo, rhi);
#pragma unroll
            for (int s2 = 0; s2 < 2; ++s2) { u32x4 pw; pw.x = pk2(st[8 * s2 + 0], st[8 * s2 + 1]); pw.y = pk2(st[8 * s2 + 2], st[8 * s2 + 3]); pw.z = pk2(st[8 * s2 + 4], st[8 * s2 + 5]); pw.w = pk2(st[8 * s2 + 6], st[8 * s2 + 7]);
                const bf16x8 pf = __builtin_bit_cast(bf16x8, pw);
                LAS const unsigned char* vp = lds + LDS_VOFF + (32 * wave + 32 * j + 16 * s2 + 4 * h + q) * VP + 32 * blk + 8 * p;
#pragma unroll
                for (int dt = 0; dt < 2; ++dt) { const s16x4 lo = trrd(vp + dt * 64), hi = trrd(vp + 8 * VP + dt * 64);
                    const bf16x8 vf = __builtin_shufflevector(lo, hi, 0, 1, 2, 3, 4, 5, 6, 7);
                    o[dt] = __builtin_amdgcn_mfma_f32_32x32x16_bf16(vf, pf, o[dt], 0, 0, 0); } }
            __builtin_amdgcn_sched_barrier(0);
        }
        sum += __shfl_xor(sum, 32);
        if (un < NU) { const AUnit wq = attn_decode(un, HD0, NH); ATTN_QLOAD(wq); }
        const float inv = __builtin_amdgcn_rcpf(sum);
        {
            u32x4 fo1[4], fo2[4], fg[4]; float fl1[4], fl2[4];
            if constexpr (FUSED) {
                const bf16_t* Gb = (const bf16_t*)(a.ws + WS_G);
#pragma unroll
                for (int it = 0; it < 4; ++it) { const int r = 8 * it + (lane >> 3), c16 = lane & 7, t = i0 + 32 * wave + r; const size_t tokg = (size_t)w.b * SEQ + t;
                    fl1[it] = LSE[tokg * 24 + 8 + slot]; fl2[it] = LSE[tokg * 24 + 16 + slot];
                    fo1[it] = __builtin_nontemporal_load((const u32x4*)(Qb + ((size_t)(w.b * 24 + 8 + slot) * SEQ + (t & 3) * 2048 + (t >> 2)) * 64 + c16 * 8));
                    fo2[it] = __builtin_nontemporal_load((const u32x4*)(Qb + ((size_t)(w.b * 24 + 16 + slot) * SEQ + (t & 15) * 512 + (t >> 4)) * 64 + c16 * 8));
                    fg[it] = __builtin_nontemporal_load((const u32x4*)(Gb + tokg * 1024 + 512 + slot * 64 + c16 * 8)); }
            }
            LAS unsigned char* ost = lds + 129024 + wave * 4096;
#pragma unroll
            for (int dt = 0; dt < 2; ++dt)
#pragma unroll
                for (int ig = 0; ig < 4; ++ig) { u32x2 wv; wv.x = pk2(o[dt][4 * ig] * inv, o[dt][4 * ig + 1] * inv); wv.y = pk2(o[dt][4 * ig + 2] * inv, o[dt][4 * ig + 3] * inv);
                    const int p8 = 8 * dt + 2 * ig + h; *(LAS u32x2*)(ost + l31 * 128 + 8 * (p8 ^ (l31 & 15))) = wv; }
            if constexpr (FUSED) { if (h == 0) ((LAS float*)(lds + 161808))[wave * 32 + l31] = mb + __builtin_amdgcn_logf(sum); }
            asm volatile("s_waitcnt lgkmcnt(0)" ::: "memory");
            if constexpr (!FUSED) {
                bf16_t* obase = qrow - l31 * 64;
#pragma unroll
                for (int it = 0; it < 4; ++it) { const int r = 8 * it + (lane >> 3), c16 = lane & 7;
                    u32x4 v = *(LAS const u32x4*)(ost + r * 128 + 16 * (c16 ^ ((r & 15) >> 1)));
                    if (r & 1) { const unsigned t0 = v.x, t1 = v.y; v.x = v.z; v.y = v.w; v.z = t0; v.w = t1; }
                    *(u32x4*)(obase + (size_t)r * 64 + c16 * 8) = v; asm volatile("" ::: "memory"); }
            } else {
                bf16_t* ym = (bf16_t*)(a.ws + WS_Z);
#pragma unroll
                for (int it = 0; it < 4; ++it) { const int r = 8 * it + (lane >> 3), c16 = lane & 7;
                    u32x4 v = *(LAS const u32x4*)(ost + r * 128 + 16 * (c16 ^ ((r & 15) >> 1)));
                    if (r & 1) { const unsigned t0 = v.x, t1 = v.y; v.x = v.z; v.y = v.w; v.z = t0; v.w = t1; }
                    const int t = i0 + 32 * wave + r; const size_t tokg = (size_t)w.b * SEQ + t;
                    const float l0 = ((LAS const float*)(lds + 161808))[wave * 32 + r], l1 = fl1[it], l2 = fl2[it];
                    const float mxl = fmaxf(l0, fmaxf(l1, l2));
                    float w0 = __builtin_amdgcn_exp2f(l0 - mxl), w1 = __builtin_amdgcn_exp2f(l1 - mxl), w2 = __builtin_amdgcn_exp2f(l2 - mxl);
                    const float iw = 1.0f / (w0 + w1 + w2); w0 *= iw; w1 *= iw; w2 *= iw;
                    u32x4 ov;
#pragma unroll
                    for (int e = 0; e < 4; ++e) { const float lo = (bflo(v[e]) * w0 + bflo(fo1[it][e]) * w1 + bflo(fo2[it][e]) * w2) * bflo(fg[it][e]); const float hi = (bfhi(v[e]) * w0 + bfhi(fo1[it][e]) * w1 + bfhi(fo2[it][e]) * w2) * bfhi(fg[it][e]); ov[e] = pk2(lo, hi); }
                    *(u32x4*)(ym + tokg * 1024 + 512 + slot * 64 + c16 * 8) = ov; }
            }
        }
        if constexpr (!FUSED) { if (h == 0) LSE[tq * 24 + hd] = mb + __builtin_amdgcn_logf(sum); }
        __syncthreads();
        u = un;
    }
}
__device__ __forceinline__ void merge_phase(const Args& a, int lane, int wave) {
    asm volatile("" : "+v"(lane));
    const bf16_t* Ob = (const bf16_t*)(a.ws + WS_Q); const bf16_t* Gb = (const bf16_t*)(a.ws + WS_G); const float* LSE = (const float*)(a.ws + WS_LSE); bf16_t* ym = (bf16_t*)(a.ws + WS_Z);
    const int gw = blockIdx.x * 8 + wave, NGW = gridDim.x * 8, slot = lane >> 3;
    for (int tok0 = gw; tok0 < MTOK; tok0 += 2 * NGW) {
        u32x4 o0[2], o1[2], o2[2], g[2]; float l0[2], l1[2], l2[2];
#pragma unroll
        for (int z = 0; z < 2; ++z) { int tok = tok0 + z * NGW; tok = tok < MTOK ? tok : tok0;
            l0[z] = LSE[(size_t)tok * 24 + slot]; l1[z] = LSE[(size_t)tok * 24 + 8 + slot]; l2[z] = LSE[(size_t)tok * 24 + 16 + slot];
            const int b = tok >> 13, t = tok & (SEQ - 1), part = lane & 7;
            o0[z] = __builtin_nontemporal_load((const u32x4*)(Ob + ((size_t)(b * 24 + slot) * SEQ + t) * 64 + part * 8));
            o1[z] = __builtin_nontemporal_load((const u32x4*)(Ob + ((size_t)(b * 24 + 8 + slot) * SEQ + (t & 3) * 2048 + (t >> 2)) * 64 + part * 8));
            o2[z] = __builtin_nontemporal_load((const u32x4*)(Ob + ((size_t)(b * 24 + 16 + slot) * SEQ + (t & 15) * 512 + (t >> 4)) * 64 + part * 8));
            g[z] = __builtin_nontemporal_load((const u32x4*)(Gb + (size_t)tok * 1024 + 512 + lane * 8)); }
#pragma unroll
        for (int z = 0; z < 2; ++z) { const int tok = tok0 + z * NGW; if (tok >= MTOK) break;
            const float mx = fmaxf(l0[z], fmaxf(l1[z], l2[z]));
            float w0 = __builtin_amdgcn_exp2f(l0[z] - mx), w1 = __builtin_amdgcn_exp2f(l1[z] - mx), w2 = __builtin_amdgcn_exp2f(l2[z] - mx);
            const float inv = 1.0f / (w0 + w1 + w2); w0 *= inv; w1 *= inv; w2 *= inv;
            u32x4 w;
#pragma unroll
            for (int e = 0; e < 4; ++e) { const float lo = (bflo(o0[z][e]) * w0 + bflo(o1[z][e]) * w1 + bflo(o2[z][e]) * w2) * bflo(g[z][e]); const float hi = (bfhi(o0[z][e]) * w0 + bfhi(o1[z][e]) * w1 + bfhi(o2[z][e]) * w2) * bfhi(g[z][e]); w[e] = pk2(lo, hi); }
            *(u32x4*)(ym + (size_t)tok * 1024 + 512 + lane * 8) = w; }
    }
}

#define XB_TMO      128
#define XB_XCNT(j)  (256  + 64 * (j))
#define XB_XSUB(j)  (1280 + 64 * (j))
#define XB_XGEN(j)  (2304 + 64 * (j))
#define XB_TOP      3328
#define XB_TOPGEN   3392
#define XCD_BAR_WORDS 3456
#define XB_SPIN_CAP (1u << 18)

__device__ __forceinline__ unsigned xb_ld(unsigned* p)              { return __hip_atomic_load(p, __ATOMIC_RELAXED, __HIP_MEMORY_SCOPE_AGENT); }
__device__ __forceinline__ unsigned xb_add(unsigned* p, unsigned v) { return __hip_atomic_fetch_add(p, v, __ATOMIC_RELAXED, __HIP_MEMORY_SCOPE_AGENT); }
__device__ __forceinline__ unsigned xb_xcc_id() { return (unsigned)__builtin_amdgcn_s_getreg((3 << 11) | 20) & 0xFu; }
#define XB_SPIN(cond, bar) do { unsigned _sp = 0; while (cond) { __builtin_amdgcn_s_sleep(1); \
    if ((++_sp & 255u) == 0u) { if (xb_ld(&(bar)[XB_TMO])) break; if (_sp > XB_SPIN_CAP) { atomicAdd(&(bar)[XB_TMO], 1u); break; } } } } while (0)

struct XcdBarrier {
    unsigned* bar; unsigned x;
    volatile LAS unsigned* st;
};

__device__ __forceinline__ XcdBarrier xcd_barrier_post(unsigned* bar, volatile LAS unsigned* st) {
    XcdBarrier b; b.bar = bar; b.x = xb_xcc_id(); b.st = st;
    if (threadIdx.x == 0) (void)xb_add(&bar[XB_XCNT(b.x)], 1u);
    return b;
}
__device__ __forceinline__ void xcd_barrier_complete(unsigned* bar, unsigned x, unsigned& nloc, unsigned& nx) {
    const unsigned G = gridDim.x * gridDim.y * gridDim.z;
    unsigned sum, cnt, mine, sp = 0u;
    for (;;) {
        sum = 0u; cnt = 0u; mine = 0u;
#pragma unroll
        for (unsigned j = 0; j < 16; ++j) { const unsigned c = xb_ld(&bar[XB_XCNT(j)]); sum += c; cnt += (c > 0u) ? 1u : 0u; mine = (j == x) ? c : mine; }
        if (sum == G) break;
        __builtin_amdgcn_s_sleep(1);
        if ((++sp & 255u) == 0u) { if (xb_ld(&bar[XB_TMO])) break; if (sp > XB_SPIN_CAP) { atomicAdd(&bar[XB_TMO], 1u); break; } }
    }
    nloc = mine > 0u ? mine : 1u; nx = cnt > 0u ? cnt : 1u;
}

__device__ __forceinline__ void xcd_barrier(const XcdBarrier& b) {
    asm volatile("s_waitcnt vmcnt(0)" ::: "memory");
    __syncthreads();
    if (threadIdx.x == 0) {
        unsigned* bar = b.bar;
        __builtin_amdgcn_s_waitcnt(0);
        unsigned nloc = b.st[0], nx = b.st[1];
        if (nloc == 0u) { xcd_barrier_complete(bar, b.x, nloc, nx); b.st[0] = nloc; b.st[1] = nx; }
        const unsigned old = xb_add(&bar[XB_XSUB(b.x)], 1u);
        const unsigned gen = old / nloc;
        if (old + 1u == (gen + 1u) * nloc) {
            __builtin_amdgcn_fence(__ATOMIC_RELEASE, "agent");
            asm volatile("s_waitcnt vmcnt(0)" ::: "memory");
            const unsigned og = xb_add(&bar[XB_TOP], 1u);
            const unsigned tg = og / nx;
            if (og + 1u == (tg + 1u) * nx) xb_add(&bar[XB_TOPGEN], 1u);
            else XB_SPIN(xb_ld(&bar[XB_TOPGEN]) == tg, bar);
            __builtin_amdgcn_fence(__ATOMIC_ACQUIRE, "agent");
            xb_add(&bar[XB_XGEN(b.x)], 1u);
            asm volatile("s_waitcnt vmcnt(0)" ::: "memory");
        } else {
            XB_SPIN(xb_ld(&bar[XB_XGEN(b.x)]) == gen, bar);
            __builtin_amdgcn_fence(__ATOMIC_ACQUIRE, "agent");
            asm volatile("s_waitcnt vmcnt(0)" ::: "memory");
        }
    }
    __syncthreads();
}

__global__ void __launch_bounds__(512, 2) mega_fwd(Args a) {
    extern __shared__ __attribute__((aligned(16))) unsigned char lds_raw[];
    LAS unsigned char* lds = (LAS unsigned char*)lds_raw;
    cg::grid_group grid = cg::this_grid();
    const int tid = threadIdx.x, lane = tid & 63, wave = __builtin_amdgcn_readfirstlane(tid >> 6);
    volatile LAS unsigned* bst = (volatile LAS unsigned*)(lds + 161792);
    if (tid < 2) bst[tid] = 0u;
    __syncthreads();
    XcdBarrier bar = xcd_barrier_post((unsigned*)(a.ws + WS_BAR), bst);
    if (a.ws == nullptr) grid.sync();
#ifndef REP0
#define REP0 1
#define REP1 1
#define REPD1 1
#define REPD2 1
#define REPM 1
#define REP4 1
#endif
    for (int rep = 0; rep < REP0; ++rep) phase0(a, lds, tid, lane, wave);
    xcd_barrier(bar);
    {
        pg8::Gemm g{(const pg8::bf16_t*)(a.ws + WS_XB), (const pg8::bf16_t*)(a.ws + WS_WT), MTOK, NIN, DM}; pg8::StaticOrder S; S.init(MTOK, NIN, gridDim.x, (int)blockIdx.x, REP1);
        Epi1 E{(bf16_t*)(a.ws + WS_Z), (bf16_t*)(a.ws + WS_G), (bf16_t*)(a.ws + WS_Q), (bf16_t*)(a.ws + WS_K), (bf16_t*)(a.ws + WS_V)};
        pg8::gemm_phase<Epi1, pg8::StaticOrder, true, true>(lds, g, S, E);
    }
    xcd_barrier(bar);
    attn_phase<false>(a, lds, tid, lane, wave);
    for (int rep = 0; rep < REPD1; ++rep) dft1_phase(a, lds, tid, lane, wave);
    xcd_barrier(bar);
    for (int rep = 0; rep < REPD2; ++rep) dft2_phase(a, lds, tid, lane, wave);
    attn_phase<true>(a, lds, tid, lane, wave);
    xcd_barrier(bar);
    {
        pg8::Gemm g{(const pg8::bf16_t*)(a.ws + WS_Z), (const pg8::bf16_t*)(a.ws + WS_WOT), MTOK, DM, DM}; pg8::StaticOrder S; S.init(MTOK, DM, gridDim.x, (int)blockIdx.x, REP4);
        Epi2 E{a.x, a.out};
        pg8::gemm_phase<Epi2, pg8::StaticOrder, true, true>(lds, g, S, E);
    }
}

extern "C" void kernel_launch(void* const* d_in, const int* in_sizes, int n_in, void* d_out, int out_size, void* d_ws, size_t ws_size, hipStream_t stream) {
    static int grid = 0;
    if (grid == 0) {
        if (n_in != 7 || in_sizes[0] != MTOK * DM || out_size != MTOK * DM || ws_size < WS_END) { fprintf(stderr, "kernel_launch: unexpected shapes / workspace (%d inputs, ws %zu)\n", n_in, ws_size); grid = -1; return; }
        int dev = 0, cus = 0, per_cu = 0;
        hipGetDevice(&dev); hipDeviceGetAttribute(&cus, hipDeviceAttributeMultiprocessorCount, dev);
        hipFuncSetAttribute((const void*)mega_fwd, hipFuncAttributeMaxDynamicSharedMemorySize, LDS_BYTES);
        hipOccupancyMaxActiveBlocksPerMultiprocessor(&per_cu, (const void*)mega_fwd, 512, LDS_BYTES);
        if (per_cu < 1) { fprintf(stderr, "kernel_launch: occupancy query says %d blocks per CU\n", per_cu); per_cu = 1; }
        grid = cus;
        (void)hipGetLastError();
    }
    if (grid < 0) return;
    Args a{};
    a.x = (const float*)d_in[0]; a.norm_w = (const float*)d_in[1]; a.w_in = (const float*)d_in[2]; a.qw = (const float*)d_in[3]; a.kw = (const float*)d_in[4];
    a.wf = (const float*)d_in[5]; a.w_out = (const float*)d_in[6]; a.out = (float*)d_out; a.ws = (unsigned char*)d_ws;
    if (hipMemsetAsync((char*)d_ws + WS_BAR, 0, 16384, stream) != hipSuccess) { fprintf(stderr, "kernel_launch: memset of the barrier words failed\n"); return; }
    void* args[] = {&a};
    hipError_t e = hipLaunchCooperativeKernel((const void*)mega_fwd, dim3(grid), dim3(512), args, LDS_BYTES, stream);
    if (e != hipSuccess) fprintf(stderr, "cooperative launch failed: %s (grid %d)\n", hipGetErrorString(e), grid);
}
```

```cpp
#include <hip/hip_runtime.h>
#include <hip/hip_cooperative_groups.h>
#include <cstdio>
#include <cstdint>
namespace cg = cooperative_groups;
namespace pg8 {
#define PG8_LAS __attribute__((address_space(3)))
typedef unsigned short bf16_t;
typedef short bf16x8 __attribute__((ext_vector_type(8)));
typedef float f32x4 __attribute__((ext_vector_type(4)));
typedef unsigned u32x4 __attribute__((ext_vector_type(4)));
constexpr int BM = 256, BK = 64, HALF = 128, HTB = HALF * BK * 2  , STAGE_BYTES = 8 * HTB, NXCD = 8, WGM = 8;

__host__ __device__ __forceinline__ int lds_byte(int r, int c) { const int st = (r >> 4) * 2 + (c >> 5), rr = r & 15, cc = c & 31, ob = rr * 64 + cc * 2; return st * 1024 + (ob ^ (((ob >> 9) & 1) << 5)); }
__host__ __device__ __forceinline__ void stage_rc(int b, int& R, int& C) { const int st = b / 1024, sb = b % 1024, swz = sb ^ (((sb >> 9) & 1) << 5); R = (st >> 1) * 16 + swz / 64; C = (st & 1) * 32 + (swz % 64) / 2; }
__host__ __device__ __forceinline__ int perm32(int rho) { const int n = rho >> 4, i = rho & 15; return 8 * (i >> 2) + 4 * n + (i & 3); }

struct Unit { int pm, pn; };
struct Gemm { const bf16_t* A; const bf16_t* Bt; int M, N, K; };

struct StaticOrder {
    int nM, nN, nwg, G, c, rep;
    __host__ __device__ void init(int M, int N, int G_, int c_, int rep_ = 1) { nM = M / BM; nN = N / BM; nwg = nM * nN; G = G_; c = c_; rep = rep_; }
    __host__ __device__ bool next(int i, Unit& u) const {
        const int per = (nwg + G - 1) / G; if (i >= per * rep) return false; const long L = (long)(i % per) * G + c; if (L >= nwg) return false;
        int wgid = (int)L; { const int q = nwg / NXCD, r = nwg % NXCD, xcd = wgid % NXCD, off = wgid / NXCD; wgid = (xcd < r ? xcd * (q + 1) : r * (q + 1) + (xcd - r) * q) + off; }
        const int nig = WGM * nN, gid = wgid / nig, fm = gid * WGM, gsz = (nM - fm) < WGM ? (nM - fm) : WGM;
        u.pm = fm + ((wgid % nig) % gsz); u.pn = (wgid % nig) / gsz; return true;
    }
    __device__ __forceinline__ void a_ready(const Unit&) const {}
    __device__ __forceinline__ void done(const Unit&) const {}
};

__device__ __forceinline__ unsigned cvt_pk_bf16(float lo, float hi) { unsigned r; asm volatile("v_cvt_pk_bf16_f32 %0, %1, %2" : "=v"(r) : "v"(lo), "v"(hi)); return r; }
typedef float f32x2 __attribute__((ext_vector_type(2)));
template <class Epi, class Sched, bool ALIGN_EPI = false, bool SP2 = false>
__device__ __forceinline__ void gemm_phase(PG8_LAS unsigned char* lds, const Gemm g, const Sched& S, const Epi& E) {
    const int tid = threadIdx.x, wid = __builtin_amdgcn_readfirstlane(tid >> 6), lane = tid & 63, wr = wid >> 2, wc = wid & 3, fr = lane & 15, fq = lane >> 4;
    const int K = g.K, nt = K / BK;
    unsigned voffA[2], voffB[2];
#pragma unroll
    for (int i = 0; i < 2; ++i) { int R, C; stage_rc(tid * 16 + i * 8192, R, C); const int Rb = Epi::PERM2 ? (64 * (R >> 5) + perm32(R & 31)) : (Epi::PERM ? ((R & ~31) + perm32(R & 31)) : R);
        voffA[i] = (unsigned)(R * K + C) * 2u; voffB[i] = (unsigned)(Rb * K + C) * 2u; }
    const size_t kstep = (size_t)(BK * 2);
    const size_t hstep = (size_t)HALF * K * 2;
    const size_t hstepB = Epi::PERM2 ? (size_t)32 * K * 2 : hstep;
    const size_t tstep = 2 * hstep;
    const unsigned ldsw = (unsigned)wid * 1024u;
    const int aoff = lds_byte(wr * 64 + fr, fq * 8), boff = lds_byte(wc * 32 + fr, fq * 8);
#define PG8_SA(b, h) (((b) * 2 + (h)) * HTB)
#define PG8_SB(b, h) ((4 + (b) * 2 + (h)) * HTB)
#define PG8_STAGE(bufoff, gbase, voff) do { _Pragma("unroll") for (int _i = 0; _i < 2; ++_i) \
        __builtin_amdgcn_global_load_lds((const unsigned*)((const char*)(gbase) + (voff)[_i]), (PG8_LAS unsigned*)(lds + (bufoff) + ldsw + _i * 8192), 16, 0, 0); } while (0)
#define PG8_LDA(dst, b, h) do { _Pragma("unroll") for (int m = 0; m < 4; ++m) _Pragma("unroll") for (int k = 0; k < 2; ++k) dst[m][k] = *(const PG8_LAS bf16x8*)(lds + PG8_SA(b, h) + aoff + m * 2048 + k * 1024); } while (0)
#define PG8_LDB(dst, b, h) do { _Pragma("unroll") for (int n = 0; n < 2; ++n) _Pragma("unroll") for (int k = 0; k < 2; ++k) dst[n][k] = *(const PG8_LAS bf16x8*)(lds + PG8_SB(b, h) + boff + n * 2048 + k * 1024); } while (0)
#define PG8_MMA(ai, bj, At, Bt) do { __builtin_amdgcn_s_setprio(1); _Pragma("unroll") for (int m = 0; m < 4; ++m) _Pragma("unroll") for (int n = 0; n < 2; ++n) _Pragma("unroll") for (int k = 0; k < 2; ++k) \
        acc[ai][bj][m][n] = __builtin_amdgcn_mfma_f32_16x16x32_bf16(Bt[n][k], At[m][k], acc[ai][bj][m][n], 0, 0, 0); __builtin_amdgcn_s_setprio(0); } while (0)
#define PG8_WAIT_V(n) asm volatile("s_waitcnt vmcnt(" #n ")" ::: "memory")
#define PG8_WAIT_L(n) asm volatile("s_waitcnt lgkmcnt(" #n ")" ::: "memory")
#define PG8_BAR __builtin_amdgcn_s_barrier()
#define PG8_SCHED __builtin_amdgcn_sched_barrier(0)
    Unit cur, nxt; int ui = 0;
    if (!S.next(0, cur)) return;
    f32x4 acc[2][2][4][2];
#pragma unroll
    for (int a = 0; a < 2; ++a)
#pragma unroll
        for (int b = 0; b < 2; ++b)
#pragma unroll
            for (int m = 0; m < 4; ++m)
#pragma unroll
                for (int n = 0; n < 2; ++n) acc[a][b][m][n] = (f32x4){0.f, 0.f, 0.f, 0.f};
    bf16x8 At[4][2], B0[2][2], B1[2][2];
    const char* cA = (const char*)g.A + (size_t)cur.pm * tstep; const char* cB = (const char*)g.Bt + (size_t)cur.pn * tstep;
    S.a_ready(cur);
    if constexpr (SP2) {
        PG8_STAGE(PG8_SB(0, 0), cB, voffB); PG8_STAGE(PG8_SB(0, 1), cB + hstepB, voffB); PG8_STAGE(PG8_SA(0, 0), cA, voffA); PG8_STAGE(PG8_SA(0, 1), cA + hstep, voffA);
        if (wr == 1) PG8_BAR;
        PG8_WAIT_V(2); PG8_BAR;
        PG8_STAGE(PG8_SB(1, 0), cB + kstep, voffB); PG8_STAGE(PG8_SA(1, 0), cA + kstep, voffA); PG8_STAGE(PG8_SB(1, 1), cB + hstepB + kstep, voffB);
        PG8_WAIT_V(6); PG8_BAR;
    } else {
        PG8_STAGE(PG8_SB(0, 0), cB, voffB); PG8_STAGE(PG8_SA(0, 0), cA, voffA); PG8_STAGE(PG8_SB(0, 1), cB + hstepB, voffB); PG8_STAGE(PG8_SA(0, 1), cA + hstep, voffA);
        if (wr == 1) PG8_BAR;
        PG8_WAIT_V(4); PG8_BAR;
        PG8_STAGE(PG8_SB(1, 0), cB + kstep, voffB); PG8_STAGE(PG8_SA(1, 0), cA + kstep, voffA); PG8_STAGE(PG8_SB(1, 1), cB + hstepB + kstep, voffB);
        PG8_WAIT_V(6); PG8_BAR;
    }
    for (;;) {
        const bool has_next = S.next(ui + 1, nxt);
        const char* nA = has_next ? (const char*)g.A + (size_t)nxt.pm * tstep : cA; const char* nB = has_next ? (const char*)g.Bt + (size_t)nxt.pn * tstep : cB;
        for (int t = 0; t < nt; t += 2) {
            const bool last = (t == nt - 2);
            const char* a1 = cA + (size_t)(t + 1) * kstep;
            const char* a2 = last ? nA : cA + (size_t)(t + 2) * kstep; const char* b2 = last ? nB : cB + (size_t)(t + 2) * kstep;
            const char* a3 = a2 + kstep; const char* b3 = b2 + kstep;
            if (last && has_next) S.a_ready(nxt);
            if constexpr (SP2) {
            PG8_LDB(B0, 0, 0); PG8_LDB(B1, 0, 1); PG8_SCHED; PG8_LDA(At, 0, 0); PG8_STAGE(PG8_SA(1, 1), a1 + hstep, voffA);
            PG8_WAIT_V(8); PG8_WAIT_L(0); PG8_BAR; PG8_MMA(0, 0, At, B0); PG8_MMA(0, 1, At, B1); PG8_BAR; PG8_SCHED;
            PG8_LDA(At, 0, 1); PG8_STAGE(PG8_SB(0, 0), b2, voffB); PG8_STAGE(PG8_SB(0, 1), b2 + hstepB, voffB); PG8_STAGE(PG8_SA(0, 0), a2, voffA);
            PG8_WAIT_V(8); PG8_WAIT_L(0); PG8_BAR; PG8_MMA(1, 0, At, B0); PG8_MMA(1, 1, At, B1); PG8_BAR; PG8_SCHED;
            PG8_LDB(B0, 1, 0); PG8_LDB(B1, 1, 1); PG8_SCHED; PG8_LDA(At, 1, 0); PG8_STAGE(PG8_SA(0, 1), a2 + hstep, voffA);
            PG8_WAIT_V(8); PG8_WAIT_L(0); PG8_BAR; PG8_MMA(0, 0, At, B0); PG8_MMA(0, 1, At, B1); PG8_BAR; PG8_SCHED;
            PG8_LDA(At, 1, 1); PG8_STAGE(PG8_SB(1, 0), b3, voffB); PG8_STAGE(PG8_SB(1, 1), b3 + hstepB, voffB); PG8_STAGE(PG8_SA(1, 0), a3, voffA);
            PG8_WAIT_V(8); PG8_WAIT_L(0); PG8_BAR; PG8_MMA(1, 0, At, B0); PG8_MMA(1, 1, At, B1); PG8_BAR; PG8_SCHED;
            } else {
            PG8_LDB(B0, 0, 0); PG8_SCHED; PG8_LDA(At, 0, 0); PG8_STAGE(PG8_SA(1, 1), a1 + hstep, voffA);
            PG8_WAIT_L(8); PG8_BAR; PG8_WAIT_L(0); PG8_MMA(0, 0, At, B0); PG8_BAR; PG8_SCHED;
            PG8_LDB(B1, 0, 1); PG8_STAGE(PG8_SB(0, 0), b2, voffB);
            PG8_BAR; PG8_WAIT_L(0); PG8_MMA(0, 1, At, B1); PG8_BAR;
            PG8_LDA(At, 0, 1); PG8_STAGE(PG8_SA(0, 0), a2, voffA);
            PG8_BAR; PG8_WAIT_L(0); PG8_MMA(1, 0, At, B0); PG8_BAR; PG8_SCHED;
            PG8_STAGE(PG8_SB(0, 1), b2 + hstepB, voffB);
            PG8_WAIT_V(6); PG8_BAR; PG8_MMA(1, 1, At, B1); PG8_BAR;
            PG8_LDB(B0, 1, 0); PG8_SCHED; PG8_LDA(At, 1, 0); PG8_STAGE(PG8_SA(0, 1), a2 + hstep, voffA);
            PG8_WAIT_L(8); PG8_BAR; PG8_WAIT_L(0); PG8_MMA(0, 0, At, B0); PG8_BAR; PG8_SCHED;
            PG8_LDB(B1, 1, 1); PG8_STAGE(PG8_SB(1, 0), b3, voffB);
            PG8_BAR; PG8_WAIT_L(0); PG8_MMA(0, 1, At, B1); PG8_BAR;
            PG8_LDA(At, 1, 1); PG8_STAGE(PG8_SA(1, 0), a3, voffA);
            PG8_BAR; PG8_WAIT_L(0); PG8_MMA(1, 0, At, B0); PG8_BAR; PG8_SCHED;
            PG8_STAGE(PG8_SB(1, 1), b3 + hstepB, voffB);
            PG8_WAIT_V(6); PG8_BAR; PG8_MMA(1, 1, At, B1); PG8_BAR;
            }
        }
        if constexpr (ALIGN_EPI) { if (wr == 0) PG8_BAR; }
        if constexpr (!Epi::AFTER_DRAIN) { E(acc, cur, wr, wc, fr, fq); S.done(cur); }
        if (!has_next) break;
#pragma unroll
        for (int a = 0; a < 2; ++a)
#pragma unroll
            for (int b = 0; b < 2; ++b)
#pragma unroll
                for (int m = 0; m < 4; ++m)
#pragma unroll
                    for (int n = 0; n < 2; ++n) acc[a][b][m][n] = (f32x4){0.f, 0.f, 0.f, 0.f};
        cur = nxt; cA = nA; cB = nB; ++ui;
        if constexpr (ALIGN_EPI) { if (wr == 1) PG8_BAR; }
    }
    PG8_WAIT_V(0);
    if constexpr (!ALIGN_EPI) { if (wr == 0) PG8_BAR; }
    PG8_BAR;
    if constexpr (Epi::AFTER_DRAIN) { E.fused(acc, cur, wr, wc, fr, fq, lds, wid, lane); S.done(cur); }
#undef PG8_SA
#undef PG8_SB
#undef PG8_STAGE
#undef PG8_LDA
#undef PG8_LDB
#undef PG8_MMA
#undef PG8_WAIT_V
#undef PG8_WAIT_L
#undef PG8_BAR
#undef PG8_SCHED
}
}
#define LAS __attribute__((address_space(3)))
typedef unsigned short bf16_t;
typedef short bf16x8 __attribute__((ext_vector_type(8)));
typedef short s16x4 __attribute__((ext_vector_type(4)));
typedef short v4i16_t __attribute__((ext_vector_type(4)));
typedef float f32x4 __attribute__((ext_vector_type(4)));
typedef float f32x16 __attribute__((ext_vector_type(16)));
typedef unsigned u32x4 __attribute__((ext_vector_type(4)));
typedef unsigned u32x2 __attribute__((ext_vector_type(2)));

constexpr int SEQ = 8192, DM = 1024, MTOK = 65536, NIN = 6144, QKVW = 1536;
constexpr size_t WS_WT = 0, WS_WOT = 13631488, WS_RS = 15728640, WS_LSE = 15990784, WS_BAR = 23068672, WS_GMT = 24117248, WS_XB = 33554432, WS_Z = 167772160, WS_G = 301989888,
                 WS_Q = 436207616, WS_K = 637534208, WS_V = 838860800, WS_END = 1040187392;
constexpr int LDS_BYTES = 162944;
constexpr float LOG2E = 1.4426950408889634f;

__device__ __forceinline__ unsigned f2bf(float f) { unsigned u = __builtin_bit_cast(unsigned, f); return (u + 0x7fffu + ((u >> 16) & 1u)) >> 16; }
typedef float f32x2_t __attribute__((ext_vector_type(2))); typedef __bf16 bf16x2_t __attribute__((ext_vector_type(2)));
__device__ __forceinline__ unsigned pk2(float lo, float hi) { f32x2_t v = {lo, hi}; bf16x2_t b = __builtin_convertvector(v, bf16x2_t); return __builtin_bit_cast(unsigned, b); }
__device__ __forceinline__ float bflo(unsigned w) { return __builtin_bit_cast(float, w << 16); }
__device__ __forceinline__ float bfhi(unsigned w) { return __builtin_bit_cast(float, w & 0xffff0000u); }
__device__ __forceinline__ int crow(int r, int hi) { return (r & 3) + 8 * (r >> 2) + 4 * hi; }
__device__ __forceinline__ float wave_sum(float v) {
#pragma unroll
    for (int o = 1; o < 64; o <<= 1) v += __shfl_xor(v, o);
    return v;
}
__device__ __forceinline__ s16x4 trrd(LAS const unsigned char* p) { return __builtin_bit_cast(s16x4, __builtin_amdgcn_ds_read_tr16_b64_v4i16((LAS v4i16_t*)p)); }
__device__ __forceinline__ float silu_f(float v) { return v * __builtin_amdgcn_rcpf(1.f + __builtin_amdgcn_exp2f(-v * LOG2E)); }
#define LDS_WAIT() asm volatile("s_waitcnt lgkmcnt(0)" ::: "memory")
template <int CTRL> __device__ __forceinline__ unsigned dpp_mov(unsigned v) { return (unsigned)__builtin_amdgcn_update_dpp(0, (int)v, CTRL, 0xF, 0xF, true); }
template <int CTRL> __device__ __forceinline__ float dpp_movf(float v) { return __builtin_bit_cast(float, dpp_mov<CTRL>(__builtin_bit_cast(unsigned, v))); }

struct Args { const float *x, *norm_w, *w_in, *qw, *kw, *wf, *w_out; float* out; unsigned char* ws; };

__device__ __forceinline__ void transpose_item(const float* W, int ldw, int ncol0, bf16_t* WT, int row_off, const float* kscale, LAS float* scr, int kb, int nb, int lane) {
    const int k0 = 64 * kb, n0 = 32 * nb;
#pragma unroll 8
    for (int i = 0; i < 32; ++i) { const int kk = 2 * i + (lane >> 5); float v = W[(size_t)(k0 + kk) * ldw + ncol0 + n0 + (lane & 31)]; if (kscale) v *= kscale[k0 + kk]; scr[kk * 33 + (lane & 31)] = v; }
    LDS_WAIT();
    const int c = lane & 7;
#pragma unroll
    for (int j = 0; j < 4; ++j) { const int n = (lane >> 3) + 8 * j; const LAS float* s = scr + (8 * c) * 33 + n;
        u32x4 o; o.x = pk2(s[0 * 33], s[1 * 33]); o.y = pk2(s[2 * 33], s[3 * 33]); o.z = pk2(s[4 * 33], s[5 * 33]); o.w = pk2(s[6 * 33], s[7 * 33]);
        *(u32x4*)(WT + (size_t)(row_off + n0 + n) * 1024 + k0 + 8 * c) = o; }
    LDS_WAIT();
}
__device__ __forceinline__ void gmt_unit(const Args& a, LAS unsigned char* lds, int unit, int tid) {
    bf16_t* GmT = (bf16_t*)(a.ws + WS_GMT);
    LAS float* tab = (LAS float*)lds;
    if (tid < 64) { float sn, cs; sincospif((float)tid * (1.f / 32.f), &sn, &cs); tab[2 * tid] = cs; tab[2 * tid + 1] = sn; }
    __syncthreads();
    const int g = unit >> 2, d = 16 * (unit & 3) + (tid >> 5), c32 = tid & 31;
    float acc[4] = {0.f, 0.f, 0.f, 0.f};
    for (int l = 0; l < 64; ++l) { const float w = a.wf[(size_t)(g * 64 + l) * 64 + d];
#pragma unroll
        for (int e = 0; e < 4; ++e) { const int cc = c32 * 4 + e, c = cc & 63, idx = (l * c) & 63; acc[e] += w * (cc < 64 ? tab[2 * idx] : -tab[2 * idx + 1]); } }
#pragma unroll
    for (int e = 0; e < 4; ++e) GmT[(size_t)(g * 64 + d) * 128 + c32 * 4 + e] = (bf16_t)f2bf(acc[e] * 0.125f);
    __syncthreads();
}
__device__ __forceinline__ void phase0(const Args& a, LAS unsigned char* lds, int tid, int lane, int wave) {
    bf16_t* Wt = (bf16_t*)(a.ws + WS_WT); bf16_t* WoT = (bf16_t*)(a.ws + WS_WOT); bf16_t* xb = (bf16_t*)(a.ws + WS_XB);
    const int G = gridDim.x, bx = blockIdx.x;
    for (int u = bx; u < 32; u += G) gmt_unit(a, lds, u, tid);
    if (bx == G - 1 && wave < 3) {
        for (int hd = wave * 8; hd < wave * 8 + 8; ++hd) {
            float gqm = fabsf(a.qw[hd * 64 + lane]), gkm = fabsf(a.kw[hd * 64 + lane]);
#pragma unroll
            for (int o = 1; o < 64; o <<= 1) { gqm = fmaxf(gqm, __shfl_xor(gqm, o)); gkm = fmaxf(gkm, __shfl_xor(gkm, o)); }
            if (lane == 0) ((float*)(a.ws + WS_RS))[hd] = 8.08f * LOG2E * gqm * gkm;
        }
    }
    LAS float* scr = (LAS float*)(lds + 32768 + wave * 8448);
    const int gw = bx * 8 + wave, NGW = G * 8;
    constexpr int I_IN = 16 * 192, I_OUT = 16 * 32;
    for (int it = gw; it < I_IN + I_OUT; it += NGW) {
        if (it < I_IN) transpose_item(a.w_in, 6144, 0, Wt, 0, a.norm_w, scr, it / 192, it % 192, lane);
        else { const int r = it - I_IN; transpose_item(a.w_out, 1024, 0, WoT, 0, nullptr, scr, r / 32, r % 32, lane); }
    }
    for (int row = gw; row < MTOK; row += 2 * NGW) {
        const int row2 = row + NGW; const bool has2 = row2 < MTOK;
        const f32x4* xr = (const f32x4*)(a.x + (size_t)row * DM) + lane; const f32x4* xr2 = (const f32x4*)(a.x + (size_t)(has2 ? row2 : row) * DM) + lane;
        f32x4 v[4], v2[4]; float s = 0.f, s2 = 0.f;
#pragma unroll
        for (int j = 0; j < 4; ++j) { v[j] = __builtin_nontemporal_load(xr + 64 * j); v2[j] = __builtin_nontemporal_load(xr2 + 64 * j); }
#pragma unroll
        for (int j = 0; j < 4; ++j) { s += (v[j].x * v[j].x + v[j].y * v[j].y) + (v[j].z * v[j].z + v[j].w * v[j].w); s2 += (v2[j].x * v2[j].x + v2[j].y * v2[j].y) + (v2[j].z * v2[j].z + v2[j].w * v2[j].w); }
        s = wave_sum(s); s2 = wave_sum(s2);
        const float r = 1.0f / sqrtf(s * (1.f / DM) + 1e-6f), r2 = 1.0f / sqrtf(s2 * (1.f / DM) + 1e-6f);
        u32x2* o = (u32x2*)(xb + (size_t)row * DM) + lane;
#pragma unroll
        for (int j = 0; j < 4; ++j) { u32x2 w; w.x = pk2(v[j].x * r, v[j].y * r); w.y = pk2(v[j].z * r, v[j].w * r); o[64 * j] = w; }
        if (has2) { u32x2* o2 = (u32x2*)(xb + (size_t)row2 * DM) + lane;
#pragma unroll
            for (int j = 0; j < 4; ++j) { u32x2 w; w.x = pk2(v2[j].x * r2, v2[j].y * r2); w.y = pk2(v2[j].z * r2, v2[j].w * r2); o2[64 * j] = w; } }
    }
}

struct Epi1 {
    static constexpr bool PERM = true, PERM2 = true, AFTER_DRAIN = false;
    bf16_t *Z, *G, *Q, *Kb, *V;
    __device__ __forceinline__ void operator()(const pg8::f32x4 (&acc)[2][2][4][2], const pg8::Unit& u, int wr, int wc, int fr, int fq) const {
        const int pn = u.pn; const int hi8 = (fr >> 3) & 1, fr7 = fr & 7; const int rbase = u.pm * 256 + wr * 64 + fr7;
        const bool qkv = (pn >= 4 && pn < 22);
        const bool act = !qkv && pn >= 2;
        const int ld = pn < 2 ? 512 : 1024;
        bf16_t* base; int dsh = 0; size_t rowstride_tok = 0; int ecol;
        if (qkv) { const int which = (pn - 4) / 6, ct = (pn - 4) % 6; dsh = 2 * (ct >> 1);
            base = Q + (size_t)which * ((WS_K - WS_Q) / 2) + (size_t)(ct * 4 + wc) * SEQ * 64; ecol = 32 * hi8 + 8 * fq; }
        else { const int c0 = pn < 2 ? pn * 256 : (pn < 4 ? (pn - 2) * 256 : 512 + (pn - 22) * 256); base = (pn < 2 ? Z : G) + c0 + wc * 64; ecol = 32 * hi8 + 8 * fq; }
        const int dmask = (1 << dsh) - 1, Lc = SEQ >> dsh;
#pragma unroll
        for (int ai = 0; ai < 2; ++ai)
#pragma unroll
            for (int m = 0; m < 4; ++m) {
                pg8::f32x4 a0 = acc[ai][0][m][0], a1 = acc[ai][0][m][1], b0 = acc[ai][1][m][0], b1 = acc[ai][1][m][1];
                if (act) {
#pragma unroll
                    for (int e = 0; e < 4; ++e) { a0[e] = silu_f(a0[e]); a1[e] = silu_f(a1[e]); b0[e] = silu_f(b0[e]); b1[e] = silu_f(b1[e]); } }
                u32x4 A, B; A.x = pk2(a0[0], a0[1]); A.y = pk2(a0[2], a0[3]); A.z = pk2(a1[0], a1[1]); A.w = pk2(a1[2], a1[3]);
                B.x = pk2(b0[0], b0[1]); B.y = pk2(b0[2], b0[3]); B.z = pk2(b1[0], b1[1]); B.w = pk2(b1[2], b1[3]);
                u32x4 snd, rcv;
#pragma unroll
                for (int e = 0; e < 4; ++e) { snd[e] = hi8 ? A[e] : B[e]; rcv[e] = dpp_mov<0x128>(snd[e]); }
                u32x4 d1, d2;
#pragma unroll
                for (int e = 0; e < 4; ++e) { d1[e] = hi8 ? rcv[e] : A[e]; d2[e] = hi8 ? B[e] : rcv[e]; }
                const int row1 = rbase + ai * 128 + m * 16, row2 = row1 + 8;
                if (qkv) {
                    const int bb = row1 >> 13, t1 = row1 & (SEQ - 1), t2 = row2 & (SEQ - 1);
                    const int p1 = (t1 & dmask) * Lc + (t1 >> dsh), p2 = (t2 & dmask) * Lc + (t2 >> dsh);
                    bf16_t* hb = base + (size_t)bb * 24 * SEQ * 64 + ecol;
                    *(u32x4*)(hb + (size_t)p1 * 64) = d1; *(u32x4*)(hb + (size_t)p2 * 64) = d2;
                } else {
                    *(u32x4*)(base + (size_t)row1 * ld + ecol) = d1; *(u32x4*)(base + (size_t)row2 * ld + ecol) = d2;
                }
            }
    }
};
struct Epi2 {
    static constexpr bool PERM = false, PERM2 = false, AFTER_DRAIN = false;
    const float* x; float* out;
    __device__ __forceinline__ void operator()(const pg8::f32x4 (&acc)[2][2][4][2], const pg8::Unit& u, int wr, int wc, int fr, int fq) const {
        const int row0 = u.pm * 256 + wr * 64 + fr, col0 = u.pn * 256 + wc * 32 + 4 * fq;
#pragma unroll
        for (int ai = 0; ai < 2; ++ai)
#pragma unroll
            for (int m = 0; m < 4; ++m) { const size_t off = (size_t)(row0 + ai * 128 + m * 16) * DM + col0;
#pragma unroll
                for (int bj = 0; bj < 2; ++bj)
#pragma unroll
                    for (int n = 0; n < 2; ++n) { const size_t o2 = off + bj * 128 + n * 16; *(pg8::f32x4*)(out + o2) = *(const pg8::f32x4*)(x + o2) + acc[ai][bj][m][n]; }
                if (m & 1) asm volatile("" ::: "memory"); }
    }
};

constexpr int TP = 192;
constexpr int TTP = 272;
template <int NROWS> __device__ __forceinline__ void load_tile(LAS unsigned char* lds, const bf16_t* src, size_t rstride, int tid) {
    u32x4 v[NROWS / 64];
#pragma unroll
    for (int i = 0; i < NROWS / 64; ++i) { const int ci = tid + 512 * i, row = ci >> 3, ch = ci & 7; v[i] = *(const u32x4*)(src + (size_t)row * rstride + ch * 8); }
#pragma unroll
    for (int i = 0; i < NROWS / 64; ++i) { const int ci = tid + 512 * i, row = ci >> 3, ch = ci & 7; *(LAS u32x4*)(lds + row * TP + ch * 16) = v[i]; }
}
__device__ __forceinline__ void dft1_phase(const Args& a, LAS unsigned char* lds, int tid, int lane, int wave) {
    asm volatile("" : "+v"(tid), "+v"(lane));
    const bf16_t* Z = (const bf16_t*)(a.ws + WS_Z); bf16_t* Y = (bf16_t*)(a.ws + WS_XB);
    const int h = lane >> 5, l31 = lane & 31, kb = wave & 3, nt = wave >> 2;
    bf16x8 af[8];
    { const int ri_row = l31 >> 4, k1 = 16 * kb + (l31 & 15);
#pragma unroll
      for (int ks = 0; ks < 8; ++ks) { unsigned pw[4];
#pragma unroll
        for (int jj = 0; jj < 4; ++jj) { float vv[2];
#pragma unroll
            for (int e = 0; e < 2; ++e) { const int s1 = 16 * ks + 8 * h + 2 * jj + e; float sn, cs; sincospif((float)((s1 * k1) & 127) * (1.f / 64.f), &sn, &cs);
                float val = ri_row == 0 ? cs : sn;
                if (ri_row == 1 && k1 == 0) val = (s1 & 1) ? -1.f : 1.f;
                vv[e] = val * 0.08838834764831845f; }
            pw[jj] = pk2(vv[0], vv[1]); }
        u32x4 t; t.x = pw[0]; t.y = pw[1]; t.z = pw[2]; t.w = pw[3]; af[ks] = __builtin_bit_cast(bf16x8, t); } }
    const int q = (lane & 15) >> 2, p = lane & 3, blk = (lane >> 4) & 1;
    LAS const unsigned char* rb = lds + (8 * h + q) * TP + 32 * blk + 8 * p + nt * 64;
    u32x4 pf[2][2];
#define DFT1_ISSUE(zz, uu) do { const int dc_ = (uu) & 7, s2_ = ((uu) >> 3) & 63, b_ = (uu) >> 9; const bf16_t* src_ = Z + ((size_t)b_ * SEQ + s2_) * 512 + dc_ * 64; \
        _Pragma("unroll") for (int i_ = 0; i_ < 2; ++i_) { const int ci_ = tid + 512 * i_; pf[zz][i_] = *(const u32x4*)(src_ + (size_t)(ci_ >> 3) * (64 * 512) + (ci_ & 7) * 8); } } while (0)
    const int G2 = 2 * (int)gridDim.x;
    { const int u0 = blockIdx.x; if (u0 < 4096) DFT1_ISSUE(0, u0); if (u0 + (int)gridDim.x < 4096) DFT1_ISSUE(1, u0 + (int)gridDim.x); }
    for (int u = blockIdx.x; u < 4096; u += G2) {
        const bool has1 = u + (int)gridDim.x < 4096;
#pragma unroll
        for (int z = 0; z < 2; ++z)
#pragma unroll
            for (int i = 0; i < 2; ++i) { const int ci = tid + 512 * i; *(LAS u32x4*)(lds + z * 24576 + (ci >> 3) * TP + (ci & 7) * 16) = pf[z][i]; }
        __syncthreads();
        { const int un = u + G2; if (un < 4096) DFT1_ISSUE(0, un); if (un + (int)gridDim.x < 4096) DFT1_ISSUE(1, un + (int)gridDim.x); }
        f32x16 acc[2]; acc[0] = f32x16{}; acc[1] = f32x16{};
#pragma unroll
        for (int ks = 0; ks < 8; ++ks)
#pragma unroll
            for (int z = 0; z < 2; ++z) { const s16x4 lo = trrd(rb + z * 24576 + ks * 16 * TP), hi = trrd(rb + z * 24576 + ks * 16 * TP + 4 * TP);
                const bf16x8 bfr = __builtin_shufflevector(lo, hi, 0, 1, 2, 3, 4, 5, 6, 7);
                acc[z] = __builtin_amdgcn_mfma_f32_32x32x16_bf16(af[ks], bfr, acc[z], 0, 0, 0); }
#pragma unroll
        for (int z = 0; z < 2; ++z) { const int uz = u + z * (int)gridDim.x, s2 = (uz >> 3) & 63;
            LAS bf16_t* yt = (LAS bf16_t*)(lds + 49152 + z * 16640);
#pragma unroll
            for (int i = 0; i < 8; ++i) { const int k1 = 16 * kb + crow(i, h); const float re = acc[z][i], im = acc[z][i + 8]; const int col = 32 * nt + l31;
                if (k1 != 0) { float sn, cs; sincospif((float)(s2 * k1) * (1.f / 4096.f), &sn, &cs);
                    yt[(2 * k1) * 64 + col] = (bf16_t)f2bf(cs * re - sn * im); yt[(2 * k1 + 1) * 64 + col] = (bf16_t)f2bf(sn * re + cs * im); }
                else { float sn, cs; sincospif((float)s2 * (1.f / 64.f), &sn, &cs);
                    yt[col] = (bf16_t)f2bf(re); yt[64 + col] = (bf16_t)0; yt[128 * 64 + col] = (bf16_t)f2bf(cs * im); yt[129 * 64 + col] = (bf16_t)f2bf(sn * im); } } }
        __syncthreads();
#pragma unroll
        for (int z = 0; z < 2; ++z) { if (z == 1 && !has1) break;
            const int uz = u + z * (int)gridDim.x, dc = uz & 7, s2 = (uz >> 3) & 63, b = uz >> 9;
            LAS const bf16_t* yt = (LAS const bf16_t*)(lds + 49152 + z * 16640);
#pragma unroll
            for (int zz = 0; zz < 3; ++zz) { const int ci = tid + 512 * zz; if (ci < 130 * 8) { const int row = ci >> 3, ch = ci & 7, k1 = row < 128 ? (row >> 1) : 64, ri = row < 128 ? (row & 1) : (row - 128);
                *(u32x4*)(Y + ((size_t)((b * 128 + k1) * 2 + ri) * 64 + s2) * 512 + dc * 64 + ch * 8) = *(LAS const u32x4*)(yt + row * 64 + ch * 8); } } }
        __syncthreads();
    }
}
__device__ __forceinline__ void dft2_phase(const Args& a, LAS unsigned char* lds, int tid, int lane, int wave) {
    asm volatile("" : "+v"(tid), "+v"(lane));
    const bf16_t* Y = (const bf16_t*)(a.ws + WS_XB); const bf16_t* Gb = (const bf16_t*)(a.ws + WS_G); bf16_t* ym = (bf16_t*)(a.ws + WS_Z); const bf16_t* GmT = (const bf16_t*)(a.ws + WS_GMT);
    const int h = lane >> 5, l31 = lane & 31, ksub = wave >> 2, mh = (wave >> 1) & 1, nt = wave & 1;
    bf16x8 af[2][8];
#pragma unroll
    for (int z = 0; z < 2; ++z) { const int m = 64 * mh + 32 * z + l31, k2 = m & 63, imrow = m >> 6;
#pragma unroll
      for (int ks = 0; ks < 8; ++ks) { unsigned pw[4];
#pragma unroll
        for (int jj = 0; jj < 4; ++jj) { float vv[2];
#pragma unroll
            for (int e = 0; e < 2; ++e) { const int kk = 16 * ks + 8 * h + 2 * jj + e, ri = kk >> 6, s2 = kk & 63; float sn, cs; sincospif((float)((s2 * k2) & 63) * (1.f / 32.f), &sn, &cs);
                vv[e] = (imrow == 0 ? (ri == 0 ? cs : -sn) : (ri == 0 ? sn : cs)) * 0.125f; }
            pw[jj] = pk2(vv[0], vv[1]); }
        u32x4 t; t.x = pw[0]; t.y = pw[1]; t.z = pw[2]; t.w = pw[3]; af[z][ks] = __builtin_bit_cast(bf16x8, t); } }
    const int q = (lane & 15) >> 2, p = lane & 3, blk = (lane >> 4) & 1;
    LAS const unsigned char* rb = lds + (ksub * 128 + 8 * h + q) * TP + 32 * blk + 8 * p + nt * 64;
    LAS unsigned char* tt = lds + 49152;
    LAS float* ot = (LAS float*)(lds + 83968);
    const int mt2 = wave >> 1, nt2 = wave & 1;
    u32x4 ld[4];
#define DFT2_ISSUE(uu) do { const int dc_ = (uu) & 7, k1p_ = ((uu) >> 3) & 63, b_ = (uu) >> 9; \
        if (k1p_ == 0) { _Pragma("unroll") for (int z_ = 0; z_ < 2; ++z_) { const int ci_ = tid + 512 * z_; const size_t o_ = (size_t)(ci_ >> 3) * 512 + dc_ * 64 + (ci_ & 7) * 8; \
                ld[z_] = __builtin_nontemporal_load((const u32x4*)(Y + ((size_t)(b_ * 128) * 128) * 512 + o_)); ld[2 + z_] = __builtin_nontemporal_load((const u32x4*)(Y + ((size_t)(b_ * 128 + 64) * 128) * 512 + o_)); } } \
        else { const bf16_t* src_ = Y + ((size_t)(b_ * 128 + k1p_) * 128 + (tid >> 3)) * 512 + dc_ * 64 + (tid & 7) * 8; ld[0] = __builtin_nontemporal_load((const u32x4*)src_); ld[1] = __builtin_nontemporal_load((const u32x4*)(src_ + (size_t)64 * 512)); } } while (0)
    if ((int)blockIdx.x < 4096) DFT2_ISSUE((int)blockIdx.x);
    const bool gf_fixed = (gridDim.x & 7u) == 0u;
    bf16x8 gf[8];
#pragma unroll
    for (int ks = 0; ks < 8; ++ks) gf[ks] = *(const bf16x8*)(GmT + (size_t)((blockIdx.x & 7) * 64 + 32 * nt2 + l31) * 128 + 16 * ks + 8 * h);
    for (int u = blockIdx.x; u < 4096; u += gridDim.x) {
        const int dc = u & 7, k1p = (u >> 3) & 63, b = u >> 9;
        if (!gf_fixed) {
#pragma unroll
            for (int ks = 0; ks < 8; ++ks) gf[ks] = *(const bf16x8*)(GmT + (size_t)(dc * 64 + 32 * nt2 + l31) * 128 + 16 * ks + 8 * h); }
        const int k1a = k1p, k1b = k1p == 0 ? 64 : 128 - k1p;
        const int tr_e = tid >> 2, qt_e = tid & 3; const size_t tok_e = (size_t)b * SEQ + ((tr_e >> 6) ? k1b : k1a) + 128 * (tr_e & 63);
        const u32x4 g0 = __builtin_nontemporal_load((const u32x4*)(Gb + tok_e * 1024 + dc * 64 + qt_e * 16)), g1 = __builtin_nontemporal_load((const u32x4*)(Gb + tok_e * 1024 + dc * 64 + qt_e * 16 + 8));
        if (k1p == 0) {
#pragma unroll
            for (int z = 0; z < 2; ++z) { const int ci = tid + 512 * z, row = ci >> 3, ch = ci & 7; *(LAS u32x4*)(lds + row * TP + ch * 16) = ld[z]; *(LAS u32x4*)(lds + (128 + row) * TP + ch * 16) = ld[2 + z]; }
        } else {
            const int s2 = tid >> 3, ch = tid & 7;
            const u32x4 yr = ld[0], yi = ld[1];
            float sn, cs; sincospif((float)s2 * (1.f / 32.f), &sn, &cs);
            u32x4 zr, zi;
#pragma unroll
            for (int e = 0; e < 4; ++e) { const float rl = bflo(yr[e]), rh = bfhi(yr[e]), il = bflo(yi[e]), ih = bfhi(yi[e]);
                zr[e] = pk2(rl * cs + il * sn, rh * cs + ih * sn); zi[e] = pk2(rl * sn - il * cs, rh * sn - ih * cs); }
            *(LAS u32x4*)(lds + s2 * TP + ch * 16) = yr; *(LAS u32x4*)(lds + (64 + s2) * TP + ch * 16) = yi;
            *(LAS u32x4*)(lds + (128 + s2) * TP + ch * 16) = zr; *(LAS u32x4*)(lds + (192 + s2) * TP + ch * 16) = zi;
        }
        __syncthreads();
        if (u + (int)gridDim.x < 4096) DFT2_ISSUE(u + (int)gridDim.x);
        f32x16 acc[2]; acc[0] = f32x16{}; acc[1] = f32x16{};
#pragma unroll
        for (int ks = 0; ks < 8; ++ks) { const s16x4 lo = trrd(rb + ks * 16 * TP), hi = trrd(rb + ks * 16 * TP + 4 * TP);
            const bf16x8 bfr = __builtin_shufflevector(lo, hi, 0, 1, 2, 3, 4, 5, 6, 7);
            acc[0] = __builtin_amdgcn_mfma_f32_32x32x16_bf16(af[0][ks], bfr, acc[0], 0, 0, 0);
            acc[1] = __builtin_amdgcn_mfma_f32_32x32x16_bf16(af[1][ks], bfr, acc[1], 0, 0, 0); }
#pragma unroll
        for (int z = 0; z < 2; ++z)
#pragma unroll
            for (int i = 0; i < 16; ++i) *(LAS bf16_t*)(tt + (ksub * 64 + 32 * z + crow(i, h)) * TTP + (mh * 64 + 32 * nt + l31) * 2) = (bf16_t)f2bf(acc[z][i]);
        __syncthreads();
        f32x16 o2 = f32x16{}, o2b = f32x16{};
#pragma unroll
        for (int ks = 0; ks < 8; ks += 2) { const bf16x8 tf = *(LAS const bf16x8*)(tt + (32 * mt2 + l31) * TTP + (16 * ks + 8 * h) * 2), tf2 = *(LAS const bf16x8*)(tt + (32 * mt2 + l31) * TTP + (16 * (ks + 1) + 8 * h) * 2);
            o2 = __builtin_amdgcn_mfma_f32_32x32x16_bf16(tf, gf[ks], o2, 0, 0, 0); o2b = __builtin_amdgcn_mfma_f32_32x32x16_bf16(tf2, gf[ks + 1], o2b, 0, 0, 0); }
#pragma unroll
        for (int i = 0; i < 16; ++i) o2[i] += o2b[i];
#pragma unroll
        for (int i = 0; i < 16; ++i) ot[(32 * mt2 + crow(i, h)) * 64 + 32 * nt2 + l31] = o2[i];
        __syncthreads();
        {
            const int tr = tid >> 2, qt = tid & 3, ks2 = tr >> 6, k2 = tr & 63;
            const size_t tok = (size_t)b * SEQ + (ks2 ? k1b : k1a) + 128 * k2;
            const LAS f32x4* op = (const LAS f32x4*)(ot + tr * 64 + qt * 16);
            const f32x4 v0 = op[0], v1 = op[1], v2 = op[2], v3 = op[3];
            u32x4 w0, w1;
            w0.x = pk2(v0.x * bflo(g0.x), v0.y * bfhi(g0.x)); w0.y = pk2(v0.z * bflo(g0.y), v0.w * bfhi(g0.y)); w0.z = pk2(v1.x * bflo(g0.z), v1.y * bfhi(g0.z)); w0.w = pk2(v1.z * bflo(g0.w), v1.w * bfhi(g0.w));
            w1.x = pk2(v2.x * bflo(g1.x), v2.y * bfhi(g1.x)); w1.y = pk2(v2.z * bflo(g1.y), v2.w * bfhi(g1.y)); w1.z = pk2(v3.x * bflo(g1.z), v3.y * bfhi(g1.z)); w1.w = pk2(v3.z * bflo(g1.w), v3.w * bfhi(g1.w));
            *(u32x4*)(ym + tok * 1024 + dc * 64 + qt * 16) = w0; *(u32x4*)(ym + tok * 1024 + dc * 64 + qt * 16 + 8) = w1;
        }
        __syncthreads();
    }
}

constexpr int KP = 144, VP = 192, KROWS = 384, LDS_VOFF = KROWS * KP;
struct AUnit { int b, hd, dil, L, r, i0; };
__device__ __forceinline__ AUnit attn_decode(int u, int hd0, int nh) {
    AUnit w; const int blk32 = u & 31; w.hd = hd0 + (u >> 5) % nh; w.b = u / (32 * nh);
    const int dsh = 2 * (w.hd >> 3), nbr = 32 >> dsh; w.dil = 1 << dsh; w.L = SEQ >> dsh; w.r = blk32 / nbr; w.i0 = (blk32 % nbr) * 256; return w;
}
__device__ __forceinline__ void attn_issue(const AUnit& w, const bf16_t* Qb, const bf16_t* Kb, const bf16_t* Vb, int tid, int wave, int lane, u32x4 (&kv)[6], u32x4 (&vv)[6]) {
    const int ch = tid & 7;
#pragma unroll
    for (int i = 0; i < 6; ++i) { const int row = (tid + 512 * i) >> 3; int pk = w.i0 - 64 + row; pk = pk < 0 ? 0 : (pk >= w.L ? w.L - 1 : pk);
        const size_t off = ((size_t)(w.b * 24 + w.hd) * SEQ + (size_t)(w.r * w.L + pk)) * 64 + ch * 8; kv[i] = *(const u32x4*)(Kb + off); vv[i] = *(const u32x4*)(Vb + off); }
}
__device__ __forceinline__ float attn_tile_exp(f32x16& st, int j, float tlf, float bsl, float rlo, float rhi) {
    float sum = 0.f;
#pragma unroll
    for (int i = 0; i < 16; ++i) { const float tmp = (float)(32 * j - 64 + (i & 3) + 8 * (i >> 2)) + tlf;
        float arg = __builtin_fmaf(-bsl, __builtin_fabsf(tmp), st[i]);
        arg = (tmp >= rlo && tmp <= rhi) ? arg : -1.0e30f;
        const float pe = __builtin_amdgcn_exp2f(arg); st[i] = pe; sum += pe; }
    return sum;
}
template <bool FUSED> __device__ __forceinline__ void attn_phase(const Args& a, LAS unsigned char* lds, int tid, int lane, int wave) {
    constexpr int HD0 = FUSED ? 0 : 8, NH = FUSED ? 8 : 16, NU = 8 * NH * 32;
    asm volatile("" : "+v"(tid), "+v"(lane));
    bf16_t* Qb = (bf16_t*)(a.ws + WS_Q); const bf16_t* Kb = (const bf16_t*)(a.ws + WS_K); const bf16_t* Vb = (const bf16_t*)(a.ws + WS_V); float* LSE = (float*)(a.ws + WS_LSE);
    const int h = lane >> 5, l31 = lane & 31;
    const int q = (lane & 15) >> 2, p = lane & 3, blk = (lane >> 4) & 1;
    int u = blockIdx.x;
    u32x4 kv[6], vv[6], qv[4];
#define ATTN_QLOAD(W) do { const bf16_t* qr_ = Qb + ((size_t)((W).b * 24 + (W).hd) * SEQ + (size_t)((W).r * (W).L + (W).i0 + 32 * wave + l31)) * 64; \
        _Pragma("unroll") for (int ks_ = 0; ks_ < 4; ++ks_) qv[ks_] = *(const u32x4*)(qr_ + 16 * ks_ + 8 * h); } while (0)
    if (u < NU) { const AUnit w0 = attn_decode(u, HD0, NH); attn_issue(w0, Qb, Kb, Vb, tid, wave, lane, kv, vv); ATTN_QLOAD(w0); }
    while (u < NU) {
        const AUnit w = attn_decode(u, HD0, NH);
        const int hd = w.hd, slot = hd & 7, L = w.L, i0 = w.i0;
        const int iq = i0 + 32 * wave + l31; const size_t tq = (size_t)w.b * SEQ + (size_t)iq * w.dil + w.r;
        bf16_t* qrow = Qb + ((size_t)(w.b * 24 + hd) * SEQ + (size_t)(w.r * L + iq)) * 64;
        {
            const int ch = tid & 7;
            const f32x4 g0 = *(const f32x4*)(a.kw + hd * 64 + ch * 8), g1 = *(const f32x4*)(a.kw + hd * 64 + ch * 8 + 4);
#pragma unroll
            for (int i = 0; i < 6; ++i) { const int row = (tid + 512 * i) >> 3;
                const float e0 = bflo(kv[i].x), e1 = bfhi(kv[i].x), e2 = bflo(kv[i].y), e3 = bfhi(kv[i].y), e4 = bflo(kv[i].z), e5 = bfhi(kv[i].z), e6 = bflo(kv[i].w), e7 = bfhi(kv[i].w);
                float ss = (e0 * e0 + e1 * e1) + (e2 * e2 + e3 * e3) + (e4 * e4 + e5 * e5) + (e6 * e6 + e7 * e7);
                ss += dpp_movf<0xB1>(ss); ss += dpp_movf<0x4E>(ss); ss += dpp_movf<0x141>(ss);
                const float rk = __builtin_amdgcn_rsqf(ss * (1.f / 64.f) + 1e-6f);
                u32x4 wv; wv.x = pk2(e0 * rk * g0.x, e1 * rk * g0.y); wv.y = pk2(e2 * rk * g0.z, e3 * rk * g0.w); wv.z = pk2(e4 * rk * g1.x, e5 * rk * g1.y); wv.w = pk2(e6 * rk * g1.z, e7 * rk * g1.w);
                *(LAS u32x4*)(lds + row * KP + ch * 16) = wv;
                *(LAS u32x4*)(lds + LDS_VOFF + row * VP + ch * 16) = vv[i];
                if (i & 1) __builtin_amdgcn_sched_barrier(0); }
        }
        bf16x8 qf[4];
        {
            float ss = 0.f;
#pragma unroll
            for (int ks = 0; ks < 4; ++ks)
#pragma unroll
                for (int e = 0; e < 4; ++e) { const float lo = bflo(qv[ks][e]), hi = bfhi(qv[ks][e]); ss += lo * lo + hi * hi; }
            ss += __shfl_xor(ss, 32);
            const float rq = 0.125f * LOG2E * __builtin_amdgcn_rsqf(ss * (1.f / 64.f) + 1e-6f);
#pragma unroll
            for (int ks = 0; ks < 4; ++ks) { const f32x4 g0 = *(const f32x4*)(a.qw + hd * 64 + 16 * ks + 8 * h), g1 = *(const f32x4*)(a.qw + hd * 64 + 16 * ks + 8 * h + 4); u32x4 wv;
                wv.x = pk2(bflo(qv[ks].x) * rq * g0.x, bfhi(qv[ks].x) * rq * g0.y); wv.y = pk2(bflo(qv[ks].y) * rq * g0.z, bfhi(qv[ks].y) * rq * g0.w);
                wv.z = pk2(bflo(qv[ks].z) * rq * g1.x, bfhi(qv[ks].z) * rq * g1.y); wv.w = pk2(bflo(qv[ks].w) * rq * g1.z, bfhi(qv[ks].w) * rq * g1.w);
                qf[ks] = __builtin_bit_cast(bf16x8, wv); }
        }
        const float mb = ((const float*)(a.ws + WS_RS))[hd];
        __syncthreads();
        const int un = u + gridDim.x;
        if (un < NU) { const AUnit wn = attn_decode(un, HD0, NH); attn_issue(wn, Qb, Kb, Vb, tid, wave, lane, kv, vv); }
        const float bsl = __builtin_amdgcn_exp2f(-(float)(slot + 1)) * (float)w.dil * LOG2E;
        int tl = 4 * h - l31; asm volatile("" : "+v"(tl));
        const float tlf = (float)tl;
        const int lo_i = -iq > -64 ? -iq : -64, hi_i = (L - 1 - iq) < 64 ? (L - 1 - iq) : 64;
        const float rlo = (float)lo_i, rhi = (float)hi_i;
        const int wq0 = i0 + 32 * wave;
        const bool edge = (wq0 < 64) || (wq0 + 32 > L - 64);
        float sum = 0.f;
        f32x16 o[2]; o[0] = f32x16{}; o[1] = f32x16{};
#pragma unroll
        for (int j = 0; j < 5; ++j) {
            f32x16 st;
#pragma unroll
            for (int i = 0; i < 16; ++i) st[i] = -mb;
            LAS const unsigned char* kp = lds + (32 * wave + 32 * j + l31) * KP + 16 * h;
#pragma unroll
            for (int ks = 0; ks < 4; ++ks) { const bf16x8 kf = *(LAS const bf16x8*)(kp + 32 * ks); st = __builtin_amdgcn_mfma_f32_32x32x16_bf16(kf, qf[ks], st, 0, 0, 0); }
            sum += attn_tile_exp(st, j, tlf, bsl, rlo, rhi);
#pragma unroll
            for (int s2 = 0; s2 < 2; ++s2) { u32x4 pw; pw.x = pk2(st[8 * s2 + 0], st[8 * s2 + 1]); pw.y = pk2(st[8 * s2 + 2], st[8 * s2 + 3]); pw.z = pk2(st[8 * s2 + 4], st[8 * s2 + 5]); pw.w = pk2(st[8 * s2 + 6], st[8 * s2 + 7]);
                const bf16x8 pf = __builtin_bit_cast(bf16x8, pw);
                LAS const unsigned char* vp = lds + LDS_VOFF + (32 * wave + 32 * j + 16 * s2 + 4 * h + q) * VP + 32 * blk + 8 * p;
#pragma unroll
                for (int dt = 0; dt < 2; ++dt) { const s16x4 lo = trrd(vp + dt * 64), hi = trrd(vp + 8 * VP + dt * 64);
                    const bf16x8 vf = __builtin_shufflevector(lo, hi, 0, 1, 2, 3, 4, 5, 6, 7);
                    o[dt] = __builtin_amdgcn_mfma_f32_32x32x16_bf16(vf, pf, o[dt], 0, 0, 0); } }
            __builtin_amdgcn_sched_barrier(0);
        }
        sum += __shfl_xor(sum, 32);
        if (un < NU) { const AUnit wq = attn_decode(un, HD0, NH); ATTN_QLOAD(wq); }
        const float inv = __builtin_amdgcn_rcpf(sum);
        {
            u32x4 fo1[4], fo2[4], fg[4]; float fl1[4], fl2[4];
            if constexpr (FUSED) {
                const bf16_t* Gb = (const bf16_t*)(a.ws + WS_G);
#pragma unroll
                for (int it = 0; it < 4; ++it) { const int r = 8 * it + (lane >> 3), c16 = lane & 7, t = i0 + 32 * wave + r; const size_t tokg = (size_t)w.b * SEQ + t;
                    fl1[it] = LSE[tokg * 24 + 8 + slot]; fl2[it] = LSE[tokg * 24 + 16 + slot];
                    fo1[it] = __builtin_nontemporal_load((const u32x4*)(Qb + ((size_t)(w.b * 24 + 8 + slot) * SEQ + (t & 3) * 2048 + (t >> 2)) * 64 + c16 * 8));
                    fo2[it] = __builtin_nontemporal_load((const u32x4*)(Qb + ((size_t)(w.b * 24 + 16 + slot) * SEQ + (t & 15) * 512 + (t >> 4)) * 64 + c16 * 8));
                    fg[it] = __builtin_nontemporal_load((const u32x4*)(Gb + tokg * 1024 + 512 + slot * 64 + c16 * 8)); }
            }
            LAS unsigned char* ost = lds + 129024 + wave * 4096;
#pragma unroll
            for (int dt = 0; dt < 2; ++dt)
#pragma unroll
                for (int ig = 0; ig < 4; ++ig) { u32x2 wv; wv.x = pk2(o[dt][4 * ig] * inv, o[dt][4 * ig + 1] * inv); wv.y = pk2(o[dt][4 * ig + 2] * inv, o[dt][4 * ig + 3] * inv);
                    const int p8 = 8 * dt + 2 * ig + h; *(LAS u32x2*)(ost + l31 * 128 + 8 * (p8 ^ (l31 & 15))) = wv; }
            if constexpr (FUSED) { if (h == 0) ((LAS float*)(lds + 161808))[wave * 32 + l31] = mb + __builtin_amdgcn_logf(sum); }
            asm volatile("s_waitcnt lgkmcnt(0)" ::: "memory");
            if constexpr (!FUSED) {
                bf16_t* obase = qrow - l31 * 64;
#pragma unroll
                for (int it = 0; it < 4; ++it) { const int r = 8 * it + (lane >> 3), c16 = lane & 7;
                    u32x4 v = *(LAS const u32x4*)(ost + r * 128 + 16 * (c16 ^ ((r & 15) >> 1)));
                    if (r & 1) { const unsigned t0 = v.x, t1 = v.y; v.x = v.z; v.y = v.w; v.z = t0; v.w = t1; }
                    *(u32x4*)(obase + (size_t)r * 64 + c16 * 8) = v; asm volatile("" ::: "memory"); }
            } else {
                bf16_t* ym = (bf16_t*)(a.ws + WS_Z);
#pragma unroll
                for (int it = 0; it < 4; ++it) { const int r = 8 * it + (lane >> 3), c16 = lane & 7;
                    u32x4 v = *(LAS const u32x4*)(ost + r * 128 + 16 * (c16 ^ ((r & 15) >> 1)));
                    if (r & 1) { const unsigned t0 = v.x, t1 = v.y; v.x = v.z; v.y = v.w; v.z = t0; v.w = t1; }
                    const int t = i0 + 32 * wave + r; const size_t tokg = (size_t)w.b * SEQ + t;
                    const float l0 = ((LAS const float*)(lds + 161808))[wave * 32 + r], l1 = fl1[it], l2 = fl2[it];
                    const float mxl = fmaxf(l0, fmaxf(l1, l2));
                    float w0 = __builtin_amdgcn_exp2f(l0 - mxl), w1 = __builtin_amdgcn_exp2f(l1 - mxl), w2 = __builtin_amdgcn_exp2f(l2 - mxl);
                    const float iw = 1.0f / (w0 + w1 + w2); w0 *= iw; w1 *= iw; w2 *= iw;
                    u32x4 ov;
#pragma unroll
                    for (int e = 0; e < 4; ++e) { const float lo = (bflo(v[e]) * w0 + bflo(fo1[it][e]) * w1 + bflo(fo2[it][e]) * w2) * bflo(fg[it][e]); const float hi = (bfhi(v[e]) * w0 + bfhi(fo1[it][e]) * w1 + bfhi(fo2[it][e]) * w2) * bfhi(fg[it][e]); ov[e] = pk2(lo, hi); }
                    *(u32x4*)(ym + tokg * 1024 + 512 + slot * 64 + c16 * 8) = ov; }
            }
        }
        if constexpr (!FUSED) { if (h == 0) LSE[tq * 24 + hd] = mb + __builtin_amdgcn_logf(sum); }
        __syncthreads();
        u = un;
    }
}
__device__ __forceinline__ void merge_phase(const Args& a, int lane, int wave) {
    asm volatile("" : "+v"(lane));
    const bf16_t* Ob = (const bf16_t*)(a.ws + WS_Q); const bf16_t* Gb = (const bf16_t*)(a.ws + WS_G); const float* LSE = (const float*)(a.ws + WS_LSE); bf16_t* ym = (bf16_t*)(a.ws + WS_Z);
    const int gw = blockIdx.x * 8 + wave, NGW = gridDim.x * 8, slot = lane >> 3;
    for (int tok0 = gw; tok0 < MTOK; tok0 += 2 * NGW) {
        u32x4 o0[2], o1[2], o2[2], g[2]; float l0[2], l1[2], l2[2];
#pragma unroll
        for (int z = 0; z < 2; ++z) { int tok = tok0 + z * NGW; tok = tok < MTOK ? tok : tok0;
            l0[z] = LSE[(size_t)tok * 24 + slot]; l1[z] = LSE[(size_t)tok * 24 + 8 + slot]; l2[z] = LSE[(size_t)tok * 24 + 16 + slot];
            const int b = tok >> 13, t = tok & (SEQ - 1), part = lane & 7;
            o0[z] = __builtin_nontemporal_load((const u32x4*)(Ob + ((size_t)(b * 24 + slot) * SEQ + t) * 64 + part * 8));
            o1[z] = __builtin_nontemporal_load((const u32x4*)(Ob + ((size_t)(b * 24 + 8 + slot) * SEQ + (t & 3) * 2048 + (t >> 2)) * 64 + part * 8));
            o2[z] = __builtin_nontemporal_load((const u32x4*)(Ob + ((size_t)(b * 24 + 16 + slot) * SEQ + (t & 15) * 512 + (t >> 4)) * 64 + part * 8));
            g[z] = __builtin_nontemporal_load((const u32x4*)(Gb + (size_t)tok * 1024 + 512 + lane * 8)); }
#pragma unroll
        for (int z = 0; z < 2; ++z) { const int tok = tok0 + z * NGW; if (tok >= MTOK) break;
            const float mx = fmaxf(l0[z], fmaxf(l1[z], l2[z]));
            float w0 = __builtin_amdgcn_exp2f(l0[z] - mx), w1 = __builtin_amdgcn_exp2f(l1[z] - mx), w2 = __builtin_amdgcn_exp2f(l2[z] - mx);
            const float inv = 1.0f / (w0 + w1 + w2); w0 *= inv; w1 *= inv; w2 *= inv;
            u32x4 w;
#pragma unroll
            for (int e = 0; e < 4; ++e) { const float lo = (bflo(o0[z][e]) * w0 + bflo(o1[z][e]) * w1 + bflo(o2[z][e]) * w2) * bflo(g[z][e]); const float hi = (bfhi(o0[z][e]) * w0 + bfhi(o1[z][e]) * w1 + bfhi(o2[z][e]) * w2) * bfhi(g[z][e]); w[e] = pk2(lo, hi); }
            *(u32x4*)(ym + (size_t)tok * 1024 + 512 + lane * 8) = w; }
    }
}

#define XB_TMO      128
#define XB_XCNT(j)  (256  + 64 * (j))
#define XB_XSUB(j)  (1280 + 64 * (j))
#define XB_XGEN(j)  (2304 + 64 * (j))
#define XB_TOP      3328
#define XB_TOPGEN   3392
#define XCD_BAR_WORDS 3456
#define XB_SPIN_CAP (1u << 18)

__device__ __forceinline__ unsigned xb_ld(unsigned* p)              { return __hip_atomic_load(p, __ATOMIC_RELAXED, __HIP_MEMORY_SCOPE_AGENT); }
__device__ __forceinline__ unsigned xb_add(unsigned* p, unsigned v) { return __hip_atomic_fetch_add(p, v, __ATOMIC_RELAXED, __HIP_MEMORY_SCOPE_AGENT); }
__device__ __forceinline__ unsigned xb_xcc_id() { return (unsigned)__builtin_amdgcn_s_getreg((3 << 11) | 20) & 0xFu; }
#define XB_SPIN(cond, bar) do { unsigned _sp = 0; while (cond) { __builtin_amdgcn_s_sleep(1); \
    if ((++_sp & 255u) == 0u) { if (xb_ld(&(bar)[XB_TMO])) break; if (_sp > XB_SPIN_CAP) { atomicAdd(&(bar)[XB_TMO], 1u); break; } } } } while (0)

struct XcdBarrier {
    unsigned* bar; unsigned x;
    volatile LAS unsigned* st;
};

__device__ __forceinline__ XcdBarrier xcd_barrier_post(unsigned* bar, volatile LAS unsigned* st) {
    XcdBarrier b; b.bar = bar; b.x = xb_xcc_id(); b.st = st;
    if (threadIdx.x == 0) (void)xb_add(&bar[XB_XCNT(b.x)], 1u);
    return b;
}
__device__ __forceinline__ void xcd_barrier_complete(unsigned* bar, unsigned x, unsigned& nloc, unsigned& nx) {
    const unsigned G = gridDim.x * gridDim.y * gridDim.z;
    unsigned sum, cnt, mine, sp = 0u;
    for (;;) {
        sum = 0u; cnt = 0u; mine = 0u;
#pragma unroll
        for (unsigned j = 0; j < 16; ++j) { const unsigned c = xb_ld(&bar[XB_XCNT(j)]); sum += c; cnt += (c > 0u) ? 1u : 0u; mine = (j == x) ? c : mine; }
        if (sum == G) break;
        __builtin_amdgcn_s_sleep(1);
        if ((++sp & 255u) == 0u) { if (xb_ld(&bar[XB_TMO])) break; if (sp > XB_SPIN_CAP) { atomicAdd(&bar[XB_TMO], 1u); break; } }
    }
    nloc = mine > 0u ? mine : 1u; nx = cnt > 0u ? cnt : 1u;
}

__device__ __forceinline__ void xcd_barrier(const XcdBarrier& b) {
    asm volatile("s_waitcnt vmcnt(0)" ::: "memory");
    __syncthreads();
    if (threadIdx.x == 0) {
        unsigned* bar = b.bar;
        __builtin_amdgcn_s_waitcnt(0);
        unsigned nloc = b.st[0], nx = b.st[1];
        if (nloc == 0u) { xcd_barrier_complete(bar, b.x, nloc, nx); b.st[0] = nloc; b.st[1] = nx; }
        const unsigned old = xb_add(&bar[XB_XSUB(b.x)], 1u);
        const unsigned gen = old / nloc;
        if (old + 1u == (gen + 1u) * nloc) {
            __builtin_amdgcn_fence(__ATOMIC_RELEASE, "agent");
            asm volatile("s_waitcnt vmcnt(0)" ::: "memory");
            const unsigned og = xb_add(&bar[XB_TOP], 1u);
            const unsigned tg = og / nx;
            if (og + 1u == (tg + 1u) * nx) xb_add(&bar[XB_TOPGEN], 1u);
            else XB_SPIN(xb_ld(&bar[XB_TOPGEN]) == tg, bar);
            __builtin_amdgcn_fence(__ATOMIC_ACQUIRE, "agent");
            xb_add(&bar[XB_XGEN(b.x)], 1u);
            asm volatile("s_waitcnt vmcnt(0)" ::: "memory");
        } else {
            XB_SPIN(xb_ld(&bar[XB_XGEN(b.x)]) == gen, bar);
            __builtin_amdgcn_fence(__ATOMIC_ACQUIRE, "agent");
            asm volatile("s_waitcnt vmcnt(0)" ::: "memory");
        }
    }
    __syncthreads();
}

__global__ void __launch_bounds__(512, 2) mega_fwd(Args a) {
    extern __shared__ __attribute__((aligned(16))) unsigned char lds_raw[];
    LAS unsigned char* lds = (LAS unsigned char*)lds_raw;
    cg::grid_group grid = cg::this_grid();
    const int tid = threadIdx.x, lane = tid & 63, wave = __builtin_amdgcn_readfirstlane(tid >> 6);
    volatile LAS unsigned* bst = (volatile LAS unsigned*)(lds + 161792);
    if (tid < 2) bst[tid] = 0u;
    __syncthreads();
    XcdBarrier bar = xcd_barrier_post((unsigned*)(a.ws + WS_BAR), bst);
    if (a.ws == nullptr) grid.sync();
#ifndef REP0
#define REP0 1
#define REP1 1
#define REPD1 1
#define REPD2 1
#define REPM 1
#define REP4 1
#endif
    for (int rep = 0; rep < REP0; ++rep) phase0(a, lds, tid, lane, wave);
    xcd_barrier(bar);
    {
        pg8::Gemm g{(const pg8::bf16_t*)(a.ws + WS_XB), (const pg8::bf16_t*)(a.ws + WS_WT), MTOK, NIN, DM}; pg8::StaticOrder S; S.init(MTOK, NIN, gridDim.x, (int)blockIdx.x, REP1);
        Epi1 E{(bf16_t*)(a.ws + WS_Z), (bf16_t*)(a.ws + WS_G), (bf16_t*)(a.ws + WS_Q), (bf16_t*)(a.ws + WS_K), (bf16_t*)(a.ws + WS_V)};
        pg8::gemm_phase<Epi1, pg8::StaticOrder, true, true>(lds, g, S, E);
    }
    xcd_barrier(bar);
    attn_phase<false>(a, lds, tid, lane, wave);
    for (int rep = 0; rep < REPD1; ++rep) dft1_phase(a, lds, tid, lane, wave);
    xcd_barrier(bar);
    for (int rep = 0; rep < REPD2; ++rep) dft2_phase(a, lds, tid, lane, wave);
    attn_phase<true>(a, lds, tid, lane, wave);
    xcd_barrier(bar);
    {
        pg8::Gemm g{(const pg8::bf16_t*)(a.ws + WS_Z), (const pg8::bf16_t*)(a.ws + WS_WOT), MTOK, DM, DM}; pg8::StaticOrder S; S.init(MTOK, DM, gridDim.x, (int)blockIdx.x, REP4);
        Epi2 E{a.x, a.out};
        pg8::gemm_phase<Epi2, pg8::StaticOrder, true, true>(lds, g, S, E);
    }
}

extern "C" void kernel_launch(void* const* d_in, const int* in_sizes, int n_in, void* d_out, int out_size, void* d_ws, size_t ws_size, hipStream_t stream) {
    static int grid = 0;
    if (grid == 0) {
        if (n_in != 7 || in_sizes[0] != MTOK * DM || out_size != MTOK * DM || ws_size < WS_END) { fprintf(stderr, "kernel_launch: unexpected shapes / workspace (%d inputs, ws %zu)\n", n_in, ws_size); grid = -1; return; }
        int dev = 0, cus = 0, per_cu = 0;
        hipGetDevice(&dev); hipDeviceGetAttribute(&cus, hipDeviceAttributeMultiprocessorCount, dev);
        hipFuncSetAttribute((const void*)mega_fwd, hipFuncAttributeMaxDynamicSharedMemorySize, LDS_BYTES);
        hipOccupancyMaxActiveBlocksPerMultiprocessor(&per_cu, (const void*)mega_fwd, 512, LDS_BYTES);
        if (per_cu < 1) { fprintf(stderr, "kernel_launch: occupancy query says %d blocks per CU\n", per_cu); per_cu = 1; }
        grid = cus;
        (void)hipGetLastError();
    }
    if (grid < 0) return;
    Args a{};
    a.x = (const float*)d_in[0]; a.norm_w = (const float*)d_in[1]; a.w_in = (const float*)d_in[2]; a.qw = (const float*)d_in[3]; a.kw = (const float*)d_in[4];
    a.wf = (const float*)d_in[5]; a.w_out = (const float*)d_in[6]; a.out = (float*)d_out; a.ws = (unsigned char*)d_ws;
    if (hipMemsetAsync((char*)d_ws + WS_BAR, 0, 16384, stream) != hipSuccess) { fprintf(stderr, "kernel_launch: memset of the barrier words failed\n"); return; }
    void* args[] = {&a};
    hipError_t e = hipLaunchCooperativeKernel((const void*)mega_fwd, dim3(grid), dim3(512), args, LDS_BYTES, stream);
    if (e != hipSuccess) fprintf(stderr, "cooperative launch failed: %s (grid %d)\n", hipGetErrorString(e), grid);
}
```

```cpp
#include <hip/hip_runtime.h>
#include <hip/hip_cooperative_groups.h>
#include <cstdio>
#include <cstdint>
namespace cg = cooperative_groups;
namespace pg8 {
#define PG8_LAS __attribute__((address_space(3)))
typedef unsigned short bf16_t;
typedef short bf16x8 __attribute__((ext_vector_type(8)));
typedef float f32x4 __attribute__((ext_vector_type(4)));
typedef unsigned u32x4 __attribute__((ext_vector_type(4)));
constexpr int BM = 256, BK = 64, HALF = 128, HTB = HALF * BK * 2  , STAGE_BYTES = 8 * HTB, NXCD = 8, WGM = 8;

__host__ __device__ __forceinline__ int lds_byte(int r, int c) { const int st = (r >> 4) * 2 + (c >> 5), rr = r & 15, cc = c & 31, ob = rr * 64 + cc * 2; return st * 1024 + (ob ^ (((ob >> 9) & 1) << 5)); }
__host__ __device__ __forceinline__ void stage_rc(int b, int& R, int& C) { const int st = b / 1024, sb = b % 1024, swz = sb ^ (((sb >> 9) & 1) << 5); R = (st >> 1) * 16 + swz / 64; C = (st & 1) * 32 + (swz % 64) / 2; }
__host__ __device__ __forceinline__ int perm32(int rho) { const int n = rho >> 4, i = rho & 15; return 8 * (i >> 2) + 4 * n + (i & 3); }

struct Unit { int pm, pn; };
struct Gemm { const bf16_t* A; const bf16_t* Bt; int M, N, K; };

struct StaticOrder {
    int nM, nN, nwg, G, c, rep;
    __host__ __device__ void init(int M, int N, int G_, int c_, int rep_ = 1) { nM = M / BM; nN = N / BM; nwg = nM * nN; G = G_; c = c_; rep = rep_; }
    __host__ __device__ bool next(int i, Unit& u) const {
        const int per = (nwg + G - 1) / G; if (i >= per * rep) return false; const long L = (long)(i % per) * G + c; if (L >= nwg) return false;
        int wgid = (int)L; { const int q = nwg / NXCD, r = nwg % NXCD, xcd = wgid % NXCD, off = wgid / NXCD; wgid = (xcd < r ? xcd * (q + 1) : r * (q + 1) + (xcd - r) * q) + off; }
        const int nig = WGM * nN, gid = wgid / nig, fm = gid * WGM, gsz = (nM - fm) < WGM ? (nM - fm) : WGM;
        u.pm = fm + ((wgid % nig) % gsz); u.pn = (wgid % nig) / gsz; return true;
    }
    __device__ __forceinline__ void a_ready(const Unit&) const {}
    __device__ __forceinline__ void done(const Unit&) const {}
};

__device__ __forceinline__ unsigned cvt_pk_bf16(float lo, float hi) { unsigned r; asm volatile("v_cvt_pk_bf16_f32 %0, %1, %2" : "=v"(r) : "v"(lo), "v"(hi)); return r; }
typedef float f32x2 __attribute__((ext_vector_type(2)));
template <class Epi, class Sched, bool ALIGN_EPI = false, bool SP2 = false>
__device__ __forceinline__ void gemm_phase(PG8_LAS unsigned char* lds, const Gemm g, const Sched& S, const Epi& E) {
    const int tid = threadIdx.x, wid = __builtin_amdgcn_readfirstlane(tid >> 6), lane = tid & 63, wr = wid >> 2, wc = wid & 3, fr = lane & 15, fq = lane >> 4;
    const int K = g.K, nt = K / BK;
    unsigned voffA[2], voffB[2];
#pragma unroll
    for (int i = 0; i < 2; ++i) { int R, C; stage_rc(tid * 16 + i * 8192, R, C); const int Rb = Epi::PERM2 ? (64 * (R >> 5) + perm32(R & 31)) : (Epi::PERM ? ((R & ~31) + perm32(R & 31)) : R);
        voffA[i] = (unsigned)(R * K + C) * 2u; voffB[i] = (unsigned)(Rb * K + C) * 2u; }
    const size_t kstep = (size_t)(BK * 2);
    const size_t hstep = (size_t)HALF * K * 2;
    const size_t hstepB = Epi::PERM2 ? (size_t)32 * K * 2 : hstep;
    const size_t tstep = 2 * hstep;
    const unsigned ldsw = (unsigned)wid * 1024u;
    const int aoff = lds_byte(wr * 64 + fr, fq * 8), boff = lds_byte(wc * 32 + fr, fq * 8);
#define PG8_SA(b, h) (((b) * 2 + (h)) * HTB)
#define PG8_SB(b, h) ((4 + (b) * 2 + (h)) * HTB)
#define PG8_STAGE(bufoff, gbase, voff) do { _Pragma("unroll") for (int _i = 0; _i < 2; ++_i) \
        __builtin_amdgcn_global_load_lds((const unsigned*)((const char*)(gbase) + (voff)[_i]), (PG8_LAS unsigned*)(lds + (bufoff) + ldsw + _i * 8192), 16, 0, 0); } while (0)
#define PG8_LDA(dst, b, h) do { _Pragma("unroll") for (int m = 0; m < 4; ++m) _Pragma("unroll") for (int k = 0; k < 2; ++k) dst[m][k] = *(const PG8_LAS bf16x8*)(lds + PG8_SA(b, h) + aoff + m * 2048 + k * 1024); } while (0)
#define PG8_LDB(dst, b, h) do { _Pragma("unroll") for (int n = 0; n < 2; ++n) _Pragma("unroll") for (int k = 0; k < 2; ++k) dst[n][k] = *(const PG8_LAS bf16x8*)(lds + PG8_SB(b, h) + boff + n * 2048 + k * 1024); } while (0)
#define PG8_MMA(ai, bj, At, Bt) do { __builtin_amdgcn_s_setprio(1); _Pragma("unroll") for (int m = 0; m < 4; ++m) _Pragma("unroll") for (int n = 0; n < 2; ++n) _Pragma("unroll") for (int k = 0; k < 2; ++k) \
        acc[ai][bj][m][n] = __builtin_amdgcn_mfma_f32_16x16x32_bf16(Bt[n][k], At[m][k], acc[ai][bj][m][n], 0, 0, 0); __builtin_amdgcn_s_setprio(0); } while (0)
#define PG8_WAIT_V(n) asm volatile("s_waitcnt vmcnt(" #n ")" ::: "memory")
#define PG8_WAIT_L(n) asm volatile("s_waitcnt lgkmcnt(" #n ")" ::: "memory")
#define PG8_BAR __builtin_amdgcn_s_barrier()
#define PG8_SCHED __builtin_amdgcn_sched_barrier(0)
    Unit cur, nxt; int ui = 0;
    if (!S.next(0, cur)) return;
    f32x4 acc[2][2][4][2];
#pragma unroll
    for (int a = 0; a < 2; ++a)
#pragma unroll
        for (int b = 0; b < 2; ++b)
#pragma unroll
            for (int m = 0; m < 4; ++m)
#pragma unroll
                for (int n = 0; n < 2; ++n) acc[a][b][m][n] = (f32x4){0.f, 0.f, 0.f, 0.f};
    bf16x8 At[4][2], B0[2][2], B1[2][2];
    const char* cA = (const char*)g.A + (size_t)cur.pm * tstep; const char* cB = (const char*)g.Bt + (size_t)cur.pn * tstep;
    S.a_ready(cur);
    if constexpr (SP2) {
        PG8_STAGE(PG8_SB(0, 0), cB, voffB); PG8_STAGE(PG8_SB(0, 1), cB + hstepB, voffB); PG8_STAGE(PG8_SA(0, 0), cA, voffA); PG8_STAGE(PG8_SA(0, 1), cA + hstep, voffA);
        if (wr == 1) PG8_BAR;
        PG8_WAIT_V(2); PG8_BAR;
        PG8_STAGE(PG8_SB(1, 0), cB + kstep, voffB); PG8_STAGE(PG8_SA(1, 0), cA + kstep, voffA); PG8_STAGE(PG8_SB(1, 1), cB + hstepB + kstep, voffB);
        PG8_WAIT_V(6); PG8_BAR;
    } else {
        PG8_STAGE(PG8_SB(0, 0), cB, voffB); PG8_STAGE(PG8_SA(0, 0), cA, voffA); PG8_STAGE(PG8_SB(0, 1), cB + hstepB, voffB); PG8_STAGE(PG8_SA(0, 1), cA + hstep, voffA);
        if (wr == 1) PG8_BAR;
        PG8_WAIT_V(4); PG8_BAR;
        PG8_STAGE(PG8_SB(1, 0), cB + kstep, voffB); PG8_STAGE(PG8_SA(1, 0), cA + kstep, voffA); PG8_STAGE(PG8_SB(1, 1), cB + hstepB + kstep, voffB);
        PG8_WAIT_V(6); PG8_BAR;
    }
    for (;;) {
        const bool has_next = S.next(ui + 1, nxt);
        const char* nA = has_next ? (const char*)g.A + (size_t)nxt.pm * tstep : cA; const char* nB = has_next ? (const char*)g.Bt + (size_t)nxt.pn * tstep : cB;
        for (int t = 0; t < nt; t += 2) {
            const bool last = (t == nt - 2);
            const char* a1 = cA + (size_t)(t + 1) * kstep;
            const char* a2 = last ? nA : cA + (size_t)(t + 2) * kstep; const char* b2 = last ? nB : cB + (size_t)(t + 2) * kstep;
            const char* a3 = a2 + kstep; const char* b3 = b2 + kstep;
            if (last && has_next) S.a_ready(nxt);
            if constexpr (SP2) {
            PG8_LDB(B0, 0, 0); PG8_LDB(B1, 0, 1); PG8_SCHED; PG8_LDA(At, 0, 0); PG8_STAGE(PG8_SA(1, 1), a1 + hstep, voffA);
            PG8_WAIT_V(8); PG8_WAIT_L(0); PG8_BAR; PG8_MMA(0, 0, At, B0); PG8_MMA(0, 1, At, B1); PG8_BAR; PG8_SCHED;
            PG8_LDA(At, 0, 1); PG8_STAGE(PG8_SB(0, 0), b2, voffB); PG8_STAGE(PG8_SB(0, 1), b2 + hstepB, voffB); PG8_STAGE(PG8_SA(0, 0), a2, voffA);
            PG8_WAIT_V(8); PG8_WAIT_L(0); PG8_BAR; PG8_MMA(1, 0, At, B0); PG8_MMA(1, 1, At, B1); PG8_BAR; PG8_SCHED;
            PG8_LDB(B0, 1, 0); PG8_LDB(B1, 1, 1); PG8_SCHED; PG8_LDA(At, 1, 0); PG8_STAGE(PG8_SA(0, 1), a2 + hstep, voffA);
            PG8_WAIT_V(8); PG8_WAIT_L(0); PG8_BAR; PG8_MMA(0, 0, At, B0); PG8_MMA(0, 1, At, B1); PG8_BAR; PG8_SCHED;
            PG8_LDA(At, 1, 1); PG8_STAGE(PG8_SB(1, 0), b3, voffB); PG8_STAGE(PG8_SB(1, 1), b3 + hstepB, voffB); PG8_STAGE(PG8_SA(1, 0), a3, voffA);
            PG8_WAIT_V(8); PG8_WAIT_L(0); PG8_BAR; PG8_MMA(1, 0, At, B0); PG8_MMA(1, 1, At, B1); PG8_BAR; PG8_SCHED;
            } else {
            PG8_LDB(B0, 0, 0); PG8_SCHED; PG8_LDA(At, 0, 0); PG8_STAGE(PG8_SA(1, 1), a1 + hstep, voffA);
            PG8_WAIT_L(8); PG8_BAR; PG8_WAIT_L(0); PG8_MMA(0, 0, At, B0); PG8_BAR; PG8_SCHED;
            PG8_LDB(B1, 0, 1); PG8_STAGE(PG8_SB(0, 0), b2, voffB);
            PG8_BAR; PG8_WAIT_L(0); PG8_MMA(0, 1, At, B1); PG8_BAR;
            PG8_LDA(At, 0, 1); PG8_STAGE(PG8_SA(0, 0), a2, voffA);
            PG8_BAR; PG8_WAIT_L(0); PG8_MMA(1, 0, At, B0); PG8_BAR; PG8_SCHED;
            PG8_STAGE(PG8_SB(0, 1), b2 + hstepB, voffB);
            PG8_WAIT_V(6); PG8_BAR; PG8_MMA(1, 1, At, B1); PG8_BAR;
            PG8_LDB(B0, 1, 0); PG8_SCHED; PG8_LDA(At, 1, 0); PG8_STAGE(PG8_SA(0, 1), a2 + hstep, voffA);
            PG8_WAIT_L(8); PG8_BAR; PG8_WAIT_L(0); PG8_MMA(0, 0, At, B0); PG8_BAR; PG8_SCHED;
            PG8_LDB(B1, 1, 1); PG8_STAGE(PG8_SB(1, 0), b3, voffB);
            PG8_BAR; PG8_WAIT_L(0); PG8_MMA(0, 1, At, B1); PG8_BAR;
            PG8_LDA(At, 1, 1); PG8_STAGE(PG8_SA(1, 0), a3, voffA);
            PG8_BAR; PG8_WAIT_L(0); PG8_MMA(1, 0, At, B0); PG8_BAR; PG8_SCHED;
            PG8_STAGE(PG8_SB(1, 1), b3 + hstepB, voffB);
            PG8_WAIT_V(6); PG8_BAR; PG8_MMA(1, 1, At, B1); PG8_BAR;
            }
        }
        if constexpr (ALIGN_EPI) { if (wr == 0) PG8_BAR; }
        if constexpr (!Epi::AFTER_DRAIN) { E(acc, cur, wr, wc, fr, fq); S.done(cur); }
        if (!has_next) break;
#pragma unroll
        for (int a = 0; a < 2; ++a)
#pragma unroll
            for (int b = 0; b < 2; ++b)
#pragma unroll
                for (int m = 0; m < 4; ++m)
#pragma unroll
                    for (int n = 0; n < 2; ++n) acc[a][b][m][n] = (f32x4){0.f, 0.f, 0.f, 0.f};
        cur = nxt; cA = nA; cB = nB; ++ui;
        if constexpr (ALIGN_EPI) { if (wr == 1) PG8_BAR; }
    }
    PG8_WAIT_V(0);
    if constexpr (!ALIGN_EPI) { if (wr == 0) PG8_BAR; }
    PG8_BAR;
    if constexpr (Epi::AFTER_DRAIN) { E.fused(acc, cur, wr, wc, fr, fq, lds, wid, lane); S.done(cur); }
#undef PG8_SA
#undef PG8_SB
#undef PG8_STAGE
#undef PG8_LDA
#undef PG8_LDB
#undef PG8_MMA
#undef PG8_WAIT_V
#undef PG8_WAIT_L
#undef PG8_BAR
#undef PG8_SCHED
}
}
#define LAS __attribute__((address_space(3)))
typedef unsigned short bf16_t;
typedef short bf16x8 __attribute__((ext_vector_type(8)));
typedef short s16x4 __attribute__((ext_vector_type(4)));
typedef short v4i16_t __attribute__((ext_vector_type(4)));
typedef float f32x4 __attribute__((ext_vector_type(4)));
typedef float f32x16 __attribute__((ext_vector_type(16)));
typedef unsigned u32x4 __attribute__((ext_vector_type(4)));
typedef unsigned u32x2 __attribute__((ext_vector_type(2)));

constexpr int SEQ = 8192, DM = 1024, MTOK = 65536, NIN = 6144, QKVW = 1536;
constexpr size_t WS_WT = 0, WS_WOT = 13631488, WS_RS = 15728640, WS_LSE = 15990784, WS_BAR = 23068672, WS_GMT = 24117248, WS_XB = 33554432, WS_Z = 167772160, WS_G = 301989888,
                 WS_Q = 436207616, WS_K = 637534208, WS_V = 838860800, WS_END = 1040187392;
constexpr int LDS_BYTES = 162944;
constexpr float LOG2E = 1.4426950408889634f;

__device__ __forceinline__ unsigned f2bf(float f) { unsigned u = __builtin_bit_cast(unsigned, f); return (u + 0x7fffu + ((u >> 16) & 1u)) >> 16; }
typedef float f32x2_t __attribute__((ext_vector_type(2))); typedef __bf16 bf16x2_t __attribute__((ext_vector_type(2)));
__device__ __forceinline__ unsigned pk2(float lo, float hi) { f32x2_t v = {lo, hi}; bf16x2_t b = __builtin_convertvector(v, bf16x2_t); return __builtin_bit_cast(unsigned, b); }
__device__ __forceinline__ float bflo(unsigned w) { return __builtin_bit_cast(float, w << 16); }
__device__ __forceinline__ float bfhi(unsigned w) { return __builtin_bit_cast(float, w & 0xffff0000u); }
__device__ __forceinline__ int crow(int r, int hi) { return (r & 3) + 8 * (r >> 2) + 4 * hi; }
__device__ __forceinline__ float wave_sum(float v) {
#pragma unroll
    for (int o = 1; o < 64; o <<= 1) v += __shfl_xor(v, o);
    return v;
}
__device__ __forceinline__ s16x4 trrd(LAS const unsigned char* p) { return __builtin_bit_cast(s16x4, __builtin_amdgcn_ds_read_tr16_b64_v4i16((LAS v4i16_t*)p)); }
__device__ __forceinline__ float silu_f(float v) { return v * __builtin_amdgcn_rcpf(1.f + __builtin_amdgcn_exp2f(-v * LOG2E)); }
#define LDS_WAIT() asm volatile("s_waitcnt lgkmcnt(0)" ::: "memory")
template <int CTRL> __device__ __forceinline__ unsigned dpp_mov(unsigned v) { return (unsigned)__builtin_amdgcn_update_dpp(0, (int)v, CTRL, 0xF, 0xF, true); }
template <int CTRL> __device__ __forceinline__ float dpp_movf(float v) { return __builtin_bit_cast(float, dpp_mov<CTRL>(__builtin_bit_cast(unsigned, v))); }

struct Args { const float *x, *norm_w, *w_in, *qw, *kw, *wf, *w_out; float* out; unsigned char* ws; };

__device__ __forceinline__ void transpose_item(const float* W, int ldw, int ncol0, bf16_t* WT, int row_off, const float* kscale, LAS float* scr, int kb, int nb, int lane) {
    const int k0 = 64 * kb, n0 = 32 * nb;
#pragma unroll 8
    for (int i = 0; i < 32; ++i) { const int kk = 2 * i + (lane >> 5); float v = W[(size_t)(k0 + kk) * ldw + ncol0 + n0 + (lane & 31)]; if (kscale) v *= kscale[k0 + kk]; scr[kk * 33 + (lane & 31)] = v; }
    LDS_WAIT();
    const int c = lane & 7;
#pragma unroll
    for (int j = 0; j < 4; ++j) { const int n = (lane >> 3) + 8 * j; const LAS float* s = scr + (8 * c) * 33 + n;
        u32x4 o; o.x = pk2(s[0 * 33], s[1 * 33]); o.y = pk2(s[2 * 33], s[3 * 33]); o.z = pk2(s[4 * 33], s[5 * 33]); o.w = pk2(s[6 * 33], s[7 * 33]);
        *(u32x4*)(WT + (size_t)(row_off + n0 + n) * 1024 + k0 + 8 * c) = o; }
    LDS_WAIT();
}
__device__ __forceinline__ void gmt_unit(const Args& a, LAS unsigned char* lds, int unit, int tid) {
    bf16_t* GmT = (bf16_t*)(a.ws + WS_GMT);
    LAS float* tab = (LAS float*)lds;
    if (tid < 64) { float sn, cs; sincospif((float)tid * (1.f / 32.f), &sn, &cs); tab[2 * tid] = cs; tab[2 * tid + 1] = sn; }
    __syncthreads();
    const int g = unit >> 2, d = 16 * (unit & 3) + (tid >> 5), c32 = tid & 31;
    float acc[4] = {0.f, 0.f, 0.f, 0.f};
    for (int l = 0; l < 64; ++l) { const float w = a.wf[(size_t)(g * 64 + l) * 64 + d];
#pragma unroll
        for (int e = 0; e < 4; ++e) { const int cc = c32 * 4 + e, c = cc & 63, idx = (l * c) & 63; acc[e] += w * (cc < 64 ? tab[2 * idx] : -tab[2 * idx + 1]); } }
#pragma unroll
    for (int e = 0; e < 4; ++e) GmT[(size_t)(g * 64 + d) * 128 + c32 * 4 + e] = (bf16_t)f2bf(acc[e] * 0.125f);
    __syncthreads();
}
__device__ __forceinline__ void phase0(const Args& a, LAS unsigned char* lds, int tid, int lane, int wave) {
    bf16_t* Wt = (bf16_t*)(a.ws + WS_WT); bf16_t* WoT = (bf16_t*)(a.ws + WS_WOT); bf16_t* xb = (bf16_t*)(a.ws + WS_XB);
    const int G = gridDim.x, bx = blockIdx.x;
    for (int u = bx; u < 32; u += G) gmt_unit(a, lds, u, tid);
    if (bx == G - 1 && wave < 3) {
        for (int hd = wave * 8; hd < wave * 8 + 8; ++hd) {
            float gqm = fabsf(a.qw[hd * 64 + lane]), gkm = fabsf(a.kw[hd * 64 + lane]);
#pragma unroll
            for (int o = 1; o < 64; o <<= 1) { gqm = fmaxf(gqm, __shfl_xor(gqm, o)); gkm = fmaxf(gkm, __shfl_xor(gkm, o)); }
            if (lane == 0) ((float*)(a.ws + WS_RS))[hd] = 8.08f * LOG2E * gqm * gkm;
        }
    }
    LAS float* scr = (LAS float*)(lds + 32768 + wave * 8448);
    const int gw = bx * 8 + wave, NGW = G * 8;
    constexpr int I_IN = 16 * 192, I_OUT = 16 * 32;
    for (int it = gw; it < I_IN + I_OUT; it += NGW) {
        if (it < I_IN) transpose_item(a.w_in, 6144, 0, Wt, 0, a.norm_w, scr, it / 192, it % 192, lane);
        else { const int r = it - I_IN; transpose_item(a.w_out, 1024, 0, WoT, 0, nullptr, scr, r / 32, r % 32, lane); }
    }
    for (int row = gw; row < MTOK; row += 2 * NGW) {
        const int row2 = row + NGW; const bool has2 = row2 < MTOK;
        const f32x4* xr = (const f32x4*)(a.x + (size_t)row * DM) + lane; const f32x4* xr2 = (const f32x4*)(a.x + (size_t)(has2 ? row2 : row) * DM) + lane;
        f32x4 v[4], v2[4]; float s = 0.f, s2 = 0.f;
#pragma unroll
        for (int j = 0; j < 4; ++j) { v[j] = __builtin_nontemporal_load(xr + 64 * j); v2[j] = __builtin_nontemporal_load(xr2 + 64 * j); }
#pragma unroll
        for (int j = 0; j < 4; ++j) { s += (v[j].x * v[j].x + v[j].y * v[j].y) + (v[j].z * v[j].z + v[j].w * v[j].w); s2 += (v2[j].x * v2[j].x + v2[j].y * v2[j].y) + (v2[j].z * v2[j].z + v2[j].w * v2[j].w); }
        s = wave_sum(s); s2 = wave_sum(s2);
        const float r = 1.0f / sqrtf(s * (1.f / DM) + 1e-6f), r2 = 1.0f / sqrtf(s2 * (1.f / DM) + 1e-6f);
        u32x2* o = (u32x2*)(xb + (size_t)row * DM) + lane;
#pragma unroll
        for (int j = 0; j < 4; ++j) { u32x2 w; w.x = pk2(v[j].x * r, v[j].y * r); w.y = pk2(v[j].z * r, v[j].w * r); o[64 * j] = w; }
        if (has2) { u32x2* o2 = (u32x2*)(xb + (size_t)row2 * DM) + lane;
#pragma unroll
            for (int j = 0; j < 4; ++j) { u32x2 w; w.x = pk2(v2[j].x * r2, v2[j].y * r2); w.y = pk2(v2[j].z * r2, v2[j].w * r2); o2[64 * j] = w; } }
    }
}

struct Epi1 {
    static constexpr bool PERM = true, PERM2 = true, AFTER_DRAIN = false;
    bf16_t *Z, *G, *Q, *Kb, *V;
    __device__ __forceinline__ void operator()(const pg8::f32x4 (&acc)[2][2][4][2], const pg8::Unit& u, int wr, int wc, int fr, int fq) const {
        const int pn = u.pn; const int hi8 = (fr >> 3) & 1, fr7 = fr & 7; const int rbase = u.pm * 256 + wr * 64 + fr7;
        const bool qkv = (pn >= 4 && pn < 22);
        const bool act = !qkv && pn >= 2;
        const int ld = pn < 2 ? 512 : 1024;
        bf16_t* base; int dsh = 0; size_t rowstride_tok = 0; int ecol;
        if (qkv) { const int which = (pn - 4) / 6, ct = (pn - 4) % 6; dsh = 2 * (ct >> 1);
            base = Q + (size_t)which * ((WS_K - WS_Q) / 2) + (size_t)(ct * 4 + wc) * SEQ * 64; ecol = 32 * hi8 + 8 * fq; }
        else { const int c0 = pn < 2 ? pn * 256 : (pn < 4 ? (pn - 2) * 256 : 512 + (pn - 22) * 256); base = (pn < 2 ? Z : G) + c0 + wc * 64; ecol = 32 * hi8 + 8 * fq; }
        const int dmask = (1 << dsh) - 1, Lc = SEQ >> dsh;
#pragma unroll
        for (int ai = 0; ai < 2; ++ai)
#pragma unroll
            for (int m = 0; m < 4; ++m) {
                pg8::f32x4 a0 = acc[ai][0][m][0], a1 = acc[ai][0][m][1], b0 = acc[ai][1][m][0], b1 = acc[ai][1][m][1];
                if (act) {
#pragma unroll
                    for (int e = 0; e < 4; ++e) { a0[e] = silu_f(a0[e]); a1[e] = silu_f(a1[e]); b0[e] = silu_f(b0[e]); b1[e] = silu_f(b1[e]); } }
                u32x4 A, B; A.x = pk2(a0[0], a0[1]); A.y = pk2(a0[2], a0[3]); A.z = pk2(a1[0], a1[1]); A.w = pk2(a1[2], a1[3]);
                B.x = pk2(b0[0], b0[1]); B.y = pk2(b0[2], b0[3]); B.z = pk2(b1[0], b1[1]); B.w = pk2(b1[2], b1[3]);
                u32x4 snd, rcv;
#pragma unroll
                for (int e = 0; e < 4; ++e) { snd[e] = hi8 ? A[e] : B[e]; rcv[e] = dpp_mov<0x128>(snd[e]); }
                u32x4 d1, d2;
#pragma unroll
                for (int e = 0; e < 4; ++e) { d1[e] = hi8 ? rcv[e] : A[e]; d2[e] = hi8 ? B[e] : rcv[e]; }
                const int row1 = rbase + ai * 128 + m * 16, row2 = row1 + 8;
                if (qkv) {
                    const int bb = row1 >> 13, t1 = row1 & (SEQ - 1), t2 = row2 & (SEQ - 1);
                    const int p1 = (t1 & dmask) * Lc + (t1 >> dsh), p2 = (t2 & dmask) * Lc + (t2 >> dsh);
                    bf16_t* hb = base + (size_t)bb * 24 * SEQ * 64 + ecol;
                    *(u32x4*)(hb + (size_t)p1 * 64) = d1; *(u32x4*)(hb + (size_t)p2 * 64) = d2;
                } else {
                    *(u32x4*)(base + (size_t)row1 * ld + ecol) = d1; *(u32x4*)(base + (size_t)row2 * ld + ecol) = d2;
                }
            }
    }
};
struct Epi2 {
    static constexpr bool PERM = false, PERM2 = false, AFTER_DRAIN = false;
    const float* x; float* out;
    __device__ __forceinline__ void operator()(const pg8::f32x4 (&acc)[2][2][4][2], const pg8::Unit& u, int wr, int wc, int fr, int fq) const {
        const int row0 = u.pm * 256 + wr * 64 + fr, col0 = u.pn * 256 + wc * 32 + 4 * fq;
#pragma unroll
        for (int ai = 0; ai < 2; ++ai)
#pragma unroll
            for (int m = 0; m < 4; ++m) { const size_t off = (size_t)(row0 + ai * 128 + m * 16) * DM + col0;
#pragma unroll
                for (int bj = 0; bj < 2; ++bj)
#pragma unroll
                    for (int n = 0; n < 2; ++n) { const size_t o2 = off + bj * 128 + n * 16; *(pg8::f32x4*)(out + o2) = *(const pg8::f32x4*)(x + o2) + acc[ai][bj][m][n]; }
                if (m & 1) asm volatile("" ::: "memory"); }
    }
};

constexpr int TP = 192;
constexpr int TTP = 272;
template <int NROWS> __device__ __forceinline__ void load_tile(LAS unsigned char* lds, const bf16_t* src, size_t rstride, int tid) {
    u32x4 v[NROWS / 64];
#pragma unroll
    for (int i = 0; i < NROWS / 64; ++i) { const int ci = tid + 512 * i, row = ci >> 3, ch = ci & 7; v[i] = *(const u32x4*)(src + (size_t)row * rstride + ch * 8); }
#pragma unroll
    for (int i = 0; i < NROWS / 64; ++i) { const int ci = tid + 512 * i, row = ci >> 3, ch = ci & 7; *(LAS u32x4*)(lds + row * TP + ch * 16) = v[i]; }
}
__device__ __forceinline__ void dft1_phase(const Args& a, LAS unsigned char* lds, int tid, int lane, int wave) {
    asm volatile("" : "+v"(tid), "+v"(lane));
    const bf16_t* Z = (const bf16_t*)(a.ws + WS_Z); bf16_t* Y = (bf16_t*)(a.ws + WS_XB);
    const int h = lane >> 5, l31 = lane & 31, kb = wave & 3, nt = wave >> 2;
    bf16x8 af[8];
    { const int ri_row = l31 >> 4, k1 = 16 * kb + (l31 & 15);
#pragma unroll
      for (int ks = 0; ks < 8; ++ks) { unsigned pw[4];
#pragma unroll
        for (int jj = 0; jj < 4; ++jj) { float vv[2];
#pragma unroll
            for (int e = 0; e < 2; ++e) { const int s1 = 16 * ks + 8 * h + 2 * jj + e; float sn, cs; sincospif((float)((s1 * k1) & 127) * (1.f / 64.f), &sn, &cs);
                float val = ri_row == 0 ? cs : sn;
                if (ri_row == 1 && k1 == 0) val = (s1 & 1) ? -1.f : 1.f;
                vv[e] = val * 0.08838834764831845f; }
            pw[jj] = pk2(vv[0], vv[1]); }
        u32x4 t; t.x = pw[0]; t.y = pw[1]; t.z = pw[2]; t.w = pw[3]; af[ks] = __builtin_bit_cast(bf16x8, t); } }
    const int q = (lane & 15) >> 2, p = lane & 3, blk = (lane >> 4) & 1;
    LAS const unsigned char* rb = lds + (8 * h + q) * TP + 32 * blk + 8 * p + nt * 64;
    u32x4 pf[2][2];
#define DFT1_ISSUE(zz, uu) do { const int dc_ = (uu) & 7, s2_ = ((uu) >> 3) & 63, b_ = (uu) >> 9; const bf16_t* src_ = Z + ((size_t)b_ * SEQ + s2_) * 512 + dc_ * 64; \
        _Pragma("unroll") for (int i_ = 0; i_ < 2; ++i_) { const int ci_ = tid + 512 * i_; pf[zz][i_] = *(const u32x4*)(src_ + (size_t)(ci_ >> 3) * (64 * 512) + (ci_ & 7) * 8); } } while (0)
    const int G2 = 2 * (int)gridDim.x;
    { const int u0 = blockIdx.x; if (u0 < 4096) DFT1_ISSUE(0, u0); if (u0 + (int)gridDim.x < 4096) DFT1_ISSUE(1, u0 + (int)gridDim.x); }
    for (int u = blockIdx.x; u < 4096; u += G2) {
        const bool has1 = u + (int)gridDim.x < 4096;
#pragma unroll
        for (int z = 0; z < 2; ++z)
#pragma unroll
            for (int i = 0; i < 2; ++i) { const int ci = tid + 512 * i; *(LAS u32x4*)(lds + z * 24576 + (ci >> 3) * TP + (ci & 7) * 16) = pf[z][i]; }
        __syncthreads();
        { const int un = u + G2; if (un < 4096) DFT1_ISSUE(0, un); if (un + (int)gridDim.x < 4096) DFT1_ISSUE(1, un + (int)gridDim.x); }
        f32x16 acc[2]; acc[0] = f32x16{}; acc[1] = f32x16{};
#pragma unroll
        for (int ks = 0; ks < 8; ++ks)
#pragma unroll
            for (int z = 0; z < 2; ++z) { const s16x4 lo = trrd(rb + z * 24576 + ks * 16 * TP), hi = trrd(rb + z * 24576 + ks * 16 * TP + 4 * TP);
                const bf16x8 bfr = __builtin_shufflevector(lo, hi, 0, 1, 2, 3, 4, 5, 6, 7);
                acc[z] = __builtin_amdgcn_mfma_f32_32x32x16_bf16(af[ks], bfr, acc[z], 0, 0, 0); }
#pragma unroll
        for (int z = 0; z < 2; ++z) { const int uz = u + z * (int)gridDim.x, s2 = (uz >> 3) & 63;
            LAS bf16_t* yt = (LAS bf16_t*)(lds + 49152 + z * 16640);
#pragma unroll
            for (int i = 0; i < 8; ++i) { const int k1 = 16 * kb + crow(i, h); const float re = acc[z][i], im = acc[z][i + 8]; const int col = 32 * nt + l31;
                if (k1 != 0) { const float fr = (float)(s2 * k1) * (1.f / 8192.f); const float sn = __builtin_amdgcn_sinf(fr), cs = __builtin_amdgcn_cosf(fr);
                    yt[(2 * k1) * 64 + col] = (bf16_t)f2bf(cs * re - sn * im); yt[(2 * k1 + 1) * 64 + col] = (bf16_t)f2bf(sn * re + cs * im); }
                else { const float fr = (float)s2 * (1.f / 128.f); const float sn = __builtin_amdgcn_sinf(fr), cs = __builtin_amdgcn_cosf(fr);
                    yt[col] = (bf16_t)f2bf(re); yt[64 + col] = (bf16_t)0; yt[128 * 64 + col] = (bf16_t)f2bf(cs * im); yt[129 * 64 + col] = (bf16_t)f2bf(sn * im); } } }
        __syncthreads();
#pragma unroll
        for (int z = 0; z < 2; ++z) { if (z == 1 && !has1) break;
            const int uz = u + z * (int)gridDim.x, dc = uz & 7, s2 = (uz >> 3) & 63, b = uz >> 9;
            LAS const bf16_t* yt = (LAS const bf16_t*)(lds + 49152 + z * 16640);
#pragma unroll
            for (int zz = 0; zz < 3; ++zz) { const int ci = tid + 512 * zz; if (ci < 130 * 8) { const int row = ci >> 3, ch = ci & 7, k1 = row < 128 ? (row >> 1) : 64, ri = row < 128 ? (row & 1) : (row - 128);
                *(u32x4*)(Y + ((size_t)((b * 128 + k1) * 2 + ri) * 64 + s2) * 512 + dc * 64 + ch * 8) = *(LAS const u32x4*)(yt + row * 64 + ch * 8); } } }
        __syncthreads();
    }
}
__device__ __forceinline__ void dft2_phase(const Args& a, LAS unsigned char* lds, int tid, int lane, int wave) {
    asm volatile("" : "+v"(tid), "+v"(lane));
    const bf16_t* Y = (const bf16_t*)(a.ws + WS_XB); const bf16_t* Gb = (const bf16_t*)(a.ws + WS_G); bf16_t* ym = (bf16_t*)(a.ws + WS_Z); const bf16_t* GmT = (const bf16_t*)(a.ws + WS_GMT);
    const int h = lane >> 5, l31 = lane & 31, ksub = wave >> 2, mh = (wave >> 1) & 1, nt = wave & 1;
    bf16x8 af[2][8];
#pragma unroll
    for (int z = 0; z < 2; ++z) { const int m = 64 * mh + 32 * z + l31, k2 = m & 63, imrow = m >> 6;
#pragma unroll
      for (int ks = 0; ks < 8; ++ks) { unsigned pw[4];
#pragma unroll
        for (int jj = 0; jj < 4; ++jj) { float vv[2];
#pragma unroll
            for (int e = 0; e < 2; ++e) { const int kk = 16 * ks + 8 * h + 2 * jj + e, ri = kk >> 6, s2 = kk & 63; float sn, cs; sincospif((float)((s2 * k2) & 63) * (1.f / 32.f), &sn, &cs);
                vv[e] = (imrow == 0 ? (ri == 0 ? cs : -sn) : (ri == 0 ? sn : cs)) * 0.125f; }
            pw[jj] = pk2(vv[0], vv[1]); }
        u32x4 t; t.x = pw[0]; t.y = pw[1]; t.z = pw[2]; t.w = pw[3]; af[z][ks] = __builtin_bit_cast(bf16x8, t); } }
    const int q = (lane & 15) >> 2, p = lane & 3, blk = (lane >> 4) & 1;
    LAS const unsigned char* rb = lds + (ksub * 128 + 8 * h + q) * TP + 32 * blk + 8 * p + nt * 64;
    LAS unsigned char* tt = lds + 49152;
    LAS float* ot = (LAS float*)(lds + 83968);
    const int mt2 = wave >> 1, nt2 = wave & 1;
    u32x4 ld[4];
#define DFT2_ISSUE(uu) do { const int dc_ = (uu) & 7, k1p_ = ((uu) >> 3) & 63, b_ = (uu) >> 9; \
        if (k1p_ == 0) { _Pragma("unroll") for (int z_ = 0; z_ < 2; ++z_) { const int ci_ = tid + 512 * z_; const size_t o_ = (size_t)(ci_ >> 3) * 512 + dc_ * 64 + (ci_ & 7) * 8; \
                ld[z_] = __builtin_nontemporal_load((const u32x4*)(Y + ((size_t)(b_ * 128) * 128) * 512 + o_)); ld[2 + z_] = __builtin_nontemporal_load((const u32x4*)(Y + ((size_t)(b_ * 128 + 64) * 128) * 512 + o_)); } } \
        else { const bf16_t* src_ = Y + ((size_t)(b_ * 128 + k1p_) * 128 + (tid >> 3)) * 512 + dc_ * 64 + (tid & 7) * 8; ld[0] = __builtin_nontemporal_load((const u32x4*)src_); ld[1] = __builtin_nontemporal_load((const u32x4*)(src_ + (size_t)64 * 512)); } } while (0)
    if ((int)blockIdx.x < 4096) DFT2_ISSUE((int)blockIdx.x);
    const bool gf_fixed = (gridDim.x & 7u) == 0u;
    bf16x8 gf[8];
#pragma unroll
    for (int ks = 0; ks < 8; ++ks) gf[ks] = *(const bf16x8*)(GmT + (size_t)((blockIdx.x & 7) * 64 + 32 * nt2 + l31) * 128 + 16 * ks + 8 * h);
    for (int u = blockIdx.x; u < 4096; u += gridDim.x) {
        const int dc = u & 7, k1p = (u >> 3) & 63, b = u >> 9;
        if (!gf_fixed) {
#pragma unroll
            for (int ks = 0; ks < 8; ++ks) gf[ks] = *(const bf16x8*)(GmT + (size_t)(dc * 64 + 32 * nt2 + l31) * 128 + 16 * ks + 8 * h); }
        const int k1a = k1p, k1b = k1p == 0 ? 64 : 128 - k1p;
        const int tr_e = tid >> 2, qt_e = tid & 3; const size_t tok_e = (size_t)b * SEQ + ((tr_e >> 6) ? k1b : k1a) + 128 * (tr_e & 63);
        const u32x4 g0 = __builtin_nontemporal_load((const u32x4*)(Gb + tok_e * 1024 + dc * 64 + qt_e * 16)), g1 = __builtin_nontemporal_load((const u32x4*)(Gb + tok_e * 1024 + dc * 64 + qt_e * 16 + 8));
        if (k1p == 0) {
#pragma unroll
            for (int z = 0; z < 2; ++z) { const int ci = tid + 512 * z, row = ci >> 3, ch = ci & 7; *(LAS u32x4*)(lds + row * TP + ch * 16) = ld[z]; *(LAS u32x4*)(lds + (128 + row) * TP + ch * 16) = ld[2 + z]; }
        } else {
            const int s2 = tid >> 3, ch = tid & 7;
            const u32x4 yr = ld[0], yi = ld[1];
            const float fr = (float)s2 * (1.f / 64.f); const float sn = __builtin_amdgcn_sinf(fr), cs = __builtin_amdgcn_cosf(fr);
            u32x4 zr, zi;
#pragma unroll
            for (int e = 0; e < 4; ++e) { const float rl = bflo(yr[e]), rh = bfhi(yr[e]), il = bflo(yi[e]), ih = bfhi(yi[e]);
                zr[e] = pk2(rl * cs + il * sn, rh * cs + ih * sn); zi[e] = pk2(rl * sn - il * cs, rh * sn - ih * cs); }
            *(LAS u32x4*)(lds + s2 * TP + ch * 16) = yr; *(LAS u32x4*)(lds + (64 + s2) * TP + ch * 16) = yi;
            *(LAS u32x4*)(lds + (128 + s2) * TP + ch * 16) = zr; *(LAS u32x4*)(lds + (192 + s2) * TP + ch * 16) = zi;
        }
        __syncthreads();
        if (u + (int)gridDim.x < 4096) DFT2_ISSUE(u + (int)gridDim.x);
        f32x16 acc[2]; acc[0] = f32x16{}; acc[1] = f32x16{};
#pragma unroll
        for (int ks = 0; ks < 8; ++ks) { const s16x4 lo = trrd(rb + ks * 16 * TP), hi = trrd(rb + ks * 16 * TP + 4 * TP);
            const bf16x8 bfr = __builtin_shufflevector(lo, hi, 0, 1, 2, 3, 4, 5, 6, 7);
            acc[0] = __builtin_amdgcn_mfma_f32_32x32x16_bf16(af[0][ks], bfr, acc[0], 0, 0, 0);
            acc[1] = __builtin_amdgcn_mfma_f32_32x32x16_bf16(af[1][ks], bfr, acc[1], 0, 0, 0); }
#pragma unroll
        for (int z = 0; z < 2; ++z)
#pragma unroll
            for (int i = 0; i < 16; ++i) *(LAS bf16_t*)(tt + (ksub * 64 + 32 * z + crow(i, h)) * TTP + (mh * 64 + 32 * nt + l31) * 2) = (bf16_t)f2bf(acc[z][i]);
        __syncthreads();
        f32x16 o2 = f32x16{}, o2b = f32x16{};
#pragma unroll
        for (int ks = 0; ks < 8; ks += 2) { const bf16x8 tf = *(LAS const bf16x8*)(tt + (32 * mt2 + l31) * TTP + (16 * ks + 8 * h) * 2), tf2 = *(LAS const bf16x8*)(tt + (32 * mt2 + l31) * TTP + (16 * (ks + 1) + 8 * h) * 2);
            o2 = __builtin_amdgcn_mfma_f32_32x32x16_bf16(tf, gf[ks], o2, 0, 0, 0); o2b = __builtin_amdgcn_mfma_f32_32x32x16_bf16(tf2, gf[ks + 1], o2b, 0, 0, 0); }
#pragma unroll
        for (int i = 0; i < 16; ++i) o2[i] += o2b[i];
#pragma unroll
        for (int i = 0; i < 16; ++i) ot[(32 * mt2 + crow(i, h)) * 64 + 32 * nt2 + l31] = o2[i];
        __syncthreads();
        {
            const int tr = tid >> 2, qt = tid & 3, ks2 = tr >> 6, k2 = tr & 63;
            const size_t tok = (size_t)b * SEQ + (ks2 ? k1b : k1a) + 128 * k2;
            const LAS f32x4* op = (const LAS f32x4*)(ot + tr * 64 + qt * 16);
            const f32x4 v0 = op[0], v1 = op[1], v2 = op[2], v3 = op[3];
            u32x4 w0, w1;
            w0.x = pk2(v0.x * bflo(g0.x), v0.y * bfhi(g0.x)); w0.y = pk2(v0.z * bflo(g0.y), v0.w * bfhi(g0.y)); w0.z = pk2(v1.x * bflo(g0.z), v1.y * bfhi(g0.z)); w0.w = pk2(v1.z * bflo(g0.w), v1.w * bfhi(g0.w));
            w1.x = pk2(v2.x * bflo(g1.x), v2.y * bfhi(g1.x)); w1.y = pk2(v2.z * bflo(g1.y), v2.w * bfhi(g1.y)); w1.z = pk2(v3.x * bflo(g1.z), v3.y * bfhi(g1.z)); w1.w = pk2(v3.z * bflo(g1.w), v3.w * bfhi(g1.w));
            *(u32x4*)(ym + tok * 1024 + dc * 64 + qt * 16) = w0; *(u32x4*)(ym + tok * 1024 + dc * 64 + qt * 16 + 8) = w1;
        }
        __syncthreads();
    }
}

constexpr int KP = 144, VP = 192, KROWS = 384, LDS_VOFF = KROWS * KP;
struct AUnit { int b, hd, dil, L, r, i0; };
__device__ __forceinline__ AUnit attn_decode(int u, int hd0, int nh) {
    AUnit w; const int blk32 = u & 31; w.hd = hd0 + (u >> 5) % nh; w.b = u / (32 * nh);
    const int dsh = 2 * (w.hd >> 3), nbr = 32 >> dsh; w.dil = 1 << dsh; w.L = SEQ >> dsh; w.r = blk32 / nbr; w.i0 = (blk32 % nbr) * 256; return w;
}
__device__ __forceinline__ void attn_issue(const AUnit& w, const bf16_t* Qb, const bf16_t* Kb, const bf16_t* Vb, int tid, int wave, int lane, u32x4 (&kv)[6], u32x4 (&vv)[6]) {
    const int ch = tid & 7;
#pragma unroll
    for (int i = 0; i < 6; ++i) { const int row = (tid + 512 * i) >> 3; int pk = w.i0 - 64 + row; pk = pk < 0 ? 0 : (pk >= w.L ? w.L - 1 : pk);
        const size_t off = ((size_t)(w.b * 24 + w.hd) * SEQ + (size_t)(w.r * w.L + pk)) * 64 + ch * 8; kv[i] = *(const u32x4*)(Kb + off); vv[i] = *(const u32x4*)(Vb + off); }
}
__device__ __forceinline__ float attn_tile_exp(f32x16& st, int j, float tlf, float bsl, float rlo, float rhi) {
    float sum = 0.f;
#pragma unroll
    for (int i = 0; i < 16; ++i) { const float tmp = (float)(32 * j - 64 + (i & 3) + 8 * (i >> 2)) + tlf;
        float arg = __builtin_fmaf(-bsl, __builtin_fabsf(tmp), st[i]);
        arg = (tmp >= rlo && tmp <= rhi) ? arg : -1.0e30f;
        const float pe = __builtin_amdgcn_exp2f(arg); st[i] = pe; sum += pe; }
    return sum;
}
template <bool FUSED> __device__ __forceinline__ void attn_phase(const Args& a, LAS unsigned char* lds, int tid, int lane, int wave) {
    constexpr int HD0 = FUSED ? 0 : 8, NH = FUSED ? 8 : 16, NU = 8 * NH * 32;
    asm volatile("" : "+v"(tid), "+v"(lane));
    bf16_t* Qb = (bf16_t*)(a.ws + WS_Q); const bf16_t* Kb = (const bf16_t*)(a.ws + WS_K); const bf16_t* Vb = (const bf16_t*)(a.ws + WS_V); float* LSE = (float*)(a.ws + WS_LSE);
    const int h = lane >> 5, l31 = lane & 31;
    const int q = (lane & 15) >> 2, p = lane & 3, blk = (lane >> 4) & 1;
    int u = blockIdx.x;
    u32x4 kv[6], vv[6], qv[4];
#define ATTN_QLOAD(W) do { const bf16_t* qr_ = Qb + ((size_t)((W).b * 24 + (W).hd) * SEQ + (size_t)((W).r * (W).L + (W).i0 + 32 * wave + l31)) * 64; \
        _Pragma("unroll") for (int ks_ = 0; ks_ < 4; ++ks_) qv[ks_] = *(const u32x4*)(qr_ + 16 * ks_ + 8 * h); } while (0)
    if (u < NU) { const AUnit w0 = attn_decode(u, HD0, NH); attn_issue(w0, Qb, Kb, Vb, tid, wave, lane, kv, vv); ATTN_QLOAD(w0); }
    while (u < NU) {
        const AUnit w = attn_decode(u, HD0, NH);
        const int hd = w.hd, slot = hd & 7, L = w.L, i0 = w.i0;
        const int iq = i0 + 32 * wave + l31; const size_t tq = (size_t)w.b * SEQ + (size_t)iq * w.dil + w.r;
        bf16_t* qrow = Qb + ((size_t)(w.b * 24 + hd) * SEQ + (size_t)(w.r * L + iq)) * 64;
        {
            const int ch = tid & 7;
            const f32x4 g0 = *(const f32x4*)(a.kw + hd * 64 + ch * 8), g1 = *(const f32x4*)(a.kw + hd * 64 + ch * 8 + 4);
#pragma unroll
            for (int i = 0; i < 6; ++i) { const int row = (tid + 512 * i) >> 3;
                const float e0 = bflo(kv[i].x), e1 = bfhi(kv[i].x), e2 = bflo(kv[i].y), e3 = bfhi(kv[i].y), e4 = bflo(kv[i].z), e5 = bfhi(kv[i].z), e6 = bflo(kv[i].w), e7 = bfhi(kv[i].w);
                float ss = (e0 * e0 + e1 * e1) + (e2 * e2 + e3 * e3) + (e4 * e4 + e5 * e5) + (e6 * e6 + e7 * e7);
                ss += dpp_movf<0xB1>(ss); ss += dpp_movf<0x4E>(ss); ss += dpp_movf<0x141>(ss);
                const float rk = __builtin_amdgcn_rsqf(ss * (1.f / 64.f) + 1e-6f);
                u32x4 wv; wv.x = pk2(e0 * rk * g0.x, e1 * rk * g0.y); wv.y = pk2(e2 * rk * g0.z, e3 * rk * g0.w); wv.z = pk2(e4 * rk * g1.x, e5 * rk * g1.y); wv.w = pk2(e6 * rk * g1.z, e7 * rk * g1.w);
                *(LAS u32x4*)(lds + row * KP + ch * 16) = wv;
                *(LAS u32x4*)(lds + LDS_VOFF + row * VP + ch * 16) = vv[i];
                if (i & 1) __builtin_amdgcn_sched_barrier(0); }
        }
        bf16x8 qf[4];
        {
            float ss = 0.f;
#pragma unroll
            for (int ks = 0; ks < 4; ++ks)
#pragma unroll
                for (int e = 0; e < 4; ++e) { const float lo = bflo(qv[ks][e]), hi = bfhi(qv[ks][e]); ss += lo * lo + hi * hi; }
            ss += __shfl_xor(ss, 32);
            const float rq = 0.125f * LOG2E * __builtin_amdgcn_rsqf(ss * (1.f / 64.f) + 1e-6f);
#pragma unroll
            for (int ks = 0; ks < 4; ++ks) { const f32x4 g0 = *(const f32x4*)(a.qw + hd * 64 + 16 * ks + 8 * h), g1 = *(const f32x4*)(a.qw + hd * 64 + 16 * ks + 8 * h + 4); u32x4 wv;
                wv.x = pk2(bflo(qv[ks].x) * rq * g0.x, bfhi(qv[ks].x) * rq * g0.y); wv.y = pk2(bflo(qv[ks].y) * rq * g0.z, bfhi(qv[ks].y) * rq * g0.w);
                wv.z = pk2(bflo(qv[ks].z) * rq * g1.x, bfhi(qv[ks].z) * rq * g1.y); wv.w = pk2(bflo(qv[ks].w) * rq * g1.z, bfhi(qv[ks].w) * rq * g1.w);
                qf[ks] = __builtin_bit_cast(bf16x8, wv); }
        }
        const float mb = ((const float*)(a.ws + WS_RS))[hd];
        __syncthreads();
        const int un = u + gridDim.x;
        if (un < NU) { const AUnit wn = attn_decode(un, HD0, NH); attn_issue(wn, Qb, Kb, Vb, tid, wave, lane, kv, vv); }
        const float bsl = __builtin_amdgcn_exp2f(-(float)(slot + 1)) * (float)w.dil * LOG2E;
        int tl = 4 * h - l31; asm volatile("" : "+v"(tl));
        const float tlf = (float)tl;
        const int lo_i = -iq > -64 ? -iq : -64, hi_i = (L - 1 - iq) < 64 ? (L - 1 - iq) : 64;
        const float rlo = (float)lo_i, rhi = (float)hi_i;
        const int wq0 = i0 + 32 * wave;
        const bool edge = (wq0 < 64) || (wq0 + 32 > L - 64);
        float sum = 0.f;
        f32x16 o[2]; o[0] = f32x16{}; o[1] = f32x16{};
#pragma unroll
        for (int j = 0; j < 5; ++j) {
            f32x16 st;
#pragma unroll
            for (int i = 0; i < 16; ++i) st[i] = -mb;
            LAS const unsigned char* kp = lds + (32 * wave + 32 * j + l31) * KP + 16 * h;
#pragma unroll
            for (int ks = 0; ks < 4; ++ks) { const bf16x8 kf = *(LAS const bf16x8*)(kp + 32 * ks); st = __builtin_amdgcn_mfma_f32_32x32x16_bf16(kf, qf[ks], st, 0, 0, 0); }
            sum += attn_tile_exp(st, j, tlf, bsl, rlo, rhi);
#pragma unroll
            for (int s2 = 0; s2 < 2; ++s2) { u32x4 pw; pw.x = pk2(st[8 * s2 + 0], st[8 * s2 + 1]); pw.y = pk2(st[8 * s2 + 2], st[8 * s2 + 3]); pw.z = pk2(st[8 * s2 + 4], st[8 * s2 + 5]); pw.w = pk2(st[8 * s2 + 6], st[8 * s2 + 7]);
                const bf16x8 pf = __builtin_bit_cast(bf16x8, pw);
                LAS const unsigned char* vp = lds + LDS_VOFF + (32 * wave + 32 * j + 16 * s2 + 4 * h + q) * VP + 32 * blk + 8 * p;
#pragma unroll
                for (int dt = 0; dt < 2; ++dt) { const s16x4 lo = trrd(vp + dt * 64), hi = trrd(vp + 8 * VP + dt * 64);
                    const bf16x8 vf = __builtin_shufflevector(lo, hi, 0, 1, 2, 3, 4, 5, 6, 7);
                    o[dt] = __builtin_amdgcn_mfma_f32_32x32x16_bf16(vf, pf, o[dt], 0, 0, 0); } }
            __builtin_amdgcn_sched_barrier(0);
        }
        sum += __shfl_xor(sum, 32);
        if (un < NU) { const AUnit wq = attn_decode(un, HD0, NH); ATTN_QLOAD(wq); }
        const float inv = __builtin_amdgcn_rcpf(sum);
        {
            u32x4 fo1[4], fo2[4], fg[4]; float fl1[4], fl2[4];
            if constexpr (FUSED) {
                const bf16_t* Gb = (const bf16_t*)(a.ws + WS_G);
#pragma unroll
                for (int it = 0; it < 4; ++it) { const int r = 8 * it + (lane >> 3), c16 = lane & 7, t = i0 + 32 * wave + r; const size_t tokg = (size_t)w.b * SEQ + t;
                    fl1[it] = LSE[tokg * 24 + 8 + slot]; fl2[it] = LSE[tokg * 24 + 16 + slot];
                    fo1[it] = __builtin_nontemporal_load((const u32x4*)(Qb + ((size_t)(w.b * 24 + 8 + slot) * SEQ + (t & 3) * 2048 + (t >> 2)) * 64 + c16 * 8));
                    fo2[it] = __builtin_nontemporal_load((const u32x4*)(Qb + ((size_t)(w.b * 24 + 16 + slot) * SEQ + (t & 15) * 512 + (t >> 4)) * 64 + c16 * 8));
                    fg[it] = __builtin_nontemporal_load((const u32x4*)(Gb + tokg * 1024 + 512 + slot * 64 + c16 * 8)); }
            }
            LAS unsigned char* ost = lds + 129024 + wave * 4096;
#pragma unroll
            for (int dt = 0; dt < 2; ++dt)
#pragma unroll
                for (int ig = 0; ig < 4; ++ig) { u32x2 wv; wv.x = pk2(o[dt][4 * ig] * inv, o[dt][4 * ig + 1] * inv); wv.y = pk2(o[dt][4 * ig + 2] * inv, o[dt][4 * ig + 3] * inv);
                    const int p8 = 8 * dt + 2 * ig + h; *(LAS u32x2*)(ost + l31 * 128 + 8 * (p8 ^ (l31 & 15))) = wv; }
            if constexpr (FUSED) { if (h == 0) ((LAS float*)(lds + 161808))[wave * 32 + l31] = mb + __builtin_amdgcn_logf(sum); }
            asm volatile("s_waitcnt lgkmcnt(0)" ::: "memory");
            if constexpr (!FUSED) {
                bf16_t* obase = qrow - l31 * 64;
#pragma unroll
                for (int it = 0; it < 4; ++it) { const int r = 8 * it + (lane >> 3), c16 = lane & 7;
                    u32x4 v = *(LAS const u32x4*)(ost + r * 128 + 16 * (c16 ^ ((r & 15) >> 1)));
                    if (r & 1) { const unsigned t0 = v.x, t1 = v.y; v.x = v.z; v.y = v.w; v.z = t0; v.w = t1; }
                    *(u32x4*)(obase + (size_t)r * 64 + c16 * 8) = v; asm volatile("" ::: "memory"); }
            } else {
                bf16_t* ym = (bf16_t*)(a.ws + WS_Z);
#pragma unroll
                for (int it = 0; it < 4; ++it) { const int r = 8 * it + (lane >> 3), c16 = lane & 7;
                    u32x4 v = *(LAS const u32x4*)(ost + r * 128 + 16 * (c16 ^ ((r & 15) >> 1)));
                    if (r & 1) { const unsigned t0 = v.x, t1 = v.y; v.x = v.z; v.y = v.w; v.z = t0; v.w = t1; }
                    const int t = i0 + 32 * wave + r; const size_t tokg = (size_t)w.b * SEQ + t;
                    const float l0 = ((LAS const float*)(lds + 161808))[wave * 32 + r], l1 = fl1[it], l2 = fl2[it];
                    const float mxl = fmaxf(l0, fmaxf(l1, l2));
                    float w0 = __builtin_amdgcn_exp2f(l0 - mxl), w1 = __builtin_amdgcn_exp2f(l1 - mxl), w2 = __builtin_amdgcn_exp2f(l2 - mxl);
                    const float iw = 1.0f / (w0 + w1 + w2); w0 *= iw; w1 *= iw; w2 *= iw;
                    u32x4 ov;
#pragma unroll
                    for (int e = 0; e < 4; ++e) { const float lo = (bflo(v[e]) * w0 + bflo(fo1[it][e]) * w1 + bflo(fo2[it][e]) * w2) * bflo(fg[it][e]); const float hi = (bfhi(v[e]) * w0 + bfhi(fo1[it][e]) * w1 + bfhi(fo2[it][e]) * w2) * bfhi(fg[it][e]); ov[e] = pk2(lo, hi); }
                    *(u32x4*)(ym + tokg * 1024 + 512 + slot * 64 + c16 * 8) = ov; }
            }
        }
        if constexpr (!FUSED) { if (h == 0) LSE[tq * 24 + hd] = mb + __builtin_amdgcn_logf(sum); }
        __syncthreads();
        u = un;
    }
}
__device__ __forceinline__ void merge_phase(const Args& a, int lane, int wave) {
    asm volatile("" : "+v"(lane));
    const bf16_t* Ob = (const bf16_t*)(a.ws + WS_Q); const bf16_t* Gb = (const bf16_t*)(a.ws + WS_G); const float* LSE = (const float*)(a.ws + WS_LSE); bf16_t* ym = (bf16_t*)(a.ws + WS_Z);
    const int gw = blockIdx.x * 8 + wave, NGW = gridDim.x * 8, slot = lane >> 3;
    for (int tok0 = gw; tok0 < MTOK; tok0 += 2 * NGW) {
        u32x4 o0[2], o1[2], o2[2], g[2]; float l0[2], l1[2], l2[2];
#pragma unroll
        for (int z = 0; z < 2; ++z) { int tok = tok0 + z * NGW; tok = tok < MTOK ? tok : tok0;
            l0[z] = LSE[(size_t)tok * 24 + slot]; l1[z] = LSE[(size_t)tok * 24 + 8 + slot]; l2[z] = LSE[(size_t)tok * 24 + 16 + slot];
            const int b = tok >> 13, t = tok & (SEQ - 1), part = lane & 7;
            o0[z] = __builtin_nontemporal_load((const u32x4*)(Ob + ((size_t)(b * 24 + slot) * SEQ + t) * 64 + part * 8));
            o1[z] = __builtin_nontemporal_load((const u32x4*)(Ob + ((size_t)(b * 24 + 8 + slot) * SEQ + (t & 3) * 2048 + (t >> 2)) * 64 + part * 8));
            o2[z] = __builtin_nontemporal_load((const u32x4*)(Ob + ((size_t)(b * 24 + 16 + slot) * SEQ + (t & 15) * 512 + (t >> 4)) * 64 + part * 8));
            g[z] = __builtin_nontemporal_load((const u32x4*)(Gb + (size_t)tok * 1024 + 512 + lane * 8)); }
#pragma unroll
        for (int z = 0; z < 2; ++z) { const int tok = tok0 + z * NGW; if (tok >= MTOK) break;
            const float mx = fmaxf(l0[z], fmaxf(l1[z], l2[z]));
            float w0 = __builtin_amdgcn_exp2f(l0[z] - mx), w1 = __builtin_amdgcn_exp2f(l1[z] - mx), w2 = __builtin_amdgcn_exp2f(l2[z] - mx);
            const float inv = 1.0f / (w0 + w1 + w2); w0 *= inv; w1 *= inv; w2 *= inv;
            u32x4 w;
#pragma unroll
            for (int e = 0; e < 4; ++e) { const float lo = (bflo(o0[z][e]) * w0 + bflo(o1[z][e]) * w1 + bflo(o2[z][e]) * w2) * bflo(g[z][e]); const float hi = (bfhi(o0[z][e]) * w0 + bfhi(o1[z][e]) * w1 + bfhi(o2[z][e]) * w2) * bfhi(g[z][e]); w[e] = pk2(lo, hi); }
            *(u32x4*)(ym + (size_t)tok * 1024 + 512 + lane * 8) = w; }
    }
}

#define XB_TMO      128
#define XB_XCNT(j)  (256  + 64 * (j))
#define XB_XSUB(j)  (1280 + 64 * (j))
#define XB_XGEN(j)  (2304 + 64 * (j))
#define XB_TOP      3328
#define XB_TOPGEN   3392
#define XCD_BAR_WORDS 3456
#define XB_SPIN_CAP (1u << 18)

__device__ __forceinline__ unsigned xb_ld(unsigned* p)              { return __hip_atomic_load(p, __ATOMIC_RELAXED, __HIP_MEMORY_SCOPE_AGENT); }
__device__ __forceinline__ unsigned xb_add(unsigned* p, unsigned v) { return __hip_atomic_fetch_add(p, v, __ATOMIC_RELAXED, __HIP_MEMORY_SCOPE_AGENT); }
__device__ __forceinline__ unsigned xb_xcc_id() { return (unsigned)__builtin_amdgcn_s_getreg((3 << 11) | 20) & 0xFu; }
#define XB_SPIN(cond, bar) do { unsigned _sp = 0; while (cond) { __builtin_amdgcn_s_sleep(1); \
    if ((++_sp & 255u) == 0u) { if (xb_ld(&(bar)[XB_TMO])) break; if (_sp > XB_SPIN_CAP) { atomicAdd(&(bar)[XB_TMO], 1u); break; } } } } while (0)

struct XcdBarrier {
    unsigned* bar; unsigned x;
    volatile LAS unsigned* st;
};

__device__ __forceinline__ XcdBarrier xcd_barrier_post(unsigned* bar, volatile LAS unsigned* st) {
    XcdBarrier b; b.bar = bar; b.x = xb_xcc_id(); b.st = st;
    if (threadIdx.x == 0) (void)xb_add(&bar[XB_XCNT(b.x)], 1u);
    return b;
}
__device__ __forceinline__ void xcd_barrier_complete(unsigned* bar, unsigned x, unsigned& nloc, unsigned& nx) {
    const unsigned G = gridDim.x * gridDim.y * gridDim.z;
    unsigned sum, cnt, mine, sp = 0u;
    for (;;) {
        sum = 0u; cnt = 0u; mine = 0u;
#pragma unroll
        for (unsigned j = 0; j < 16; ++j) { const unsigned c = xb_ld(&bar[XB_XCNT(j)]); sum += c; cnt += (c > 0u) ? 1u : 0u; mine = (j == x) ? c : mine; }
        if (sum == G) break;
        __builtin_amdgcn_s_sleep(1);
        if ((++sp & 255u) == 0u) { if (xb_ld(&bar[XB_TMO])) break; if (sp > XB_SPIN_CAP) { atomicAdd(&bar[XB_TMO], 1u); break; } }
    }
    nloc = mine > 0u ? mine : 1u; nx = cnt > 0u ? cnt : 1u;
}

__device__ __forceinline__ void xcd_barrier(const XcdBarrier& b) {
    asm volatile("s_waitcnt vmcnt(0)" ::: "memory");
    __syncthreads();
    if (threadIdx.x == 0) {
        unsigned* bar = b.bar;
        __builtin_amdgcn_s_waitcnt(0);
        unsigned nloc = b.st[0], nx = b.st[1];
        if (nloc == 0u) { xcd_barrier_complete(bar, b.x, nloc, nx); b.st[0] = nloc; b.st[1] = nx; }
        const unsigned old = xb_add(&bar[XB_XSUB(b.x)], 1u);
        const unsigned gen = old / nloc;
        if (old + 1u == (gen + 1u) * nloc) {
            __builtin_amdgcn_fence(__ATOMIC_RELEASE, "agent");
            asm volatile("s_waitcnt vmcnt(0)" ::: "memory");
            const unsigned og = xb_add(&bar[XB_TOP], 1u);
            const unsigned tg = og / nx;
            if (og + 1u == (tg + 1u) * nx) xb_add(&bar[XB_TOPGEN], 1u);
            else XB_SPIN(xb_ld(&bar[XB_TOPGEN]) == tg, bar);
            __builtin_amdgcn_fence(__ATOMIC_ACQUIRE, "agent");
            xb_add(&bar[XB_XGEN(b.x)], 1u);
            asm volatile("s_waitcnt vmcnt(0)" ::: "memory");
        } else {
            XB_SPIN(xb_ld(&bar[XB_XGEN(b.x)]) == gen, bar);
            __builtin_amdgcn_fence(__ATOMIC_ACQUIRE, "agent");
            asm volatile("s_waitcnt vmcnt(0)" ::: "memory");
        }
    }
    __syncthreads();
}

__global__ void __launch_bounds__(512, 2) mega_fwd(Args a) {
    extern __shared__ __attribute__((aligned(16))) unsigned char lds_raw[];
    LAS unsigned char* lds = (LAS unsigned char*)lds_raw;
    cg::grid_group grid = cg::this_grid();
    const int tid = threadIdx.x, lane = tid & 63, wave = __builtin_amdgcn_readfirstlane(tid >> 6);
    volatile LAS unsigned* bst = (volatile LAS unsigned*)(lds + 161792);
    if (tid < 2) bst[tid] = 0u;
    __syncthreads();
    XcdBarrier bar = xcd_barrier_post((unsigned*)(a.ws + WS_BAR), bst);
    if (a.ws == nullptr) grid.sync();
#ifndef REP0
#define REP0 1
#define REP1 1
#define REPD1 1
#define REPD2 1
#define REPM 1
#define REP4 1
#endif
    for (int rep = 0; rep < REP0; ++rep) phase0(a, lds, tid, lane, wave);
    xcd_barrier(bar);
    {
        pg8::Gemm g{(const pg8::bf16_t*)(a.ws + WS_XB), (const pg8::bf16_t*)(a.ws + WS_WT), MTOK, NIN, DM}; pg8::StaticOrder S; S.init(MTOK, NIN, gridDim.x, (int)blockIdx.x, REP1);
        Epi1 E{(bf16_t*)(a.ws + WS_Z), (bf16_t*)(a.ws + WS_G), (bf16_t*)(a.ws + WS_Q), (bf16_t*)(a.ws + WS_K), (bf16_t*)(a.ws + WS_V)};
        pg8::gemm_phase<Epi1, pg8::StaticOrder, true, true>(lds, g, S, E);
    }
    xcd_barrier(bar);
    attn_phase<false>(a, lds, tid, lane, wave);
    for (int rep = 0; rep < REPD1; ++rep) dft1_phase(a, lds, tid, lane, wave);
    xcd_barrier(bar);
    for (int rep = 0; rep < REPD2; ++rep) dft2_phase(a, lds, tid, lane, wave);
    attn_phase<true>(a, lds, tid, lane, wave);
    xcd_barrier(bar);
    {
        pg8::Gemm g{(const pg8::bf16_t*)(a.ws + WS_Z), (const pg8::bf16_t*)(a.ws + WS_WOT), MTOK, DM, DM}; pg8::StaticOrder S; S.init(MTOK, DM, gridDim.x, (int)blockIdx.x, REP4);
        Epi2 E{a.x, a.out};
        pg8::gemm_phase<Epi2, pg8::StaticOrder, true, true>(lds, g, S, E);
    }
}

extern "C" void kernel_launch(void* const* d_in, const int* in_sizes, int n_in, void* d_out, int out_size, void* d_ws, size_t ws_size, hipStream_t stream) {
    static int grid = 0;
    if (grid == 0) {
        if (n_in != 7 || in_sizes[0] != MTOK * DM || out_size != MTOK * DM || ws_size < WS_END) { fprintf(stderr, "kernel_launch: unexpected shapes / workspace (%d inputs, ws %zu)\n", n_in, ws_size); grid = -1; return; }
        int dev = 0, cus = 0, per_cu = 0;
        hipGetDevice(&dev); hipDeviceGetAttribute(&cus, hipDeviceAttributeMultiprocessorCount, dev);
        hipFuncSetAttribute((const void*)mega_fwd, hipFuncAttributeMaxDynamicSharedMemorySize, LDS_BYTES);
        hipOccupancyMaxActiveBlocksPerMultiprocessor(&per_cu, (const void*)mega_fwd, 512, LDS_BYTES);
        if (per_cu < 1) { fprintf(stderr, "kernel_launch: occupancy query says %d blocks per CU\n", per_cu); per_cu = 1; }
        grid = cus;
        (void)hipGetLastError();
    }
    if (grid < 0) return;
    Args a{};
    a.x = (const float*)d_in[0]; a.norm_w = (const float*)d_in[1]; a.w_in = (const float*)d_in[2]; a.qw = (const float*)d_in[3]; a.kw = (const float*)d_in[4];
    a.wf = (const float*)d_in[5]; a.w_out = (const float*)d_in[6]; a.out = (float*)d_out; a.ws = (unsigned char*)d_ws;
    if (hipMemsetAsync((char*)d_ws + WS_BAR, 0, 16384, stream) != hipSuccess) { fprintf(stderr, "kernel_launch: memset of the barrier words failed\n"); return; }
    void* args[] = {&a};
    hipError_t e = hipLaunchCooperativeKernel((const void*)mega_fwd, dim3(grid), dim3(512), args, LDS_BYTES, stream);
    if (e != hipSuccess) fprintf(stderr, "cooperative launch failed: %s (grid %d)\n", hipGetErrorString(e), grid);
}
```

```cpp
#include <hip/hip_runtime.h>
#include <hip/hip_cooperative_groups.h>
#include <cstdio>
#include <cstdint>
namespace cg = cooperative_groups;
namespace pg8 {
#define PG8_LAS __attribute__((address_space(3)))
typedef unsigned short bf16_t;
typedef short bf16x8 __attribute__((ext_vector_type(8)));
typedef float f32x4 __attribute__((ext_vector_type(4)));
typedef unsigned u32x4 __attribute__((ext_vector_type(4)));
constexpr int BM = 256, BK = 64, HALF = 128, HTB = HALF * BK * 2  , STAGE_BYTES = 8 * HTB, NXCD = 8, WGM = 8;

__host__ __device__ __forceinline__ int lds_byte(int r, int c) { const int st = (r >> 4) * 2 + (c >> 5), rr = r & 15, cc = c & 31, ob = rr * 64 + cc * 2; return st * 1024 + (ob ^ (((ob >> 9) & 1) << 5)); }
__host__ __device__ __forceinline__ void stage_rc(int b, int& R, int& C) { const int st = b / 1024, sb = b % 1024, swz = sb ^ (((sb >> 9) & 1) << 5); R = (st >> 1) * 16 + swz / 64; C = (st & 1) * 32 + (swz % 64) / 2; }
__host__ __device__ __forceinline__ int perm32(int rho) { const int n = rho >> 4, i = rho & 15; return 8 * (i >> 2) + 4 * n + (i & 3); }

struct Unit { int pm, pn; };
struct Gemm { const bf16_t* A; const bf16_t* Bt; int M, N, K; };

struct StaticOrder {
    int nM, nN, nwg, G, c, rep;
    __host__ __device__ void init(int M, int N, int G_, int c_, int rep_ = 1) { nM = M / BM; nN = N / BM; nwg = nM * nN; G = G_; c = c_; rep = rep_; }
    __host__ __device__ bool next(int i, Unit& u) const {
        const int per = (nwg + G - 1) / G; if (i >= per * rep) return false; const long L = (long)(i % per) * G + c; if (L >= nwg) return false;
        int wgid = (int)L; { const int q = nwg / NXCD, r = nwg % NXCD, xcd = wgid % NXCD, off = wgid / NXCD; wgid = (xcd < r ? xcd * (q + 1) : r * (q + 1) + (xcd - r) * q) + off; }
        const int nig = WGM * nN, gid = wgid / nig, fm = gid * WGM, gsz = (nM - fm) < WGM ? (nM - fm) : WGM;
        u.pm = fm + ((wgid % nig) % gsz); u.pn = (wgid % nig) / gsz; return true;
    }
    __device__ __forceinline__ void a_ready(const Unit&) const {}
    __device__ __forceinline__ void done(const Unit&) const {}
};

__device__ __forceinline__ unsigned cvt_pk_bf16(float lo, float hi) { unsigned r; asm volatile("v_cvt_pk_bf16_f32 %0, %1, %2" : "=v"(r) : "v"(lo), "v"(hi)); return r; }
typedef float f32x2 __attribute__((ext_vector_type(2)));
template <class Epi, class Sched, bool ALIGN_EPI = false, bool SP2 = false>
__device__ __forceinline__ void gemm_phase(PG8_LAS unsigned char* lds, const Gemm g, const Sched& S, const Epi& E) {
    const int tid = threadIdx.x, wid = __builtin_amdgcn_readfirstlane(tid >> 6), lane = tid & 63, wr = wid >> 2, wc = wid & 3, fr = lane & 15, fq = lane >> 4;
    const int K = g.K, nt = K / BK;
    unsigned voffA[2], voffB[2];
#pragma unroll
    for (int i = 0; i < 2; ++i) { int R, C; stage_rc(tid * 16 + i * 8192, R, C); const int Rb = Epi::PERM2 ? (64 * (R >> 5) + perm32(R & 31)) : (Epi::PERM ? ((R & ~31) + perm32(R & 31)) : R);
        voffA[i] = (unsigned)(R * K + C) * 2u; voffB[i] = (unsigned)(Rb * K + C) * 2u; }
    const size_t kstep = (size_t)(BK * 2);
    const size_t hstep = (size_t)HALF * K * 2;
    const size_t hstepB = Epi::PERM2 ? (size_t)32 * K * 2 : hstep;
    const size_t tstep = 2 * hstep;
    const unsigned ldsw = (unsigned)wid * 1024u;
    const int aoff = lds_byte(wr * 64 + fr, fq * 8), boff = lds_byte(wc * 32 + fr, fq * 8);
#define PG8_SA(b, h) (((b) * 2 + (h)) * HTB)
#define PG8_SB(b, h) ((4 + (b) * 2 + (h)) * HTB)
#define PG8_STAGE(bufoff, gbase, voff) do { _Pragma("unroll") for (int _i = 0; _i < 2; ++_i) \
        __builtin_amdgcn_global_load_lds((const unsigned*)((const char*)(gbase) + (voff)[_i]), (PG8_LAS unsigned*)(lds + (bufoff) + ldsw + _i * 8192), 16, 0, 0); } while (0)
#define PG8_LDA(dst, b, h) do { _Pragma("unroll") for (int m = 0; m < 4; ++m) _Pragma("unroll") for (int k = 0; k < 2; ++k) dst[m][k] = *(const PG8_LAS bf16x8*)(lds + PG8_SA(b, h) + aoff + m * 2048 + k * 1024); } while (0)
#define PG8_LDB(dst, b, h) do { _Pragma("unroll") for (int n = 0; n < 2; ++n) _Pragma("unroll") for (int k = 0; k < 2; ++k) dst[n][k] = *(const PG8_LAS bf16x8*)(lds + PG8_SB(b, h) + boff + n * 2048 + k * 1024); } while (0)
#define PG8_MMA(ai, bj, At, Bt) do { __builtin_amdgcn_s_setprio(1); _Pragma("unroll") for (int m = 0; m < 4; ++m) _Pragma("unroll") for (int n = 0; n < 2; ++n) _Pragma("unroll") for (int k = 0; k < 2; ++k) \
        acc[ai][bj][m][n] = __builtin_amdgcn_mfma_f32_16x16x32_bf16(Bt[n][k], At[m][k], acc[ai][bj][m][n], 0, 0, 0); __builtin_amdgcn_s_setprio(0); } while (0)
#define PG8_WAIT_V(n) asm volatile("s_waitcnt vmcnt(" #n ")" ::: "memory")
#define PG8_WAIT_L(n) asm volatile("s_waitcnt lgkmcnt(" #n ")" ::: "memory")
#define PG8_BAR __builtin_amdgcn_s_barrier()
#define PG8_SCHED __builtin_amdgcn_sched_barrier(0)
    Unit cur, nxt; int ui = 0;
    if (!S.next(0, cur)) return;
    f32x4 acc[2][2][4][2];
#pragma unroll
    for (int a = 0; a < 2; ++a)
#pragma unroll
        for (int b = 0; b < 2; ++b)
#pragma unroll
            for (int m = 0; m < 4; ++m)
#pragma unroll
                for (int n = 0; n < 2; ++n) acc[a][b][m][n] = (f32x4){0.f, 0.f, 0.f, 0.f};
    bf16x8 At[4][2], B0[2][2], B1[2][2];
    const char* cA = (const char*)g.A + (size_t)cur.pm * tstep; const char* cB = (const char*)g.Bt + (size_t)cur.pn * tstep;
    S.a_ready(cur);
    if constexpr (SP2) {
        PG8_STAGE(PG8_SB(0, 0), cB, voffB); PG8_STAGE(PG8_SB(0, 1), cB + hstepB, voffB); PG8_STAGE(PG8_SA(0, 0), cA, voffA); PG8_STAGE(PG8_SA(0, 1), cA + hstep, voffA);
        if (wr == 1) PG8_BAR;
        PG8_WAIT_V(2); PG8_BAR;
        PG8_STAGE(PG8_SB(1, 0), cB + kstep, voffB); PG8_STAGE(PG8_SA(1, 0), cA + kstep, voffA); PG8_STAGE(PG8_SB(1, 1), cB + hstepB + kstep, voffB);
        PG8_WAIT_V(6); PG8_BAR;
    } else {
        PG8_STAGE(PG8_SB(0, 0), cB, voffB); PG8_STAGE(PG8_SA(0, 0), cA, voffA); PG8_STAGE(PG8_SB(0, 1), cB + hstepB, voffB); PG8_STAGE(PG8_SA(0, 1), cA + hstep, voffA);
        if (wr == 1) PG8_BAR;
        PG8_WAIT_V(4); PG8_BAR;
        PG8_STAGE(PG8_SB(1, 0), cB + kstep, voffB); PG8_STAGE(PG8_SA(1, 0), cA + kstep, voffA); PG8_STAGE(PG8_SB(1, 1), cB + hstepB + kstep, voffB);
        PG8_WAIT_V(6); PG8_BAR;
    }
    for (;;) {
        const bool has_next = S.next(ui + 1, nxt);
        const char* nA = has_next ? (const char*)g.A + (size_t)nxt.pm * tstep : cA; const char* nB = has_next ? (const char*)g.Bt + (size_t)nxt.pn * tstep : cB;
        for (int t = 0; t < nt; t += 2) {
            const bool last = (t == nt - 2);
            const char* a1 = cA + (size_t)(t + 1) * kstep;
            const char* a2 = last ? nA : cA + (size_t)(t + 2) * kstep; const char* b2 = last ? nB : cB + (size_t)(t + 2) * kstep;
            const char* a3 = a2 + kstep; const char* b3 = b2 + kstep;
            if (last && has_next) S.a_ready(nxt);
            if constexpr (SP2) {
            PG8_LDB(B0, 0, 0); PG8_LDB(B1, 0, 1); PG8_SCHED; PG8_LDA(At, 0, 0); PG8_STAGE(PG8_SA(1, 1), a1 + hstep, voffA);
            PG8_WAIT_V(8); PG8_WAIT_L(0); PG8_BAR; PG8_MMA(0, 0, At, B0); PG8_MMA(0, 1, At, B1); PG8_BAR; PG8_SCHED;
            PG8_LDA(At, 0, 1); PG8_STAGE(PG8_SB(0, 0), b2, voffB); PG8_STAGE(PG8_SB(0, 1), b2 + hstepB, voffB); PG8_STAGE(PG8_SA(0, 0), a2, voffA);
            PG8_WAIT_V(8); PG8_WAIT_L(0); PG8_BAR; PG8_MMA(1, 0, At, B0); PG8_MMA(1, 1, At, B1); PG8_BAR; PG8_SCHED;
            PG8_LDB(B0, 1, 0); PG8_LDB(B1, 1, 1); PG8_SCHED; PG8_LDA(At, 1, 0); PG8_STAGE(PG8_SA(0, 1), a2 + hstep, voffA);
            PG8_WAIT_V(8); PG8_WAIT_L(0); PG8_BAR; PG8_MMA(0, 0, At, B0); PG8_MMA(0, 1, At, B1); PG8_BAR; PG8_SCHED;
            PG8_LDA(At, 1, 1); PG8_STAGE(PG8_SB(1, 0), b3, voffB); PG8_STAGE(PG8_SB(1, 1), b3 + hstepB, voffB); PG8_STAGE(PG8_SA(1, 0), a3, voffA);
            PG8_WAIT_V(8); PG8_WAIT_L(0); PG8_BAR; PG8_MMA(1, 0, At, B0); PG8_MMA(1, 1, At, B1); PG8_BAR; PG8_SCHED;
            } else {
            PG8_LDB(B0, 0, 0); PG8_SCHED; PG8_LDA(At, 0, 0); PG8_STAGE(PG8_SA(1, 1), a1 + hstep, voffA);
            PG8_WAIT_L(8); PG8_BAR; PG8_WAIT_L(0); PG8_MMA(0, 0, At, B0); PG8_BAR; PG8_SCHED;
            PG8_LDB(B1, 0, 1); PG8_STAGE(PG8_SB(0, 0), b2, voffB);
            PG8_BAR; PG8_WAIT_L(0); PG8_MMA(0, 1, At, B1); PG8_BAR;
            PG8_LDA(At, 0, 1); PG8_STAGE(PG8_SA(0, 0), a2, voffA);
            PG8_BAR; PG8_WAIT_L(0); PG8_MMA(1, 0, At, B0); PG8_BAR; PG8_SCHED;
            PG8_STAGE(PG8_SB(0, 1), b2 + hstepB, voffB);
            PG8_WAIT_V(6); PG8_BAR; PG8_MMA(1, 1, At, B1); PG8_BAR;
            PG8_LDB(B0, 1, 0); PG8_SCHED; PG8_LDA(At, 1, 0); PG8_STAGE(PG8_SA(0, 1), a2 + hstep, voffA);
            PG8_WAIT_L(8); PG8_BAR; PG8_WAIT_L(0); PG8_MMA(0, 0, At, B0); PG8_BAR; PG8_SCHED;
            PG8_LDB(B1, 1, 1); PG8_STAGE(PG8_SB(1, 0), b3, voffB);
            PG8_BAR; PG8_WAIT_L(0); PG8_MMA(0, 1, At, B1); PG8_BAR;
            PG8_LDA(At, 1, 1); PG8_STAGE(PG8_SA(1, 0), a3, voffA);
            PG8_BAR; PG8_WAIT_L(0); PG8_MMA(1, 0, At, B0); PG8_BAR; PG8_SCHED;
            PG8_STAGE(PG8_SB(1, 1), b3 + hstepB, voffB);
            PG8_WAIT_V(6); PG8_BAR; PG8_MMA(1, 1, At, B1); PG8_BAR;
            }
        }
        if constexpr (ALIGN_EPI) { if (wr == 0) PG8_BAR; }
        if constexpr (!Epi::AFTER_DRAIN) { E(acc, cur, wr, wc, fr, fq); S.done(cur); }
        if (!has_next) break;
#pragma unroll
        for (int a = 0; a < 2; ++a)
#pragma unroll
            for (int b = 0; b < 2; ++b)
#pragma unroll
                for (int m = 0; m < 4; ++m)
#pragma unroll
                    for (int n = 0; n < 2; ++n) acc[a][b][m][n] = (f32x4){0.f, 0.f, 0.f, 0.f};
        cur = nxt; cA = nA; cB = nB; ++ui;
        if constexpr (ALIGN_EPI) { if (wr == 1) PG8_BAR; }
    }
    PG8_WAIT_V(0);
    if constexpr (!ALIGN_EPI) { if (wr == 0) PG8_BAR; }
    PG8_BAR;
    if constexpr (Epi::AFTER_DRAIN) { E.fused(acc, cur, wr, wc, fr, fq, lds, wid, lane); S.done(cur); }
#undef PG8_SA
#undef PG8_SB
#undef PG8_STAGE
#undef PG8_LDA
#undef PG8_LDB
#undef PG8_MMA
#undef PG8_WAIT_V
#undef PG8_WAIT_L
#undef PG8_BAR
#undef PG8_SCHED
}
}
#define LAS __attribute__((address_space(3)))
typedef unsigned short bf16_t;
typedef short bf16x8 __attribute__((ext_vector_type(8)));
typedef short s16x4 __attribute__((ext_vector_type(4)));
typedef short v4i16_t __attribute__((ext_vector_type(4)));
typedef float f32x4 __attribute__((ext_vector_type(4)));
typedef float f32x16 __attribute__((ext_vector_type(16)));
typedef unsigned u32x4 __attribute__((ext_vector_type(4)));
typedef unsigned u32x2 __attribute__((ext_vector_type(2)));

constexpr int SEQ = 8192, DM = 1024, MTOK = 65536, NIN = 6144, QKVW = 1536;
constexpr size_t WS_WT = 0, WS_WOT = 13631488, WS_RS = 15728640, WS_LSE = 15990784, WS_BAR = 23068672, WS_GMT = 24117248, WS_XB = 33554432, WS_Z = 167772160, WS_G = 301989888,
                 WS_Q = 436207616, WS_K = 637534208, WS_V = 838860800, WS_END = 1040187392;
constexpr int LDS_BYTES = 162944;
constexpr float LOG2E = 1.4426950408889634f;

__device__ __forceinline__ unsigned f2bf(float f) { unsigned u = __builtin_bit_cast(unsigned, f); return (u + 0x7fffu + ((u >> 16) & 1u)) >> 16; }
typedef float f32x2_t __attribute__((ext_vector_type(2))); typedef __bf16 bf16x2_t __attribute__((ext_vector_type(2)));
__device__ __forceinline__ unsigned pk2(float lo, float hi) { f32x2_t v = {lo, hi}; bf16x2_t b = __builtin_convertvector(v, bf16x2_t); return __builtin_bit_cast(unsigned, b); }
__device__ __forceinline__ float bflo(unsigned w) { return __builtin_bit_cast(float, w << 16); }
__device__ __forceinline__ float bfhi(unsigned w) { return __builtin_bit_cast(float, w & 0xffff0000u); }
__device__ __forceinline__ int crow(int r, int hi) { return (r & 3) + 8 * (r >> 2) + 4 * hi; }
__device__ __forceinline__ float wave_sum(float v) {
#pragma unroll
    for (int o = 1; o < 64; o <<= 1) v += __shfl_xor(v, o);
    return v;
}
__device__ __forceinline__ s16x4 trrd(LAS const unsigned char* p) { return __builtin_bit_cast(s16x4, __builtin_amdgcn_ds_read_tr16_b64_v4i16((LAS v4i16_t*)p)); }
__device__ __forceinline__ float silu_f(float v) { return v * __builtin_amdgcn_rcpf(1.f + __builtin_amdgcn_exp2f(-v * LOG2E)); }
#define LDS_WAIT() asm volatile("s_waitcnt lgkmcnt(0)" ::: "memory")
template <int CTRL> __device__ __forceinline__ unsigned dpp_mov(unsigned v) { return (unsigned)__builtin_amdgcn_update_dpp(0, (int)v, CTRL, 0xF, 0xF, true); }
template <int CTRL> __device__ __forceinline__ float dpp_movf(float v) { return __builtin_bit_cast(float, dpp_mov<CTRL>(__builtin_bit_cast(unsigned, v))); }

struct Args { const float *x, *norm_w, *w_in, *qw, *kw, *wf, *w_out; float* out; unsigned char* ws; };

__device__ __forceinline__ void transpose_item(const float* W, int ldw, int ncol0, bf16_t* WT, int row_off, const float* kscale, LAS float* scr, int kb, int nb, int lane) {
    const int k0 = 64 * kb, n0 = 32 * nb;
#pragma unroll 8
    for (int i = 0; i < 32; ++i) { const int kk = 2 * i + (lane >> 5); float v = W[(size_t)(k0 + kk) * ldw + ncol0 + n0 + (lane & 31)]; if (kscale) v *= kscale[k0 + kk]; scr[kk * 33 + (lane & 31)] = v; }
    LDS_WAIT();
    const int c = lane & 7;
#pragma unroll
    for (int j = 0; j < 4; ++j) { const int n = (lane >> 3) + 8 * j; const LAS float* s = scr + (8 * c) * 33 + n;
        u32x4 o; o.x = pk2(s[0 * 33], s[1 * 33]); o.y = pk2(s[2 * 33], s[3 * 33]); o.z = pk2(s[4 * 33], s[5 * 33]); o.w = pk2(s[6 * 33], s[7 * 33]);
        *(u32x4*)(WT + (size_t)(row_off + n0 + n) * 1024 + k0 + 8 * c) = o; }
    LDS_WAIT();
}
__device__ __forceinline__ void gmt_unit(const Args& a, LAS unsigned char* lds, int unit, int tid) {
    bf16_t* GmT = (bf16_t*)(a.ws + WS_GMT);
    LAS float* tab = (LAS float*)lds;
    if (tid < 64) { float sn, cs; sincospif((float)tid * (1.f / 32.f), &sn, &cs); tab[2 * tid] = cs; tab[2 * tid + 1] = sn; }
    __syncthreads();
    const int g = unit >> 2, d = 16 * (unit & 3) + (tid >> 5), c32 = tid & 31;
    float acc[4] = {0.f, 0.f, 0.f, 0.f};
    for (int l = 0; l < 64; ++l) { const float w = a.wf[(size_t)(g * 64 + l) * 64 + d];
#pragma unroll
        for (int e = 0; e < 4; ++e) { const int cc = c32 * 4 + e, c = cc & 63, idx = (l * c) & 63; acc[e] += w * (cc < 64 ? tab[2 * idx] : -tab[2 * idx + 1]); } }
#pragma unroll
    for (int e = 0; e < 4; ++e) GmT[(size_t)(g * 64 + d) * 128 + c32 * 4 + e] = (bf16_t)f2bf(acc[e] * 0.125f);
    __syncthreads();
}
__device__ __forceinline__ void phase0(const Args& a, LAS unsigned char* lds, int tid, int lane, int wave) {
    bf16_t* Wt = (bf16_t*)(a.ws + WS_WT); bf16_t* WoT = (bf16_t*)(a.ws + WS_WOT); bf16_t* xb = (bf16_t*)(a.ws + WS_XB);
    const int G = gridDim.x, bx = blockIdx.x;
    for (int u = bx; u < 32; u += G) gmt_unit(a, lds, u, tid);
    if (bx == G - 1 && wave < 3) {
        for (int hd = wave * 8; hd < wave * 8 + 8; ++hd) {
            float gqm = fabsf(a.qw[hd * 64 + lane]), gkm = fabsf(a.kw[hd * 64 + lane]);
#pragma unroll
            for (int o = 1; o < 64; o <<= 1) { gqm = fmaxf(gqm, __shfl_xor(gqm, o)); gkm = fmaxf(gkm, __shfl_xor(gkm, o)); }
            if (lane == 0) ((float*)(a.ws + WS_RS))[hd] = 8.08f * LOG2E * gqm * gkm;
        }
    }
    LAS float* scr = (LAS float*)(lds + 32768 + wave * 8448);
    const int gw = bx * 8 + wave, NGW = G * 8;
    constexpr int I_IN = 16 * 192, I_OUT = 16 * 32;
    for (int it = gw; it < I_IN + I_OUT; it += NGW) {
        if (it < I_IN) transpose_item(a.w_in, 6144, 0, Wt, 0, a.norm_w, scr, it / 192, it % 192, lane);
        else { const int r = it - I_IN; transpose_item(a.w_out, 1024, 0, WoT, 0, nullptr, scr, r / 32, r % 32, lane); }
    }
    for (int row = gw; row < MTOK; row += 2 * NGW) {
        const int row2 = row + NGW; const bool has2 = row2 < MTOK;
        const f32x4* xr = (const f32x4*)(a.x + (size_t)row * DM) + lane; const f32x4* xr2 = (const f32x4*)(a.x + (size_t)(has2 ? row2 : row) * DM) + lane;
        f32x4 v[4], v2[4]; float s = 0.f, s2 = 0.f;
#pragma unroll
        for (int j = 0; j < 4; ++j) { v[j] = __builtin_nontemporal_load(xr + 64 * j); v2[j] = __builtin_nontemporal_load(xr2 + 64 * j); }
#pragma unroll
        for (int j = 0; j < 4; ++j) { s += (v[j].x * v[j].x + v[j].y * v[j].y) + (v[j].z * v[j].z + v[j].w * v[j].w); s2 += (v2[j].x * v2[j].x + v2[j].y * v2[j].y) + (v2[j].z * v2[j].z + v2[j].w * v2[j].w); }
        s = wave_sum(s); s2 = wave_sum(s2);
        const float r = 1.0f / sqrtf(s * (1.f / DM) + 1e-6f), r2 = 1.0f / sqrtf(s2 * (1.f / DM) + 1e-6f);
        u32x2* o = (u32x2*)(xb + (size_t)row * DM) + lane;
#pragma unroll
        for (int j = 0; j < 4; ++j) { u32x2 w; w.x = pk2(v[j].x * r, v[j].y * r); w.y = pk2(v[j].z * r, v[j].w * r); o[64 * j] = w; }
        if (has2) { u32x2* o2 = (u32x2*)(xb + (size_t)row2 * DM) + lane;
#pragma unroll
            for (int j = 0; j < 4; ++j) { u32x2 w; w.x = pk2(v2[j].x * r2, v2[j].y * r2); w.y = pk2(v2[j].z * r2, v2[j].w * r2); o2[64 * j] = w; } }
    }
}

struct Epi1 {
    static constexpr bool PERM = true, PERM2 = true, AFTER_DRAIN = false;
    bf16_t *Z, *G, *Q, *Kb, *V;
    __device__ __forceinline__ void operator()(const pg8::f32x4 (&acc)[2][2][4][2], const pg8::Unit& u, int wr, int wc, int fr, int fq) const {
        const int pn = u.pn; const int hi8 = (fr >> 3) & 1, fr7 = fr & 7; const int rbase = u.pm * 256 + wr * 64 + fr7;
        const bool qkv = (pn >= 4 && pn < 22);
        const bool act = !qkv && pn >= 2;
        const int ld = pn < 2 ? 512 : 1024;
        bf16_t* base; int dsh = 0; size_t rowstride_tok = 0; int ecol;
        if (qkv) { const int which = (pn - 4) / 6, ct = (pn - 4) % 6; dsh = 2 * (ct >> 1);
            base = Q + (size_t)which * ((WS_K - WS_Q) / 2) + (size_t)(ct * 4 + wc) * SEQ * 64; ecol = 32 * hi8 + 8 * fq; }
        else { const int c0 = pn < 2 ? pn * 256 : (pn < 4 ? (pn - 2) * 256 : 512 + (pn - 22) * 256); base = (pn < 2 ? Z : G) + c0 + wc * 64; ecol = 32 * hi8 + 8 * fq; }
        const int dmask = (1 << dsh) - 1, Lc = SEQ >> dsh;
#pragma unroll
        for (int ai = 0; ai < 2; ++ai)
#pragma unroll
            for (int m = 0; m < 4; ++m) {
                pg8::f32x4 a0 = acc[ai][0][m][0], a1 = acc[ai][0][m][1], b0 = acc[ai][1][m][0], b1 = acc[ai][1][m][1];
                if (act) {
#pragma unroll
                    for (int e = 0; e < 4; ++e) { a0[e] = silu_f(a0[e]); a1[e] = silu_f(a1[e]); b0[e] = silu_f(b0[e]); b1[e] = silu_f(b1[e]); } }
                u32x4 A, B; A.x = pk2(a0[0], a0[1]); A.y = pk2(a0[2], a0[3]); A.z = pk2(a1[0], a1[1]); A.w = pk2(a1[2], a1[3]);
                B.x = pk2(b0[0], b0[1]); B.y = pk2(b0[2], b0[3]); B.z = pk2(b1[0], b1[1]); B.w = pk2(b1[2], b1[3]);
                u32x4 snd, rcv;
#pragma unroll
                for (int e = 0; e < 4; ++e) { snd[e] = hi8 ? A[e] : B[e]; rcv[e] = dpp_mov<0x128>(snd[e]); }
                u32x4 d1, d2;
#pragma unroll
                for (int e = 0; e < 4; ++e) { d1[e] = hi8 ? rcv[e] : A[e]; d2[e] = hi8 ? B[e] : rcv[e]; }
                const int row1 = rbase + ai * 128 + m * 16, row2 = row1 + 8;
                if (qkv) {
                    const int bb = row1 >> 13, t1 = row1 & (SEQ - 1), t2 = row2 & (SEQ - 1);
                    const int p1 = (t1 & dmask) * Lc + (t1 >> dsh), p2 = (t2 & dmask) * Lc + (t2 >> dsh);
                    bf16_t* hb = base + (size_t)bb * 24 * SEQ * 64 + ecol;
                    *(u32x4*)(hb + (size_t)p1 * 64) = d1; *(u32x4*)(hb + (size_t)p2 * 64) = d2;
                } else {
                    *(u32x4*)(base + (size_t)row1 * ld + ecol) = d1; *(u32x4*)(base + (size_t)row2 * ld + ecol) = d2;
                }
            }
    }
};
struct Epi2 {
    static constexpr bool PERM = false, PERM2 = false, AFTER_DRAIN = false;
    const float* x; float* out;
    __device__ __forceinline__ void operator()(const pg8::f32x4 (&acc)[2][2][4][2], const pg8::Unit& u, int wr, int wc, int fr, int fq) const {
        const int row0 = u.pm * 256 + wr * 64 + fr, col0 = u.pn * 256 + wc * 32 + 4 * fq;
#pragma unroll
        for (int ai = 0; ai < 2; ++ai)
#pragma unroll
            for (int m = 0; m < 4; ++m) { const size_t off = (size_t)(row0 + ai * 128 + m * 16) * DM + col0;
#pragma unroll
                for (int bj = 0; bj < 2; ++bj)
#pragma unroll
                    for (int n = 0; n < 2; ++n) { const size_t o2 = off + bj * 128 + n * 16; *(pg8::f32x4*)(out + o2) = *(const pg8::f32x4*)(x + o2) + acc[ai][bj][m][n]; }
                if (m & 1) asm volatile("" ::: "memory"); }
    }
};

constexpr int TP = 192;
constexpr int TTP = 272;
template <int NROWS> __device__ __forceinline__ void load_tile(LAS unsigned char* lds, const bf16_t* src, size_t rstride, int tid) {
    u32x4 v[NROWS / 64];
#pragma unroll
    for (int i = 0; i < NROWS / 64; ++i) { const int ci = tid + 512 * i, row = ci >> 3, ch = ci & 7; v[i] = *(const u32x4*)(src + (size_t)row * rstride + ch * 8); }
#pragma unroll
    for (int i = 0; i < NROWS / 64; ++i) { const int ci = tid + 512 * i, row = ci >> 3, ch = ci & 7; *(LAS u32x4*)(lds + row * TP + ch * 16) = v[i]; }
}
__device__ __forceinline__ void dft1_phase(const Args& a, LAS unsigned char* lds, int tid, int lane, int wave) {
    asm volatile("" : "+v"(tid), "+v"(lane));
    const bf16_t* Z = (const bf16_t*)(a.ws + WS_Z); bf16_t* Y = (bf16_t*)(a.ws + WS_XB);
    const int h = lane >> 5, l31 = lane & 31, kb = wave & 3, nt = wave >> 2;
    bf16x8 af[8];
    { const int ri_row = l31 >> 4, k1 = 16 * kb + (l31 & 15);
#pragma unroll
      for (int ks = 0; ks < 8; ++ks) { unsigned pw[4];
#pragma unroll
        for (int jj = 0; jj < 4; ++jj) { float vv[2];
#pragma unroll
            for (int e = 0; e < 2; ++e) { const int s1 = 16 * ks + 8 * h + 2 * jj + e; const float fr = (float)((s1 * k1) & 127) * (1.f / 128.f); const float sn = __builtin_amdgcn_sinf(fr), cs = __builtin_amdgcn_cosf(fr);
                float val = ri_row == 0 ? cs : sn;
                if (ri_row == 1 && k1 == 0) val = (s1 & 1) ? -1.f : 1.f;
                vv[e] = val * 0.08838834764831845f; }
            pw[jj] = pk2(vv[0], vv[1]); }
        u32x4 t; t.x = pw[0]; t.y = pw[1]; t.z = pw[2]; t.w = pw[3]; af[ks] = __builtin_bit_cast(bf16x8, t); } }
    const int q = (lane & 15) >> 2, p = lane & 3, blk = (lane >> 4) & 1;
    LAS const unsigned char* rb = lds + (8 * h + q) * TP + 32 * blk + 8 * p + nt * 64;
    u32x4 pf[2][2];
#define DFT1_ISSUE(zz, uu) do { const int dc_ = (uu) & 7, s2_ = ((uu) >> 3) & 63, b_ = (uu) >> 9; const bf16_t* src_ = Z + ((size_t)b_ * SEQ + s2_) * 512 + dc_ * 64; \
        _Pragma("unroll") for (int i_ = 0; i_ < 2; ++i_) { const int ci_ = tid + 512 * i_; pf[zz][i_] = *(const u32x4*)(src_ + (size_t)(ci_ >> 3) * (64 * 512) + (ci_ & 7) * 8); } } while (0)
    const int G2 = 2 * (int)gridDim.x;
    { const int u0 = blockIdx.x; if (u0 < 4096) DFT1_ISSUE(0, u0); if (u0 + (int)gridDim.x < 4096) DFT1_ISSUE(1, u0 + (int)gridDim.x); }
    for (int u = blockIdx.x; u < 4096; u += G2) {
        const bool has1 = u + (int)gridDim.x < 4096;
#pragma unroll
        for (int z = 0; z < 2; ++z)
#pragma unroll
            for (int i = 0; i < 2; ++i) { const int ci = tid + 512 * i; *(LAS u32x4*)(lds + z * 24576 + (ci >> 3) * TP + (ci & 7) * 16) = pf[z][i]; }
        __syncthreads();
        { const int un = u + G2; if (un < 4096) DFT1_ISSUE(0, un); if (un + (int)gridDim.x < 4096) DFT1_ISSUE(1, un + (int)gridDim.x); }
        f32x16 acc[2]; acc[0] = f32x16{}; acc[1] = f32x16{};
#pragma unroll
        for (int ks = 0; ks < 8; ++ks)
#pragma unroll
            for (int z = 0; z < 2; ++z) { const s16x4 lo = trrd(rb + z * 24576 + ks * 16 * TP), hi = trrd(rb + z * 24576 + ks * 16 * TP + 4 * TP);
                const bf16x8 bfr = __builtin_shufflevector(lo, hi, 0, 1, 2, 3, 4, 5, 6, 7);
                acc[z] = __builtin_amdgcn_mfma_f32_32x32x16_bf16(af[ks], bfr, acc[z], 0, 0, 0); }
#pragma unroll
        for (int z = 0; z < 2; ++z) { const int uz = u + z * (int)gridDim.x, s2 = (uz >> 3) & 63;
            LAS bf16_t* yt = (LAS bf16_t*)(lds + 49152 + z * 16640);
#pragma unroll
            for (int i = 0; i < 8; ++i) { const int k1 = 16 * kb + crow(i, h); const float re = acc[z][i], im = acc[z][i + 8]; const int col = 32 * nt + l31;
                if (k1 != 0) { const float fr = (float)(s2 * k1) * (1.f / 8192.f); const float sn = __builtin_amdgcn_sinf(fr), cs = __builtin_amdgcn_cosf(fr);
                    yt[(2 * k1) * 64 + col] = (bf16_t)f2bf(cs * re - sn * im); yt[(2 * k1 + 1) * 64 + col] = (bf16_t)f2bf(sn * re + cs * im); }
                else { const float fr = (float)s2 * (1.f / 128.f); const float sn = __builtin_amdgcn_sinf(fr), cs = __builtin_amdgcn_cosf(fr);
                    yt[col] = (bf16_t)f2bf(re); yt[64 + col] = (bf16_t)0; yt[128 * 64 + col] = (bf16_t)f2bf(cs * im); yt[129 * 64 + col] = (bf16_t)f2bf(sn * im); } } }
        __syncthreads();
#pragma unroll
        for (int z = 0; z < 2; ++z) { if (z == 1 && !has1) break;
            const int uz = u + z * (int)gridDim.x, dc = uz & 7, s2 = (uz >> 3) & 63, b = uz >> 9;
            LAS const bf16_t* yt = (LAS const bf16_t*)(lds + 49152 + z * 16640);
#pragma unroll
            for (int zz = 0; zz < 3; ++zz) { const int ci = tid + 512 * zz; if (ci < 130 * 8) { const int row = ci >> 3, ch = ci & 7, k1 = row < 128 ? (row >> 1) : 64, ri = row < 128 ? (row & 1) : (row - 128);
                *(u32x4*)(Y + ((size_t)((b * 128 + k1) * 2 + ri) * 64 + s2) * 512 + dc * 64 + ch * 8) = *(LAS const u32x4*)(yt + row * 64 + ch * 8); } } }
        __syncthreads();
    }
}
__device__ __forceinline__ void dft2_phase(const Args& a, LAS unsigned char* lds, int tid, int lane, int wave) {
    asm volatile("" : "+v"(tid), "+v"(lane));
    const bf16_t* Y = (const bf16_t*)(a.ws + WS_XB); const bf16_t* Gb = (const bf16_t*)(a.ws + WS_G); bf16_t* ym = (bf16_t*)(a.ws + WS_Z); const bf16_t* GmT = (const bf16_t*)(a.ws + WS_GMT);
    const int h = lane >> 5, l31 = lane & 31, ksub = wave >> 2, mh = (wave >> 1) & 1, nt = wave & 1;
    bf16x8 af[2][8];
#pragma unroll
    for (int z = 0; z < 2; ++z) { const int m = 64 * mh + 32 * z + l31, k2 = m & 63, imrow = m >> 6;
#pragma unroll
      for (int ks = 0; ks < 8; ++ks) { unsigned pw[4];
#pragma unroll
        for (int jj = 0; jj < 4; ++jj) { float vv[2];
#pragma unroll
            for (int e = 0; e < 2; ++e) { const int kk = 16 * ks + 8 * h + 2 * jj + e, ri = kk >> 6, s2 = kk & 63; const float fr = (float)((s2 * k2) & 63) * (1.f / 64.f); const float sn = __builtin_amdgcn_sinf(fr), cs = __builtin_amdgcn_cosf(fr);
                vv[e] = (imrow == 0 ? (ri == 0 ? cs : -sn) : (ri == 0 ? sn : cs)) * 0.125f; }
            pw[jj] = pk2(vv[0], vv[1]); }
        u32x4 t; t.x = pw[0]; t.y = pw[1]; t.z = pw[2]; t.w = pw[3]; af[z][ks] = __builtin_bit_cast(bf16x8, t); } }
    const int q = (lane & 15) >> 2, p = lane & 3, blk = (lane >> 4) & 1;
    LAS const unsigned char* rb = lds + (ksub * 128 + 8 * h + q) * TP + 32 * blk + 8 * p + nt * 64;
    LAS unsigned char* tt = lds + 49152;
    LAS float* ot = (LAS float*)(lds + 83968);
    const int mt2 = wave >> 1, nt2 = wave & 1;
    u32x4 ld[4];
#define DFT2_ISSUE(uu) do { const int dc_ = (uu) & 7, k1p_ = ((uu) >> 3) & 63, b_ = (uu) >> 9; \
        if (k1p_ == 0) { _Pragma("unroll") for (int z_ = 0; z_ < 2; ++z_) { const int ci_ = tid + 512 * z_; const size_t o_ = (size_t)(ci_ >> 3) * 512 + dc_ * 64 + (ci_ & 7) * 8; \
                ld[z_] = __builtin_nontemporal_load((const u32x4*)(Y + ((size_t)(b_ * 128) * 128) * 512 + o_)); ld[2 + z_] = __builtin_nontemporal_load((const u32x4*)(Y + ((size_t)(b_ * 128 + 64) * 128) * 512 + o_)); } } \
        else { const bf16_t* src_ = Y + ((size_t)(b_ * 128 + k1p_) * 128 + (tid >> 3)) * 512 + dc_ * 64 + (tid & 7) * 8; ld[0] = __builtin_nontemporal_load((const u32x4*)src_); ld[1] = __builtin_nontemporal_load((const u32x4*)(src_ + (size_t)64 * 512)); } } while (0)
    if ((int)blockIdx.x < 4096) DFT2_ISSUE((int)blockIdx.x);
    const bool gf_fixed = (gridDim.x & 7u) == 0u;
    bf16x8 gf[8];
#pragma unroll
    for (int ks = 0; ks < 8; ++ks) gf[ks] = *(const bf16x8*)(GmT + (size_t)((blockIdx.x & 7) * 64 + 32 * nt2 + l31) * 128 + 16 * ks + 8 * h);
    for (int u = blockIdx.x; u < 4096; u += gridDim.x) {
        const int dc = u & 7, k1p = (u >> 3) & 63, b = u >> 9;
        if (!gf_fixed) {
#pragma unroll
            for (int ks = 0; ks < 8; ++ks) gf[ks] = *(const bf16x8*)(GmT + (size_t)(dc * 64 + 32 * nt2 + l31) * 128 + 16 * ks + 8 * h); }
        const int k1a = k1p, k1b = k1p == 0 ? 64 : 128 - k1p;
        const int tr_e = tid >> 2, qt_e = tid & 3; const size_t tok_e = (size_t)b * SEQ + ((tr_e >> 6) ? k1b : k1a) + 128 * (tr_e & 63);
        const u32x4 g0 = __builtin_nontemporal_load((const u32x4*)(Gb + tok_e * 1024 + dc * 64 + qt_e * 16)), g1 = __builtin_nontemporal_load((const u32x4*)(Gb + tok_e * 1024 + dc * 64 + qt_e * 16 + 8));
        if (k1p == 0) {
#pragma unroll
            for (int z = 0; z < 2; ++z) { const int ci = tid + 512 * z, row = ci >> 3, ch = ci & 7; *(LAS u32x4*)(lds + row * TP + ch * 16) = ld[z]; *(LAS u32x4*)(lds + (128 + row) * TP + ch * 16) = ld[2 + z]; }
        } else {
            const int s2 = tid >> 3, ch = tid & 7;
            const u32x4 yr = ld[0], yi = ld[1];
            const float fr = (float)s2 * (1.f / 64.f); const float sn = __builtin_amdgcn_sinf(fr), cs = __builtin_amdgcn_cosf(fr);
            u32x4 zr, zi;
#pragma unroll
            for (int e = 0; e < 4; ++e) { const float rl = bflo(yr[e]), rh = bfhi(yr[e]), il = bflo(yi[e]), ih = bfhi(yi[e]);
                zr[e] = pk2(rl * cs + il * sn, rh * cs + ih * sn); zi[e] = pk2(rl * sn - il * cs, rh * sn - ih * cs); }
            *(LAS u32x4*)(lds + s2 * TP + ch * 16) = yr; *(LAS u32x4*)(lds + (64 + s2) * TP + ch * 16) = yi;
            *(LAS u32x4*)(lds + (128 + s2) * TP + ch * 16) = zr; *(LAS u32x4*)(lds + (192 + s2) * TP + ch * 16) = zi;
        }
        __syncthreads();
        if (u + (int)gridDim.x < 4096) DFT2_ISSUE(u + (int)gridDim.x);
        f32x16 acc[2]; acc[0] = f32x16{}; acc[1] = f32x16{};
#pragma unroll
        for (int ks = 0; ks < 8; ++ks) { const s16x4 lo = trrd(rb + ks * 16 * TP), hi = trrd(rb + ks * 16 * TP + 4 * TP);
            const bf16x8 bfr = __builtin_shufflevector(lo, hi, 0, 1, 2, 3, 4, 5, 6, 7);
            acc[0] = __builtin_amdgcn_mfma_f32_32x32x16_bf16(af[0][ks], bfr, acc[0], 0, 0, 0);
            acc[1] = __builtin_amdgcn_mfma_f32_32x32x16_bf16(af[1][ks], bfr, acc[1], 0, 0, 0); }
#pragma unroll
        for (int z = 0; z < 2; ++z)
#pragma unroll
            for (int i = 0; i < 16; ++i) *(LAS bf16_t*)(tt + (ksub * 64 + 32 * z + crow(i, h)) * TTP + (mh * 64 + 32 * nt + l31) * 2) = (bf16_t)f2bf(acc[z][i]);
        __syncthreads();
        f32x16 o2 = f32x16{}, o2b = f32x16{};
#pragma unroll
        for (int ks = 0; ks < 8; ks += 2) { const bf16x8 tf = *(LAS const bf16x8*)(tt + (32 * mt2 + l31) * TTP + (16 * ks + 8 * h) * 2), tf2 = *(LAS const bf16x8*)(tt + (32 * mt2 + l31) * TTP + (16 * (ks + 1) + 8 * h) * 2);
            o2 = __builtin_amdgcn_mfma_f32_32x32x16_bf16(tf, gf[ks], o2, 0, 0, 0); o2b = __builtin_amdgcn_mfma_f32_32x32x16_bf16(tf2, gf[ks + 1], o2b, 0, 0, 0); }
#pragma unroll
        for (int i = 0; i < 16; ++i) o2[i] += o2b[i];
#pragma unroll
        for (int i = 0; i < 16; ++i) ot[(32 * mt2 + crow(i, h)) * 64 + 32 * nt2 + l31] = o2[i];
        __syncthreads();
        {
            const int tr = tid >> 2, qt = tid & 3, ks2 = tr >> 6, k2 = tr & 63;
            const size_t tok = (size_t)b * SEQ + (ks2 ? k1b : k1a) + 128 * k2;
            const LAS f32x4* op = (const LAS f32x4*)(ot + tr * 64 + qt * 16);
            const f32x4 v0 = op[0], v1 = op[1], v2 = op[2], v3 = op[3];
            u32x4 w0, w1;
            w0.x = pk2(v0.x * bflo(g0.x), v0.y * bfhi(g0.x)); w0.y = pk2(v0.z * bflo(g0.y), v0.w * bfhi(g0.y)); w0.z = pk2(v1.x * bflo(g0.z), v1.y * bfhi(g0.z)); w0.w = pk2(v1.z * bflo(g0.w), v1.w * bfhi(g0.w));
            w1.x = pk2(v2.x * bflo(g1.x), v2.y * bfhi(g1.x)); w1.y = pk2(v2.z * bflo(g1.y), v2.w * bfhi(g1.y)); w1.z = pk2(v3.x * bflo(g1.z), v3.y * bfhi(g1.z)); w1.w = pk2(v3.z * bflo(g1.w), v3.w * bfhi(g1.w));
            *(u32x4*)(ym + tok * 1024 + dc * 64 + qt * 16) = w0; *(u32x4*)(ym + tok * 1024 + dc * 64 + qt * 16 + 8) = w1;
        }
        __syncthreads();
    }
}

constexpr int KP = 144, VP = 192, KROWS = 384, LDS_VOFF = KROWS * KP;
struct AUnit { int b, hd, dil, L, r, i0; };
__device__ __forceinline__ AUnit attn_decode(int u, int hd0, int nh) {
    AUnit w; const int blk32 = u & 31; w.hd = hd0 + (u >> 5) % nh; w.b = u / (32 * nh);
    const int dsh = 2 * (w.hd >> 3), nbr = 32 >> dsh; w.dil = 1 << dsh; w.L = SEQ >> dsh; w.r = blk32 / nbr; w.i0 = (blk32 % nbr) * 256; return w;
}
__device__ __forceinline__ void attn_issue(const AUnit& w, const bf16_t* Qb, const bf16_t* Kb, const bf16_t* Vb, int tid, int wave, int lane, u32x4 (&kv)[6], u32x4 (&vv)[6]) {
    const int ch = tid & 7;
#pragma unroll
    for (int i = 0; i < 6; ++i) { const int row = (tid + 512 * i) >> 3; int pk = w.i0 - 64 + row; pk = pk < 0 ? 0 : (pk >= w.L ? w.L - 1 : pk);
        const size_t off = ((size_t)(w.b * 24 + w.hd) * SEQ + (size_t)(w.r * w.L + pk)) * 64 + ch * 8; kv[i] = *(const u32x4*)(Kb + off); vv[i] = *(const u32x4*)(Vb + off); }
}
__device__ __forceinline__ float attn_tile_exp(f32x16& st, int j, float tlf, float bsl, float rlo, float rhi) {
    float sum = 0.f;
#pragma unroll
    for (int i = 0; i < 16; ++i) { const float tmp = (float)(32 * j - 64 + (i & 3) + 8 * (i >> 2)) + tlf;
        float arg = __builtin_fmaf(-bsl, __builtin_fabsf(tmp), st[i]);
        arg = (tmp >= rlo && tmp <= rhi) ? arg : -1.0e30f;
        const float pe = __builtin_amdgcn_exp2f(arg); st[i] = pe; sum += pe; }
    return sum;
}
template <bool FUSED> __device__ __forceinline__ void attn_phase(const Args& a, LAS unsigned char* lds, int tid, int lane, int wave) {
    constexpr int HD0 = FUSED ? 0 : 8, NH = FUSED ? 8 : 16, NU = 8 * NH * 32;
    asm volatile("" : "+v"(tid), "+v"(lane));
    bf16_t* Qb = (bf16_t*)(a.ws + WS_Q); const bf16_t* Kb = (const bf16_t*)(a.ws + WS_K); const bf16_t* Vb = (const bf16_t*)(a.ws + WS_V); float* LSE = (float*)(a.ws + WS_LSE);
    const int h = lane >> 5, l31 = lane & 31;
    const int q = (lane & 15) >> 2, p = lane & 3, blk = (lane >> 4) & 1;
    int u = blockIdx.x;
    u32x4 kv[6], vv[6], qv[4];
#define ATTN_QLOAD(W) do { const bf16_t* qr_ = Qb + ((size_t)((W).b * 24 + (W).hd) * SEQ + (size_t)((W).r * (W).L + (W).i0 + 32 * wave + l31)) * 64; \
        _Pragma("unroll") for (int ks_ = 0; ks_ < 4; ++ks_) qv[ks_] = *(const u32x4*)(qr_ + 16 * ks_ + 8 * h); } while (0)
    if (u < NU) { const AUnit w0 = attn_decode(u, HD0, NH); attn_issue(w0, Qb, Kb, Vb, tid, wave, lane, kv, vv); ATTN_QLOAD(w0); }
    while (u < NU) {
        const AUnit w = attn_decode(u, HD0, NH);
        const int hd = w.hd, slot = hd & 7, L = w.L, i0 = w.i0;
        const int iq = i0 + 32 * wave + l31; const size_t tq = (size_t)w.b * SEQ + (size_t)iq * w.dil + w.r;
        bf16_t* qrow = Qb + ((size_t)(w.b * 24 + hd) * SEQ + (size_t)(w.r * L + iq)) * 64;
        {
            const int ch = tid & 7;
            const f32x4 g0 = *(const f32x4*)(a.kw + hd * 64 + ch * 8), g1 = *(const f32x4*)(a.kw + hd * 64 + ch * 8 + 4);
#pragma unroll
            for (int i = 0; i < 6; ++i) { const int row = (tid + 512 * i) >> 3;
                const float e0 = bflo(kv[i].x), e1 = bfhi(kv[i].x), e2 = bflo(kv[i].y), e3 = bfhi(kv[i].y), e4 = bflo(kv[i].z), e5 = bfhi(kv[i].z), e6 = bflo(kv[i].w), e7 = bfhi(kv[i].w);
                float ss = (e0 * e0 + e1 * e1) + (e2 * e2 + e3 * e3) + (e4 * e4 + e5 * e5) + (e6 * e6 + e7 * e7);
                ss += dpp_movf<0xB1>(ss); ss += dpp_movf<0x4E>(ss); ss += dpp_movf<0x141>(ss);
                const float rk = __builtin_amdgcn_rsqf(ss * (1.f / 64.f) + 1e-6f);
                u32x4 wv; wv.x = pk2(e0 * rk * g0.x, e1 * rk * g0.y); wv.y = pk2(e2 * rk * g0.z, e3 * rk * g0.w); wv.z = pk2(e4 * rk * g1.x, e5 * rk * g1.y); wv.w = pk2(e6 * rk * g1.z, e7 * rk * g1.w);
                *(LAS u32x4*)(lds + row * KP + ch * 16) = wv;
                *(LAS u32x4*)(lds + LDS_VOFF + row * VP + ch * 16) = vv[i];
                if (i & 1) __builtin_amdgcn_sched_barrier(0); }
        }
        bf16x8 qf[4];
        {
            float ss = 0.f;
#pragma unroll
            for (int ks = 0; ks < 4; ++ks)
#pragma unroll
                for (int e = 0; e < 4; ++e) { const float lo = bflo(qv[ks][e]), hi = bfhi(qv[ks][e]); ss += lo * lo + hi * hi; }
            ss += __shfl_xor(ss, 32);
            const float rq = 0.125f * LOG2E * __builtin_amdgcn_rsqf(ss * (1.f / 64.f) + 1e-6f);
#pragma unroll
            for (int ks = 0; ks < 4; ++ks) { const f32x4 g0 = *(const f32x4*)(a.qw + hd * 64 + 16 * ks + 8 * h), g1 = *(const f32x4*)(a.qw + hd * 64 + 16 * ks + 8 * h + 4); u32x4 wv;
                wv.x = pk2(bflo(qv[ks].x) * rq * g0.x, bfhi(qv[ks].x) * rq * g0.y); wv.y = pk2(bflo(qv[ks].y) * rq * g0.z, bfhi(qv[ks].y) * rq * g0.w);
                wv.z = pk2(bflo(qv[ks].z) * rq * g1.x, bfhi(qv[ks].z) * rq * g1.y); wv.w = pk2(bflo(qv[ks].w) * rq * g1.z, bfhi(qv[ks].w) * rq * g1.w);
                qf[ks] = __builtin_bit_cast(bf16x8, wv); }
        }
        const float mb = ((const float*)(a.ws + WS_RS))[hd];
        __syncthreads();
        const int un = u + gridDim.x;
        if (un < NU) { const AUnit wn = attn_decode(un, HD0, NH); attn_issue(wn, Qb, Kb, Vb, tid, wave, lane, kv, vv); }
        const float bsl = __builtin_amdgcn_exp2f(-(float)(slot + 1)) * (float)w.dil * LOG2E;
        int tl = 4 * h - l31; asm volatile("" : "+v"(tl));
        const float tlf = (float)tl;
        const int lo_i = -iq > -64 ? -iq : -64, hi_i = (L - 1 - iq) < 64 ? (L - 1 - iq) : 64;
        const float rlo = (float)lo_i, rhi = (float)hi_i;
        const int wq0 = i0 + 32 * wave;
        const bool edge = (wq0 < 64) || (wq0 + 32 > L - 64);
        float sum = 0.f;
        f32x16 o[2]; o[0] = f32x16{}; o[1] = f32x16{};
#pragma unroll
        for (int j = 0; j < 5; ++j) {
            f32x16 st;
#pragma unroll
            for (int i = 0; i < 16; ++i) st[i] = -mb;
            LAS const unsigned char* kp = lds + (32 * wave + 32 * j + l31) * KP + 16 * h;
#pragma unroll
            for (int ks = 0; ks < 4; ++ks) { const bf16x8 kf = *(LAS const bf16x8*)(kp + 32 * ks); st = __builtin_amdgcn_mfma_f32_32x32x16_bf16(kf, qf[ks], st, 0, 0, 0); }
            sum += attn_tile_exp(st, j, tlf, bsl, rlo, rhi);
#pragma unroll
            for (int s2 = 0; s2 < 2; ++s2) { u32x4 pw; pw.x = pk2(st[8 * s2 + 0], st[8 * s2 + 1]); pw.y = pk2(st[8 * s2 + 2], st[8 * s2 + 3]); pw.z = pk2(st[8 * s2 + 4], st[8 * s2 + 5]); pw.w = pk2(st[8 * s2 + 6], st[8 * s2 + 7]);
                const bf16x8 pf = __builtin_bit_cast(bf16x8, pw);
                LAS const unsigned char* vp = lds + LDS_VOFF + (32 * wave + 32 * j + 16 * s2 + 4 * h + q) * VP + 32 * blk + 8 * p;
#pragma unroll
                for (int dt = 0; dt < 2; ++dt) { const s16x4 lo = trrd(vp + dt * 64), hi = trrd(vp + 8 * VP + dt * 64);
                    const bf16x8 vf = __builtin_shufflevector(lo, hi, 0, 1, 2, 3, 4, 5, 6, 7);
                    o[dt] = __builtin_amdgcn_mfma_f32_32x32x16_bf16(vf, pf, o[dt], 0, 0, 0); } }
            __builtin_amdgcn_sched_barrier(0);
        }
        sum += __shfl_xor(sum, 32);
        if (un < NU) { const AUnit wq = attn_decode(un, HD0, NH); ATTN_QLOAD(wq); }
        const float inv = __builtin_amdgcn_rcpf(sum);
        {
            u32x4 fo1[4], fo2[4], fg[4]; float fl1[4], fl2[4];
            if constexpr (FUSED) {
                const bf16_t* Gb = (const bf16_t*)(a.ws + WS_G);
#pragma unroll
                for (int it = 0; it < 4; ++it) { const int r = 8 * it + (lane >> 3), c16 = lane & 7, t = i0 + 32 * wave + r; const size_t tokg = (size_t)w.b * SEQ + t;
                    fl1[it] = LSE[tokg * 24 + 8 + slot]; fl2[it] = LSE[tokg * 24 + 16 + slot];
                    fo1[it] = __builtin_nontemporal_load((const u32x4*)(Qb + ((size_t)(w.b * 24 + 8 + slot) * SEQ + (t & 3) * 2048 + (t >> 2)) * 64 + c16 * 8));
                    fo2[it] = __builtin_nontemporal_load((const u32x4*)(Qb + ((size_t)(w.b * 24 + 16 + slot) * SEQ + (t & 15) * 512 + (t >> 4)) * 64 + c16 * 8));
                    fg[it] = __builtin_nontemporal_load((const u32x4*)(Gb + tokg * 1024 + 512 + slot * 64 + c16 * 8)); }
            }
            LAS unsigned char* ost = lds + 129024 + wave * 4096;
#pragma unroll
            for (int dt = 0; dt < 2; ++dt)
#pragma unroll
                for (int ig = 0; ig < 4; ++ig) { u32x2 wv; wv.x = pk2(o[dt][4 * ig] * inv, o[dt][4 * ig + 1] * inv); wv.y = pk2(o[dt][4 * ig + 2] * inv, o[dt][4 * ig + 3] * inv);
                    const int p8 = 8 * dt + 2 * ig + h; *(LAS u32x2*)(ost + l31 * 128 + 8 * (p8 ^ (l31 & 15))) = wv; }
            if constexpr (FUSED) { if (h == 0) ((LAS float*)(lds + 161808))[wave * 32 + l31] = mb + __builtin_amdgcn_logf(sum); }
            asm volatile("s_waitcnt lgkmcnt(0)" ::: "memory");
            if constexpr (!FUSED) {
                bf16_t* obase = qrow - l31 * 64;
#pragma unroll
                for (int it = 0; it < 4; ++it) { const int r = 8 * it + (lane >> 3), c16 = lane & 7;
                    u32x4 v = *(LAS const u32x4*)(ost + r * 128 + 16 * (c16 ^ ((r & 15) >> 1)));
                    if (r & 1) { const unsigned t0 = v.x, t1 = v.y; v.x = v.z; v.y = v.w; v.z = t0; v.w = t1; }
                    *(u32x4*)(obase + (size_t)r * 64 + c16 * 8) = v; asm volatile("" ::: "memory"); }
            } else {
                bf16_t* ym = (bf16_t*)(a.ws + WS_Z);
#pragma unroll
                for (int it = 0; it < 4; ++it) { const int r = 8 * it + (lane >> 3), c16 = lane & 7;
                    u32x4 v = *(LAS const u32x4*)(ost + r * 128 + 16 * (c16 ^ ((r & 15) >> 1)));
                    if (r & 1) { const unsigned t0 = v.x, t1 = v.y; v.x = v.z; v.y = v.w; v.z = t0; v.w = t1; }
                    const int t = i0 + 32 * wave + r; const size_t tokg = (size_t)w.b * SEQ + t;
                    const float l0 = ((LAS const float*)(lds + 161808))[wave * 32 + r], l1 = fl1[it], l2 = fl2[it];
                    const float mxl = fmaxf(l0, fmaxf(l1, l2));
                    float w0 = __builtin_amdgcn_exp2f(l0 - mxl), w1 = __builtin_amdgcn_exp2f(l1 - mxl), w2 = __builtin_amdgcn_exp2f(l2 - mxl);
                    const float iw = 1.0f / (w0 + w1 + w2); w0 *= iw; w1 *= iw; w2 *= iw;
                    u32x4 ov;
#pragma unroll
                    for (int e = 0; e < 4; ++e) { const float lo = (bflo(v[e]) * w0 + bflo(fo1[it][e]) * w1 + bflo(fo2[it][e]) * w2) * bflo(fg[it][e]); const float hi = (bfhi(v[e]) * w0 + bfhi(fo1[it][e]) * w1 + bfhi(fo2[it][e]) * w2) * bfhi(fg[it][e]); ov[e] = pk2(lo, hi); }
                    *(u32x4*)(ym + tokg * 1024 + 512 + slot * 64 + c16 * 8) = ov; }
            }
        }
        if constexpr (!FUSED) { if (h == 0) LSE[tq * 24 + hd] = mb + __builtin_amdgcn_logf(sum); }
        __syncthreads();
        u = un;
    }
}
__device__ __forceinline__ void merge_phase(const Args& a, int lane, int wave) {
    asm volatile("" : "+v"(lane));
    const bf16_t* Ob = (const bf16_t*)(a.ws + WS_Q); const bf16_t* Gb = (const bf16_t*)(a.ws + WS_G); const float* LSE = (const float*)(a.ws + WS_LSE); bf16_t* ym = (bf16_t*)(a.ws + WS_Z);
    const int gw = blockIdx.x * 8 + wave, NGW = gridDim.x * 8, slot = lane >> 3;
    for (int tok0 = gw; tok0 < MTOK; tok0 += 2 * NGW) {
        u32x4 o0[2], o1[2], o2[2], g[2]; float l0[2], l1[2], l2[2];
#pragma unroll
        for (int z = 0; z < 2; ++z) { int tok = tok0 + z * NGW; tok = tok < MTOK ? tok : tok0;
            l0[z] = LSE[(size_t)tok * 24 + slot]; l1[z] = LSE[(size_t)tok * 24 + 8 + slot]; l2[z] = LSE[(size_t)tok * 24 + 16 + slot];
            const int b = tok >> 13, t = tok & (SEQ - 1), part = lane & 7;
            o0[z] = __builtin_nontemporal_load((const u32x4*)(Ob + ((size_t)(b * 24 + slot) * SEQ + t) * 64 + part * 8));
            o1[z] = __builtin_nontemporal_load((const u32x4*)(Ob + ((size_t)(b * 24 + 8 + slot) * SEQ + (t & 3) * 2048 + (t >> 2)) * 64 + part * 8));
            o2[z] = __builtin_nontemporal_load((const u32x4*)(Ob + ((size_t)(b * 24 + 16 + slot) * SEQ + (t & 15) * 512 + (t >> 4)) * 64 + part * 8));
            g[z] = __builtin_nontemporal_load((const u32x4*)(Gb + (size_t)tok * 1024 + 512 + lane * 8)); }
#pragma unroll
        for (int z = 0; z < 2; ++z) { const int tok = tok0 + z * NGW; if (tok >= MTOK) break;
            const float mx = fmaxf(l0[z], fmaxf(l1[z], l2[z]));
            float w0 = __builtin_amdgcn_exp2f(l0[z] - mx), w1 = __builtin_amdgcn_exp2f(l1[z] - mx), w2 = __builtin_amdgcn_exp2f(l2[z] - mx);
            const float inv = 1.0f / (w0 + w1 + w2); w0 *= inv; w1 *= inv; w2 *= inv;
            u32x4 w;
#pragma unroll
            for (int e = 0; e < 4; ++e) { const float lo = (bflo(o0[z][e]) * w0 + bflo(o1[z][e]) * w1 + bflo(o2[z][e]) * w2) * bflo(g[z][e]); const float hi = (bfhi(o0[z][e]) * w0 + bfhi(o1[z][e]) * w1 + bfhi(o2[z][e]) * w2) * bfhi(g[z][e]); w[e] = pk2(lo, hi); }
            *(u32x4*)(ym + (size_t)tok * 1024 + 512 + lane * 8) = w; }
    }
}

#define XB_TMO      128
#define XB_XCNT(j)  (256  + 64 * (j))
#define XB_XSUB(j)  (1280 + 64 * (j))
#define XB_XGEN(j)  (2304 + 64 * (j))
#define XB_TOP      3328
#define XB_TOPGEN   3392
#define XCD_BAR_WORDS 3456
#define XB_SPIN_CAP (1u << 18)

__device__ __forceinline__ unsigned xb_ld(unsigned* p)              { return __hip_atomic_load(p, __ATOMIC_RELAXED, __HIP_MEMORY_SCOPE_AGENT); }
__device__ __forceinline__ unsigned xb_add(unsigned* p, unsigned v) { return __hip_atomic_fetch_add(p, v, __ATOMIC_RELAXED, __HIP_MEMORY_SCOPE_AGENT); }
__device__ __forceinline__ unsigned xb_xcc_id() { return (unsigned)__builtin_amdgcn_s_getreg((3 << 11) | 20) & 0xFu; }
#define XB_SPIN(cond, bar) do { unsigned _sp = 0; while (cond) { __builtin_amdgcn_s_sleep(1); \
    if ((++_sp & 255u) == 0u) { if (xb_ld(&(bar)[XB_TMO])) break; if (_sp > XB_SPIN_CAP) { atomicAdd(&(bar)[XB_TMO], 1u); break; } } } } while (0)

struct XcdBarrier {
    unsigned* bar; unsigned x;
    volatile LAS unsigned* st;
};

__device__ __forceinline__ XcdBarrier xcd_barrier_post(unsigned* bar, volatile LAS unsigned* st) {
    XcdBarrier b; b.bar = bar; b.x = xb_xcc_id(); b.st = st;
    if (threadIdx.x == 0) (void)xb_add(&bar[XB_XCNT(b.x)], 1u);
    return b;
}
__device__ __forceinline__ void xcd_barrier_complete(unsigned* bar, unsigned x, unsigned& nloc, unsigned& nx) {
    const unsigned G = gridDim.x * gridDim.y * gridDim.z;
    unsigned sum, cnt, mine, sp = 0u;
    for (;;) {
        sum = 0u; cnt = 0u; mine = 0u;
#pragma unroll
        for (unsigned j = 0; j < 16; ++j) { const unsigned c = xb_ld(&bar[XB_XCNT(j)]); sum += c; cnt += (c > 0u) ? 1u : 0u; mine = (j == x) ? c : mine; }
        if (sum == G) break;
        __builtin_amdgcn_s_sleep(1);
        if ((++sp & 255u) == 0u) { if (xb_ld(&bar[XB_TMO])) break; if (sp > XB_SPIN_CAP) { atomicAdd(&bar[XB_TMO], 1u); break; } }
    }
    nloc = mine > 0u ? mine : 1u; nx = cnt > 0u ? cnt : 1u;
}

__device__ __forceinline__ void xcd_barrier(const XcdBarrier& b) {
    asm volatile("s_waitcnt vmcnt(0)" ::: "memory");
    __syncthreads();
    if (threadIdx.x == 0) {
        unsigned* bar = b.bar;
        __builtin_amdgcn_s_waitcnt(0);
        unsigned nloc = b.st[0], nx = b.st[1];
        if (nloc == 0u) { xcd_barrier_complete(bar, b.x, nloc, nx); b.st[0] = nloc; b.st[1] = nx; }
        const unsigned old = xb_add(&bar[XB_XSUB(b.x)], 1u);
        const unsigned gen = old / nloc;
        if (old + 1u == (gen + 1u) * nloc) {
            __builtin_amdgcn_fence(__ATOMIC_RELEASE, "agent");
            asm volatile("s_waitcnt vmcnt(0)" ::: "memory");
            const unsigned og = xb_add(&bar[XB_TOP], 1u);
            const unsigned tg = og / nx;
            if (og + 1u == (tg + 1u) * nx) xb_add(&bar[XB_TOPGEN], 1u);
            else XB_SPIN(xb_ld(&bar[XB_TOPGEN]) == tg, bar);
            __builtin_amdgcn_fence(__ATOMIC_ACQUIRE, "agent");
            xb_add(&bar[XB_XGEN(b.x)], 1u);
            asm volatile("s_waitcnt vmcnt(0)" ::: "memory");
        } else {
            XB_SPIN(xb_ld(&bar[XB_XGEN(b.x)]) == gen, bar);
            __builtin_amdgcn_fence(__ATOMIC_ACQUIRE, "agent");
            asm volatile("s_waitcnt vmcnt(0)" ::: "memory");
        }
    }
    __syncthreads();
}

__global__ void __launch_bounds__(512, 2) mega_fwd(Args a) {
    extern __shared__ __attribute__((aligned(16))) unsigned char lds_raw[];
    LAS unsigned char* lds = (LAS unsigned char*)lds_raw;
    cg::grid_group grid = cg::this_grid();
    const int tid = threadIdx.x, lane = tid & 63, wave = __builtin_amdgcn_readfirstlane(tid >> 6);
    volatile LAS unsigned* bst = (volatile LAS unsigned*)(lds + 161792);
    if (tid < 2) bst[tid] = 0u;
    __syncthreads();
    XcdBarrier bar = xcd_barrier_post((unsigned*)(a.ws + WS_BAR), bst);
    if (a.ws == nullptr) grid.sync();
#ifndef REP0
#define REP0 1
#define REP1 1
#define REPD1 1
#define REPD2 1
#define REPM 1
#define REP4 1
#endif
    for (int rep = 0; rep < REP0; ++rep) phase0(a, lds, tid, lane, wave);
    xcd_barrier(bar);
    {
        pg8::Gemm g{(const pg8::bf16_t*)(a.ws + WS_XB), (const pg8::bf16_t*)(a.ws + WS_WT), MTOK, NIN, DM}; pg8::StaticOrder S; S.init(MTOK, NIN, gridDim.x, (int)blockIdx.x, REP1);
        Epi1 E{(bf16_t*)(a.ws + WS_Z), (bf16_t*)(a.ws + WS_G), (bf16_t*)(a.ws + WS_Q), (bf16_t*)(a.ws + WS_K), (bf16_t*)(a.ws + WS_V)};
        pg8::gemm_phase<Epi1, pg8::StaticOrder, true, true>(lds, g, S, E);
    }
    xcd_barrier(bar);
    attn_phase<false>(a, lds, tid, lane, wave);
    for (int rep = 0; rep < REPD1; ++rep) dft1_phase(a, lds, tid, lane, wave);
    xcd_barrier(bar);
    for (int rep = 0; rep < REPD2; ++rep) dft2_phase(a, lds, tid, lane, wave);
    attn_phase<true>(a, lds, tid, lane, wave);
    xcd_barrier(bar);
    {
        pg8::Gemm g{(const pg8::bf16_t*)(a.ws + WS_Z), (const pg8::bf16_t*)(a.ws + WS_WOT), MTOK, DM, DM}; pg8::StaticOrder S; S.init(MTOK, DM, gridDim.x, (int)blockIdx.x, REP4);
        Epi2 E{a.x, a.out};
        pg8::gemm_phase<Epi2, pg8::StaticOrder, true, true>(lds, g, S, E);
    }
}

extern "C" void kernel_launch(void* const* d_in, const int* in_sizes, int n_in, void* d_out, int out_size, void* d_ws, size_t ws_size, hipStream_t stream) {
    static int grid = 0;
    if (grid == 0) {
        if (n_in != 7 || in_sizes[0] != MTOK * DM || out_size != MTOK * DM || ws_size < WS_END) { fprintf(stderr, "kernel_launch: unexpected shapes / workspace (%d inputs, ws %zu)\n", n_in, ws_size); grid = -1; return; }
        int dev = 0, cus = 0, per_cu = 0;
        hipGetDevice(&dev); hipDeviceGetAttribute(&cus, hipDeviceAttributeMultiprocessorCount, dev);
        hipFuncSetAttribute((const void*)mega_fwd, hipFuncAttributeMaxDynamicSharedMemorySize, LDS_BYTES);
        hipOccupancyMaxActiveBlocksPerMultiprocessor(&per_cu, (const void*)mega_fwd, 512, LDS_BYTES);
        if (per_cu < 1) { fprintf(stderr, "kernel_launch: occupancy query says %d blocks per CU\n", per_cu); per_cu = 1; }
        grid = cus;
        (void)hipGetLastError();
    }
    if (grid < 0) return;
    Args a{};
    a.x = (const float*)d_in[0]; a.norm_w = (const float*)d_in[1]; a.w_in = (const float*)d_in[2]; a.qw = (const float*)d_in[3]; a.kw = (const float*)d_in[4];
    a.wf = (const float*)d_in[5]; a.w_out = (const float*)d_in[6]; a.out = (float*)d_out; a.ws = (unsigned char*)d_ws;
    if (hipMemsetAsync((char*)d_ws + WS_BAR, 0, 16384, stream) != hipSuccess) { fprintf(stderr, "kernel_launch: memset of the barrier words failed\n"); return; }
    void* args[] = {&a};
    hipError_t e = hipLaunchCooperativeKernel((const void*)mega_fwd, dim3(grid), dim3(512), args, LDS_BYTES, stream);
    if (e != hipSuccess) fprintf(stderr, "cooperative launch failed: %s (grid %d)\n", hipGetErrorString(e), grid);
}
```

```cpp
#include <hip/hip_runtime.h>
#include <hip/hip_cooperative_groups.h>
#include <cstdio>
#include <cstdint>
namespace cg = cooperative_groups;
namespace pg8 {
#define PG8_LAS __attribute__((address_space(3)))
typedef unsigned short bf16_t;
typedef short bf16x8 __attribute__((ext_vector_type(8)));
typedef float f32x4 __attribute__((ext_vector_type(4)));
typedef unsigned u32x4 __attribute__((ext_vector_type(4)));
constexpr int BM = 256, BK = 64, HALF = 128, HTB = HALF * BK * 2  , STAGE_BYTES = 8 * HTB, NXCD = 8, WGM = 8;

__host__ __device__ __forceinline__ int lds_byte(int r, int c) { const int st = (r >> 4) * 2 + (c >> 5), rr = r & 15, cc = c & 31, ob = rr * 64 + cc * 2; return st * 1024 + (ob ^ (((ob >> 9) & 1) << 5)); }
__host__ __device__ __forceinline__ void stage_rc(int b, int& R, int& C) { const int st = b / 1024, sb = b % 1024, swz = sb ^ (((sb >> 9) & 1) << 5); R = (st >> 1) * 16 + swz / 64; C = (st & 1) * 32 + (swz % 64) / 2; }
__host__ __device__ __forceinline__ int perm32(int rho) { const int n = rho >> 4, i = rho & 15; return 8 * (i >> 2) + 4 * n + (i & 3); }

struct Unit { int pm, pn; };
struct Gemm { const bf16_t* A; const bf16_t* Bt; int M, N, K; };

struct StaticOrder {
    int nM, nN, nwg, G, c, rep;
    __host__ __device__ void init(int M, int N, int G_, int c_, int rep_ = 1) { nM = M / BM; nN = N / BM; nwg = nM * nN; G = G_; c = c_; rep = rep_; }
    __host__ __device__ bool next(int i, Unit& u) const {
        const int per = (nwg + G - 1) / G; if (i >= per * rep) return false; const long L = (long)(i % per) * G + c; if (L >= nwg) return false;
        int wgid = (int)L; { const int q = nwg / NXCD, r = nwg % NXCD, xcd = wgid % NXCD, off = wgid / NXCD; wgid = (xcd < r ? xcd * (q + 1) : r * (q + 1) + (xcd - r) * q) + off; }
        const int nig = WGM * nN, gid = wgid / nig, fm = gid * WGM, gsz = (nM - fm) < WGM ? (nM - fm) : WGM;
        u.pm = fm + ((wgid % nig) % gsz); u.pn = (wgid % nig) / gsz; return true;
    }
    __device__ __forceinline__ void a_ready(const Unit&) const {}
    __device__ __forceinline__ void done(const Unit&) const {}
};

__device__ __forceinline__ unsigned cvt_pk_bf16(float lo, float hi) { unsigned r; asm volatile("v_cvt_pk_bf16_f32 %0, %1, %2" : "=v"(r) : "v"(lo), "v"(hi)); return r; }
typedef float f32x2 __attribute__((ext_vector_type(2)));
template <class Epi, class Sched, bool ALIGN_EPI = false, bool SP2 = false>
__device__ __forceinline__ void gemm_phase(PG8_LAS unsigned char* lds, const Gemm g, const Sched& S, const Epi& E) {
    const int tid = threadIdx.x, wid = __builtin_amdgcn_readfirstlane(tid >> 6), lane = tid & 63, wr = wid >> 2, wc = wid & 3, fr = lane & 15, fq = lane >> 4;
    const int K = g.K, nt = K / BK;
    unsigned voffA[2], voffB[2];
#pragma unroll
    for (int i = 0; i < 2; ++i) { int R, C; stage_rc(tid * 16 + i * 8192, R, C); const int Rb = Epi::PERM2 ? (64 * (R >> 5) + perm32(R & 31)) : (Epi::PERM ? ((R & ~31) + perm32(R & 31)) : R);
        voffA[i] = (unsigned)(R * K + C) * 2u; voffB[i] = (unsigned)(Rb * K + C) * 2u; }
    const size_t kstep = (size_t)(BK * 2);
    const size_t hstep = (size_t)HALF * K * 2;
    const size_t hstepB = Epi::PERM2 ? (size_t)32 * K * 2 : hstep;
    const size_t tstep = 2 * hstep;
    const unsigned ldsw = (unsigned)wid * 1024u;
    const int aoff = lds_byte(wr * 64 + fr, fq * 8), boff = lds_byte(wc * 32 + fr, fq * 8);
#define PG8_SA(b, h) (((b) * 2 + (h)) * HTB)
#define PG8_SB(b, h) ((4 + (b) * 2 + (h)) * HTB)
#define PG8_STAGE(bufoff, gbase, voff) do { _Pragma("unroll") for (int _i = 0; _i < 2; ++_i) \
        __builtin_amdgcn_global_load_lds((const unsigned*)((const char*)(gbase) + (voff)[_i]), (PG8_LAS unsigned*)(lds + (bufoff) + ldsw + _i * 8192), 16, 0, 0); } while (0)
#define PG8_LDA(dst, b, h) do { _Pragma("unroll") for (int m = 0; m < 4; ++m) _Pragma("unroll") for (int k = 0; k < 2; ++k) dst[m][k] = *(const PG8_LAS bf16x8*)(lds + PG8_SA(b, h) + aoff + m * 2048 + k * 1024); } while (0)
#define PG8_LDB(dst, b, h) do { _Pragma("unroll") for (int n = 0; n < 2; ++n) _Pragma("unroll") for (int k = 0; k < 2; ++k) dst[n][k] = *(const PG8_LAS bf16x8*)(lds + PG8_SB(b, h) + boff + n * 2048 + k * 1024); } while (0)
#define PG8_MMA(ai, bj, At, Bt) do { __builtin_amdgcn_s_setprio(1); _Pragma("unroll") for (int m = 0; m < 4; ++m) _Pragma("unroll") for (int n = 0; n < 2; ++n) _Pragma("unroll") for (int k = 0; k < 2; ++k) \
        acc[ai][bj][m][n] = __builtin_amdgcn_mfma_f32_16x16x32_bf16(Bt[n][k], At[m][k], acc[ai][bj][m][n], 0, 0, 0); __builtin_amdgcn_s_setprio(0); } while (0)
#define PG8_WAIT_V(n) asm volatile("s_waitcnt vmcnt(" #n ")" ::: "memory")
#define PG8_WAIT_L(n) asm volatile("s_waitcnt lgkmcnt(" #n ")" ::: "memory")
#define PG8_BAR __builtin_amdgcn_s_barrier()
#define PG8_SCHED __builtin_amdgcn_sched_barrier(0)
    Unit cur, nxt; int ui = 0;
    if (!S.next(0, cur)) return;
    f32x4 acc[2][2][4][2];
#pragma unroll
    for (int a = 0; a < 2; ++a)
#pragma unroll
        for (int b = 0; b < 2; ++b)
#pragma unroll
            for (int m = 0; m < 4; ++m)
#pragma unroll
                for (int n = 0; n < 2; ++n) acc[a][b][m][n] = (f32x4){0.f, 0.f, 0.f, 0.f};
    bf16x8 At[4][2], B0[2][2], B1[2][2];
    const char* cA = (const char*)g.A + (size_t)cur.pm * tstep; const char* cB = (const char*)g.Bt + (size_t)cur.pn * tstep;
    S.a_ready(cur);
    if constexpr (SP2) {
        PG8_STAGE(PG8_SB(0, 0), cB, voffB); PG8_STAGE(PG8_SB(0, 1), cB + hstepB, voffB); PG8_STAGE(PG8_SA(0, 0), cA, voffA); PG8_STAGE(PG8_SA(0, 1), cA + hstep, voffA);
        if (wr == 1) PG8_BAR;
        PG8_WAIT_V(2); PG8_BAR;
        PG8_STAGE(PG8_SB(1, 0), cB + kstep, voffB); PG8_STAGE(PG8_SA(1, 0), cA + kstep, voffA); PG8_STAGE(PG8_SB(1, 1), cB + hstepB + kstep, voffB);
        PG8_WAIT_V(6); PG8_BAR;
    } else {
        PG8_STAGE(PG8_SB(0, 0), cB, voffB); PG8_STAGE(PG8_SA(0, 0), cA, voffA); PG8_STAGE(PG8_SB(0, 1), cB + hstepB, voffB); PG8_STAGE(PG8_SA(0, 1), cA + hstep, voffA);
        if (wr == 1) PG8_BAR;
        PG8_WAIT_V(4); PG8_BAR;
        PG8_STAGE(PG8_SB(1, 0), cB + kstep, voffB); PG8_STAGE(PG8_SA(1, 0), cA + kstep, voffA); PG8_STAGE(PG8_SB(1, 1), cB + hstepB + kstep, voffB);
        PG8_WAIT_V(6); PG8_BAR;
    }
    for (;;) {
        const bool has_next = S.next(ui + 1, nxt);
        const char* nA = has_next ? (const char*)g.A + (size_t)nxt.pm * tstep : cA; const char* nB = has_next ? (const char*)g.Bt + (size_t)nxt.pn * tstep : cB;
        for (int t = 0; t < nt; t += 2) {
            const bool last = (t == nt - 2);
            const char* a1 = cA + (size_t)(t + 1) * kstep;
            const char* a2 = last ? nA : cA + (size_t)(t + 2) * kstep; const char* b2 = last ? nB : cB + (size_t)(t + 2) * kstep;
            const char* a3 = a2 + kstep; const char* b3 = b2 + kstep;
            if (last && has_next) S.a_ready(nxt);
            if constexpr (SP2) {
            PG8_LDB(B0, 0, 0); PG8_LDB(B1, 0, 1); PG8_SCHED; PG8_LDA(At, 0, 0); PG8_STAGE(PG8_SA(1, 1), a1 + hstep, voffA);
            PG8_WAIT_V(8); PG8_WAIT_L(0); PG8_BAR; PG8_MMA(0, 0, At, B0); PG8_MMA(0, 1, At, B1); PG8_BAR; PG8_SCHED;
            PG8_LDA(At, 0, 1); PG8_STAGE(PG8_SB(0, 0), b2, voffB); PG8_STAGE(PG8_SB(0, 1), b2 + hstepB, voffB); PG8_STAGE(PG8_SA(0, 0), a2, voffA);
            PG8_WAIT_V(8); PG8_WAIT_L(0); PG8_BAR; PG8_MMA(1, 0, At, B0); PG8_MMA(1, 1, At, B1); PG8_BAR; PG8_SCHED;
            PG8_LDB(B0, 1, 0); PG8_LDB(B1, 1, 1); PG8_SCHED; PG8_LDA(At, 1, 0); PG8_STAGE(PG8_SA(0, 1), a2 + hstep, voffA);
            PG8_WAIT_V(8); PG8_WAIT_L(0); PG8_BAR; PG8_MMA(0, 0, At, B0); PG8_MMA(0, 1, At, B1); PG8_BAR; PG8_SCHED;
            PG8_LDA(At, 1, 1); PG8_STAGE(PG8_SB(1, 0), b3, voffB); PG8_STAGE(PG8_SB(1, 1), b3 + hstepB, voffB); PG8_STAGE(PG8_SA(1, 0), a3, voffA);
            PG8_WAIT_V(8); PG8_WAIT_L(0); PG8_BAR; PG8_MMA(1, 0, At, B0); PG8_MMA(1, 1, At, B1); PG8_BAR; PG8_SCHED;
            } else {
            PG8_LDB(B0, 0, 0); PG8_SCHED; PG8_LDA(At, 0, 0); PG8_STAGE(PG8_SA(1, 1), a1 + hstep, voffA);
            PG8_WAIT_L(8); PG8_BAR; PG8_WAIT_L(0); PG8_MMA(0, 0, At, B0); PG8_BAR; PG8_SCHED;
            PG8_LDB(B1, 0, 1); PG8_STAGE(PG8_SB(0, 0), b2, voffB);
            PG8_BAR; PG8_WAIT_L(0); PG8_MMA(0, 1, At, B1); PG8_BAR;
            PG8_LDA(At, 0, 1); PG8_STAGE(PG8_SA(0, 0), a2, voffA);
            PG8_BAR; PG8_WAIT_L(0); PG8_MMA(1, 0, At, B0); PG8_BAR; PG8_SCHED;
            PG8_STAGE(PG8_SB(0, 1), b2 + hstepB, voffB);
            PG8_WAIT_V(6); PG8_BAR; PG8_MMA(1, 1, At, B1); PG8_BAR;
            PG8_LDB(B0, 1, 0); PG8_SCHED; PG8_LDA(At, 1, 0); PG8_STAGE(PG8_SA(0, 1), a2 + hstep, voffA);
            PG8_WAIT_L(8); PG8_BAR; PG8_WAIT_L(0); PG8_MMA(0, 0, At, B0); PG8_BAR; PG8_SCHED;
            PG8_LDB(B1, 1, 1); PG8_STAGE(PG8_SB(1, 0), b3, voffB);
            PG8_BAR; PG8_WAIT_L(0); PG8_MMA(0, 1, At, B1); PG8_BAR;
            PG8_LDA(At, 1, 1); PG8_STAGE(PG8_SA(1, 0), a3, voffA);
            PG8_BAR; PG8_WAIT_L(0); PG8_MMA(1, 0, At, B0); PG8_BAR; PG8_SCHED;
            PG8_STAGE(PG8_SB(1, 1), b3 + hstepB, voffB);
            PG8_WAIT_V(6); PG8_BAR; PG8_MMA(1, 1, At, B1); PG8_BAR;
            }
        }
        if constexpr (ALIGN_EPI) { if (wr == 0) PG8_BAR; }
        if constexpr (!Epi::AFTER_DRAIN) { E(acc, cur, wr, wc, fr, fq); S.done(cur); }
        if (!has_next) break;
#pragma unroll
        for (int a = 0; a < 2; ++a)
#pragma unroll
            for (int b = 0; b < 2; ++b)
#pragma unroll
                for (int m = 0; m < 4; ++m)
#pragma unroll
                    for (int n = 0; n < 2; ++n) acc[a][b][m][n] = (f32x4){0.f, 0.f, 0.f, 0.f};
        cur = nxt; cA = nA; cB = nB; ++ui;
        if constexpr (ALIGN_EPI) { if (wr == 1) PG8_BAR; }
    }
    PG8_WAIT_V(0);
    if constexpr (!ALIGN_EPI) { if (wr == 0) PG8_BAR; }
    PG8_BAR;
    if constexpr (Epi::AFTER_DRAIN) { E.fused(acc, cur, wr, wc, fr, fq, lds, wid, lane); S.done(cur); }
#undef PG8_SA
#undef PG8_SB
#undef PG8_STAGE
#undef PG8_LDA
#undef PG8_LDB
#undef PG8_MMA
#undef PG8_WAIT_V
#undef PG8_WAIT_L
#undef PG8_BAR
#undef PG8_SCHED
}
}
#define LAS __attribute__((address_space(3)))
typedef unsigned short bf16_t;
typedef short bf16x8 __attribute__((ext_vector_type(8)));
typedef short s16x4 __attribute__((ext_vector_type(4)));
typedef short v4i16_t __attribute__((ext_vector_type(4)));
typedef float f32x4 __attribute__((ext_vector_type(4)));
typedef float f32x16 __attribute__((ext_vector_type(16)));
typedef unsigned u32x4 __attribute__((ext_vector_type(4)));
typedef unsigned u32x2 __attribute__((ext_vector_type(2)));

constexpr int SEQ = 8192, DM = 1024, MTOK = 65536, NIN = 6144, QKVW = 1536;
constexpr size_t WS_WT = 0, WS_WOT = 13631488, WS_RS = 15728640, WS_LSE = 15990784, WS_BAR = 23068672, WS_GMT = 24117248, WS_XB = 33554432, WS_Z = 167772160, WS_G = 301989888,
                 WS_Q = 436207616, WS_K = 637534208, WS_V = 838860800, WS_END = 1040187392;
constexpr int LDS_BYTES = 162944;
constexpr float LOG2E = 1.4426950408889634f;

__device__ __forceinline__ unsigned f2bf(float f) { unsigned u = __builtin_bit_cast(unsigned, f); return (u + 0x7fffu + ((u >> 16) & 1u)) >> 16; }
typedef float f32x2_t __attribute__((ext_vector_type(2))); typedef __bf16 bf16x2_t __attribute__((ext_vector_type(2)));
__device__ __forceinline__ unsigned pk2(float lo, float hi) { f32x2_t v = {lo, hi}; bf16x2_t b = __builtin_convertvector(v, bf16x2_t); return __builtin_bit_cast(unsigned, b); }
__device__ __forceinline__ float bflo(unsigned w) { return __builtin_bit_cast(float, w << 16); }
__device__ __forceinline__ float bfhi(unsigned w) { return __builtin_bit_cast(float, w & 0xffff0000u); }
__device__ __forceinline__ int crow(int r, int hi) { return (r & 3) + 8 * (r >> 2) + 4 * hi; }
__device__ __forceinline__ float wave_sum(float v) {
#pragma unroll
    for (int o = 1; o < 64; o <<= 1) v += __shfl_xor(v, o);
    return v;
}
__device__ __forceinline__ s16x4 trrd(LAS const unsigned char* p) { return __builtin_bit_cast(s16x4, __builtin_amdgcn_ds_read_tr16_b64_v4i16((LAS v4i16_t*)p)); }
__device__ __forceinline__ float silu_f(float v) { return v * __builtin_amdgcn_rcpf(1.f + __builtin_amdgcn_exp2f(-v * LOG2E)); }
#define LDS_WAIT() asm volatile("s_waitcnt lgkmcnt(0)" ::: "memory")
template <int CTRL> __device__ __forceinline__ unsigned dpp_mov(unsigned v) { return (unsigned)__builtin_amdgcn_update_dpp(0, (int)v, CTRL, 0xF, 0xF, true); }
template <int CTRL> __device__ __forceinline__ float dpp_movf(float v) { return __builtin_bit_cast(float, dpp_mov<CTRL>(__builtin_bit_cast(unsigned, v))); }

struct Args { const float *x, *norm_w, *w_in, *qw, *kw, *wf, *w_out; float* out; unsigned char* ws; };

__device__ __forceinline__ void transpose_item(const float* W, int ldw, int ncol0, bf16_t* WT, int row_off, const float* kscale, LAS float* scr, int kb, int nb, int lane) {
    const int k0 = 64 * kb, n0 = 32 * nb;
#pragma unroll 8
    for (int i = 0; i < 32; ++i) { const int kk = 2 * i + (lane >> 5); float v = W[(size_t)(k0 + kk) * ldw + ncol0 + n0 + (lane & 31)]; if (kscale) v *= kscale[k0 + kk]; scr[kk * 33 + (lane & 31)] = v; }
    LDS_WAIT();
    const int c = lane & 7;
#pragma unroll
    for (int j = 0; j < 4; ++j) { const int n = (lane >> 3) + 8 * j; const LAS float* s = scr + (8 * c) * 33 + n;
        u32x4 o; o.x = pk2(s[0 * 33], s[1 * 33]); o.y = pk2(s[2 * 33], s[3 * 33]); o.z = pk2(s[4 * 33], s[5 * 33]); o.w = pk2(s[6 * 33], s[7 * 33]);
        *(u32x4*)(WT + (size_t)(row_off + n0 + n) * 1024 + k0 + 8 * c) = o; }
    LDS_WAIT();
}
__device__ __forceinline__ void gmt_unit(const Args& a, LAS unsigned char* lds, int unit, int tid) {
    bf16_t* GmT = (bf16_t*)(a.ws + WS_GMT);
    LAS float* tab = (LAS float*)lds;
    if (tid < 64) { float sn, cs; sincospif((float)tid * (1.f / 32.f), &sn, &cs); tab[2 * tid] = cs; tab[2 * tid + 1] = sn; }
    __syncthreads();
    const int g = unit >> 2, d = 16 * (unit & 3) + (tid >> 5), c32 = tid & 31;
    float acc[4] = {0.f, 0.f, 0.f, 0.f};
    for (int l = 0; l < 64; ++l) { const float w = a.wf[(size_t)(g * 64 + l) * 64 + d];
#pragma unroll
        for (int e = 0; e < 4; ++e) { const int cc = c32 * 4 + e, c = cc & 63, idx = (l * c) & 63; acc[e] += w * (cc < 64 ? tab[2 * idx] : -tab[2 * idx + 1]); } }
#pragma unroll
    for (int e = 0; e < 4; ++e) GmT[(size_t)(g * 64 + d) * 128 + c32 * 4 + e] = (bf16_t)f2bf(acc[e] * 0.125f);
    __syncthreads();
}
__device__ __forceinline__ void phase0(const Args& a, LAS unsigned char* lds, int tid, int lane, int wave) {
    bf16_t* Wt = (bf16_t*)(a.ws + WS_WT); bf16_t* WoT = (bf16_t*)(a.ws + WS_WOT); bf16_t* xb = (bf16_t*)(a.ws + WS_XB);
    const int G = gridDim.x, bx = blockIdx.x;
    for (int u = bx; u < 32; u += G) gmt_unit(a, lds, u, tid);
    if (bx == G - 1 && wave < 3) {
        for (int hd = wave * 8; hd < wave * 8 + 8; ++hd) {
            float gqm = fabsf(a.qw[hd * 64 + lane]), gkm = fabsf(a.kw[hd * 64 + lane]);
#pragma unroll
            for (int o = 1; o < 64; o <<= 1) { gqm = fmaxf(gqm, __shfl_xor(gqm, o)); gkm = fmaxf(gkm, __shfl_xor(gkm, o)); }
            if (lane == 0) ((float*)(a.ws + WS_RS))[hd] = 8.08f * LOG2E * gqm * gkm;
        }
    }
    LAS float* scr = (LAS float*)(lds + 32768 + wave * 8448);
    const int gw = bx * 8 + wave, NGW = G * 8;
    constexpr int I_IN = 16 * 192, I_OUT = 16 * 32;
    for (int it = gw; it < I_IN + I_OUT; it += NGW) {
        if (it < I_IN) transpose_item(a.w_in, 6144, 0, Wt, 0, a.norm_w, scr, it / 192, it % 192, lane);
        else { const int r = it - I_IN; transpose_item(a.w_out, 1024, 0, WoT, 0, nullptr, scr, r / 32, r % 32, lane); }
    }
    for (int row = gw; row < MTOK; row += 2 * NGW) {
        const int row2 = row + NGW; const bool has2 = row2 < MTOK;
        const f32x4* xr = (const f32x4*)(a.x + (size_t)row * DM) + lane; const f32x4* xr2 = (const f32x4*)(a.x + (size_t)(has2 ? row2 : row) * DM) + lane;
        f32x4 v[4], v2[4]; float s = 0.f, s2 = 0.f;
#pragma unroll
        for (int j = 0; j < 4; ++j) { v[j] = __builtin_nontemporal_load(xr + 64 * j); v2[j] = __builtin_nontemporal_load(xr2 + 64 * j); }
#pragma unroll
        for (int j = 0; j < 4; ++j) { s += (v[j].x * v[j].x + v[j].y * v[j].y) + (v[j].z * v[j].z + v[j].w * v[j].w); s2 += (v2[j].x * v2[j].x + v2[j].y * v2[j].y) + (v2[j].z * v2[j].z + v2[j].w * v2[j].w); }
        s = wave_sum(s); s2 = wave_sum(s2);
        const float r = __builtin_amdgcn_rsqf(s * (1.f / DM) + 1e-6f), r2 = __builtin_amdgcn_rsqf(s2 * (1.f / DM) + 1e-6f);
        u32x2* o = (u32x2*)(xb + (size_t)row * DM) + lane;
#pragma unroll
        for (int j = 0; j < 4; ++j) { u32x2 w; w.x = pk2(v[j].x * r, v[j].y * r); w.y = pk2(v[j].z * r, v[j].w * r); o[64 * j] = w; }
        if (has2) { u32x2* o2 = (u32x2*)(xb + (size_t)row2 * DM) + lane;
#pragma unroll
            for (int j = 0; j < 4; ++j) { u32x2 w; w.x = pk2(v2[j].x * r2, v2[j].y * r2); w.y = pk2(v2[j].z * r2, v2[j].w * r2); o2[64 * j] = w; } }
    }
}

struct Epi1 {
    static constexpr bool PERM = true, PERM2 = true, AFTER_DRAIN = false;
    bf16_t *Z, *G, *Q, *Kb, *V;
    __device__ __forceinline__ void operator()(const pg8::f32x4 (&acc)[2][2][4][2], const pg8::Unit& u, int wr, int wc, int fr, int fq) const {
        const int pn = u.pn; const int hi8 = (fr >> 3) & 1, fr7 = fr & 7; const int rbase = u.pm * 256 + wr * 64 + fr7;
        const bool qkv = (pn >= 4 && pn < 22);
        const bool act = !qkv && pn >= 2;
        const int ld = pn < 2 ? 512 : 1024;
        bf16_t* base; int dsh = 0; size_t rowstride_tok = 0; int ecol;
        if (qkv) { const int which = (pn - 4) / 6, ct = (pn - 4) % 6; dsh = 2 * (ct >> 1);
            base = Q + (size_t)which * ((WS_K - WS_Q) / 2) + (size_t)(ct * 4 + wc) * SEQ * 64; ecol = 32 * hi8 + 8 * fq; }
        else { const int c0 = pn < 2 ? pn * 256 : (pn < 4 ? (pn - 2) * 256 : 512 + (pn - 22) * 256); base = (pn < 2 ? Z : G) + c0 + wc * 64; ecol = 32 * hi8 + 8 * fq; }
        const int dmask = (1 << dsh) - 1, Lc = SEQ >> dsh;
#pragma unroll
        for (int ai = 0; ai < 2; ++ai)
#pragma unroll
            for (int m = 0; m < 4; ++m) {
                pg8::f32x4 a0 = acc[ai][0][m][0], a1 = acc[ai][0][m][1], b0 = acc[ai][1][m][0], b1 = acc[ai][1][m][1];
                if (act) {
#pragma unroll
                    for (int e = 0; e < 4; ++e) { a0[e] = silu_f(a0[e]); a1[e] = silu_f(a1[e]); b0[e] = silu_f(b0[e]); b1[e] = silu_f(b1[e]); } }
                u32x4 A, B; A.x = pk2(a0[0], a0[1]); A.y = pk2(a0[2], a0[3]); A.z = pk2(a1[0], a1[1]); A.w = pk2(a1[2], a1[3]);
                B.x = pk2(b0[0], b0[1]); B.y = pk2(b0[2], b0[3]); B.z = pk2(b1[0], b1[1]); B.w = pk2(b1[2], b1[3]);
                u32x4 snd, rcv;
#pragma unroll
                for (int e = 0; e < 4; ++e) { snd[e] = hi8 ? A[e] : B[e]; rcv[e] = dpp_mov<0x128>(snd[e]); }
                u32x4 d1, d2;
#pragma unroll
                for (int e = 0; e < 4; ++e) { d1[e] = hi8 ? rcv[e] : A[e]; d2[e] = hi8 ? B[e] : rcv[e]; }
                const int row1 = rbase + ai * 128 + m * 16, row2 = row1 + 8;
                if (qkv) {
                    const int bb = row1 >> 13, t1 = row1 & (SEQ - 1), t2 = row2 & (SEQ - 1);
                    const int p1 = (t1 & dmask) * Lc + (t1 >> dsh), p2 = (t2 & dmask) * Lc + (t2 >> dsh);
                    bf16_t* hb = base + (size_t)bb * 24 * SEQ * 64 + ecol;
                    *(u32x4*)(hb + (size_t)p1 * 64) = d1; *(u32x4*)(hb + (size_t)p2 * 64) = d2;
                } else {
                    *(u32x4*)(base + (size_t)row1 * ld + ecol) = d1; *(u32x4*)(base + (size_t)row2 * ld + ecol) = d2;
                }
            }
    }
};
struct Epi2 {
    static constexpr bool PERM = false, PERM2 = false, AFTER_DRAIN = false;
    const float* x; float* out;
    __device__ __forceinline__ void operator()(const pg8::f32x4 (&acc)[2][2][4][2], const pg8::Unit& u, int wr, int wc, int fr, int fq) const {
        const int row0 = u.pm * 256 + wr * 64 + fr, col0 = u.pn * 256 + wc * 32 + 4 * fq;
#pragma unroll
        for (int ai = 0; ai < 2; ++ai)
#pragma unroll
            for (int m = 0; m < 4; ++m) { const size_t off = (size_t)(row0 + ai * 128 + m * 16) * DM + col0;
#pragma unroll
                for (int bj = 0; bj < 2; ++bj)
#pragma unroll
                    for (int n = 0; n < 2; ++n) { const size_t o2 = off + bj * 128 + n * 16; *(pg8::f32x4*)(out + o2) = *(const pg8::f32x4*)(x + o2) + acc[ai][bj][m][n]; }
                if (m & 1) asm volatile("" ::: "memory"); }
    }
};

constexpr int TP = 192;
constexpr int TTP = 272;
template <int NROWS> __device__ __forceinline__ void load_tile(LAS unsigned char* lds, const bf16_t* src, size_t rstride, int tid) {
    u32x4 v[NROWS / 64];
#pragma unroll
    for (int i = 0; i < NROWS / 64; ++i) { const int ci = tid + 512 * i, row = ci >> 3, ch = ci & 7; v[i] = *(const u32x4*)(src + (size_t)row * rstride + ch * 8); }
#pragma unroll
    for (int i = 0; i < NROWS / 64; ++i) { const int ci = tid + 512 * i, row = ci >> 3, ch = ci & 7; *(LAS u32x4*)(lds + row * TP + ch * 16) = v[i]; }
}
__device__ __forceinline__ void dft1_phase(const Args& a, LAS unsigned char* lds, int tid, int lane, int wave) {
    asm volatile("" : "+v"(tid), "+v"(lane));
    const bf16_t* Z = (const bf16_t*)(a.ws + WS_Z); bf16_t* Y = (bf16_t*)(a.ws + WS_XB);
    const int h = lane >> 5, l31 = lane & 31, kb = wave & 3, nt = wave >> 2;
    bf16x8 af[8];
    { const int ri_row = l31 >> 4, k1 = 16 * kb + (l31 & 15);
#pragma unroll
      for (int ks = 0; ks < 8; ++ks) { unsigned pw[4];
#pragma unroll
        for (int jj = 0; jj < 4; ++jj) { float vv[2];
#pragma unroll
            for (int e = 0; e < 2; ++e) { const int s1 = 16 * ks + 8 * h + 2 * jj + e; const float fr = (float)((s1 * k1) & 127) * (1.f / 128.f); const float sn = __builtin_amdgcn_sinf(fr), cs = __builtin_amdgcn_cosf(fr);
                float val = ri_row == 0 ? cs : sn;
                if (ri_row == 1 && k1 == 0) val = (s1 & 1) ? -1.f : 1.f;
                vv[e] = val * 0.08838834764831845f; }
            pw[jj] = pk2(vv[0], vv[1]); }
        u32x4 t; t.x = pw[0]; t.y = pw[1]; t.z = pw[2]; t.w = pw[3]; af[ks] = __builtin_bit_cast(bf16x8, t); } }
    const int q = (lane & 15) >> 2, p = lane & 3, blk = (lane >> 4) & 1;
    LAS const unsigned char* rb = lds + (8 * h + q) * TP + 32 * blk + 8 * p + nt * 64;
    u32x4 pf[2][2];
#define DFT1_ISSUE(zz, uu) do { const int dc_ = (uu) & 7, s2_ = ((uu) >> 3) & 63, b_ = (uu) >> 9; const bf16_t* src_ = Z + ((size_t)b_ * SEQ + s2_) * 512 + dc_ * 64; \
        _Pragma("unroll") for (int i_ = 0; i_ < 2; ++i_) { const int ci_ = tid + 512 * i_; pf[zz][i_] = *(const u32x4*)(src_ + (size_t)(ci_ >> 3) * (64 * 512) + (ci_ & 7) * 8); } } while (0)
    const int G2 = 2 * (int)gridDim.x;
    { const int u0 = blockIdx.x; if (u0 < 4096) DFT1_ISSUE(0, u0); if (u0 + (int)gridDim.x < 4096) DFT1_ISSUE(1, u0 + (int)gridDim.x); }
    for (int u = blockIdx.x; u < 4096; u += G2) {
        const bool has1 = u + (int)gridDim.x < 4096;
#pragma unroll
        for (int z = 0; z < 2; ++z)
#pragma unroll
            for (int i = 0; i < 2; ++i) { const int ci = tid + 512 * i; *(LAS u32x4*)(lds + z * 24576 + (ci >> 3) * TP + (ci & 7) * 16) = pf[z][i]; }
        __syncthreads();
        { const int un = u + G2; if (un < 4096) DFT1_ISSUE(0, un); if (un + (int)gridDim.x < 4096) DFT1_ISSUE(1, un + (int)gridDim.x); }
        f32x16 acc[2]; acc[0] = f32x16{}; acc[1] = f32x16{};
#pragma unroll
        for (int ks = 0; ks < 8; ++ks)
#pragma unroll
            for (int z = 0; z < 2; ++z) { const s16x4 lo = trrd(rb + z * 24576 + ks * 16 * TP), hi = trrd(rb + z * 24576 + ks * 16 * TP + 4 * TP);
                const bf16x8 bfr = __builtin_shufflevector(lo, hi, 0, 1, 2, 3, 4, 5, 6, 7);
                acc[z] = __builtin_amdgcn_mfma_f32_32x32x16_bf16(af[ks], bfr, acc[z], 0, 0, 0); }
#pragma unroll
        for (int z = 0; z < 2; ++z) { const int uz = u + z * (int)gridDim.x, s2 = (uz >> 3) & 63;
            LAS bf16_t* yt = (LAS bf16_t*)(lds + 49152 + z * 16640);
#pragma unroll
            for (int i = 0; i < 8; ++i) { const int k1 = 16 * kb + crow(i, h); const float re = acc[z][i], im = acc[z][i + 8]; const int col = 32 * nt + l31;
                if (k1 != 0) { const float fr = (float)(s2 * k1) * (1.f / 8192.f); const float sn = __builtin_amdgcn_sinf(fr), cs = __builtin_amdgcn_cosf(fr);
                    yt[(2 * k1) * 64 + col] = (bf16_t)f2bf(cs * re - sn * im); yt[(2 * k1 + 1) * 64 + col] = (bf16_t)f2bf(sn * re + cs * im); }
                else { const float fr = (float)s2 * (1.f / 128.f); const float sn = __builtin_amdgcn_sinf(fr), cs = __builtin_amdgcn_cosf(fr);
                    yt[col] = (bf16_t)f2bf(re); yt[64 + col] = (bf16_t)0; yt[128 * 64 + col] = (bf16_t)f2bf(cs * im); yt[129 * 64 + col] = (bf16_t)f2bf(sn * im); } } }
        __syncthreads();
#pragma unroll
        for (int z = 0; z < 2; ++z) { if (z == 1 && !has1) break;
            const int uz = u + z * (int)gridDim.x, dc = uz & 7, s2 = (uz >> 3) & 63, b = uz >> 9;
            LAS const bf16_t* yt = (LAS const bf16_t*)(lds + 49152 + z * 16640);
#pragma unroll
            for (int zz = 0; zz < 3; ++zz) { const int ci = tid + 512 * zz; if (ci < 130 * 8) { const int row = ci >> 3, ch = ci & 7, k1 = row < 128 ? (row >> 1) : 64, ri = row < 128 ? (row & 1) : (row - 128);
                *(u32x4*)(Y + ((size_t)((b * 128 + k1) * 2 + ri) * 64 + s2) * 512 + dc * 64 + ch * 8) = *(LAS const u32x4*)(yt + row * 64 + ch * 8); } } }
        __syncthreads();
    }
}
__device__ __forceinline__ void dft2_phase(const Args& a, LAS unsigned char* lds, int tid, int lane, int wave) {
    asm volatile("" : "+v"(tid), "+v"(lane));
    const bf16_t* Y = (const bf16_t*)(a.ws + WS_XB); const bf16_t* Gb = (const bf16_t*)(a.ws + WS_G); bf16_t* ym = (bf16_t*)(a.ws + WS_Z); const bf16_t* GmT = (const bf16_t*)(a.ws + WS_GMT);
    const int h = lane >> 5, l31 = lane & 31, ksub = wave >> 2, mh = (wave >> 1) & 1, nt = wave & 1;
    bf16x8 af[2][8];
#pragma unroll
    for (int z = 0; z < 2; ++z) { const int m = 64 * mh + 32 * z + l31, k2 = m & 63, imrow = m >> 6;
#pragma unroll
      for (int ks = 0; ks < 8; ++ks) { unsigned pw[4];
#pragma unroll
        for (int jj = 0; jj < 4; ++jj) { float vv[2];
#pragma unroll
            for (int e = 0; e < 2; ++e) { const int kk = 16 * ks + 8 * h + 2 * jj + e, ri = kk >> 6, s2 = kk & 63; const float fr = (float)((s2 * k2) & 63) * (1.f / 64.f); const float sn = __builtin_amdgcn_sinf(fr), cs = __builtin_amdgcn_cosf(fr);
                vv[e] = (imrow == 0 ? (ri == 0 ? cs : -sn) : (ri == 0 ? sn : cs)) * 0.125f; }
            pw[jj] = pk2(vv[0], vv[1]); }
        u32x4 t; t.x = pw[0]; t.y = pw[1]; t.z = pw[2]; t.w = pw[3]; af[z][ks] = __builtin_bit_cast(bf16x8, t); } }
    const int q = (lane & 15) >> 2, p = lane & 3, blk = (lane >> 4) & 1;
    LAS const unsigned char* rb = lds + (ksub * 128 + 8 * h + q) * TP + 32 * blk + 8 * p + nt * 64;
    LAS unsigned char* tt = lds + 49152;
    LAS float* ot = (LAS float*)(lds + 83968);
    const int mt2 = wave >> 1, nt2 = wave & 1;
    u32x4 ld[4];
#define DFT2_ISSUE(uu) do { const int dc_ = (uu) & 7, k1p_ = ((uu) >> 3) & 63, b_ = (uu) >> 9; \
        if (k1p_ == 0) { _Pragma("unroll") for (int z_ = 0; z_ < 2; ++z_) { const int ci_ = tid + 512 * z_; const size_t o_ = (size_t)(ci_ >> 3) * 512 + dc_ * 64 + (ci_ & 7) * 8; \
                ld[z_] = __builtin_nontemporal_load((const u32x4*)(Y + ((size_t)(b_ * 128) * 128) * 512 + o_)); ld[2 + z_] = __builtin_nontemporal_load((const u32x4*)(Y + ((size_t)(b_ * 128 + 64) * 128) * 512 + o_)); } } \
        else { const bf16_t* src_ = Y + ((size_t)(b_ * 128 + k1p_) * 128 + (tid >> 3)) * 512 + dc_ * 64 + (tid & 7) * 8; ld[0] = __builtin_nontemporal_load((const u32x4*)src_); ld[1] = __builtin_nontemporal_load((const u32x4*)(src_ + (size_t)64 * 512)); } } while (0)
    if ((int)blockIdx.x < 4096) DFT2_ISSUE((int)blockIdx.x);
    const bool gf_fixed = (gridDim.x & 7u) == 0u;
    bf16x8 gf[8];
#pragma unroll
    for (int ks = 0; ks < 8; ++ks) gf[ks] = *(const bf16x8*)(GmT + (size_t)((blockIdx.x & 7) * 64 + 32 * nt2 + l31) * 128 + 16 * ks + 8 * h);
    for (int u = blockIdx.x; u < 4096; u += gridDim.x) {
        const int dc = u & 7, k1p = (u >> 3) & 63, b = u >> 9;
        if (!gf_fixed) {
#pragma unroll
            for (int ks = 0; ks < 8; ++ks) gf[ks] = *(const bf16x8*)(GmT + (size_t)(dc * 64 + 32 * nt2 + l31) * 128 + 16 * ks + 8 * h); }
        const int k1a = k1p, k1b = k1p == 0 ? 64 : 128 - k1p;
        const int tr_e = tid >> 2, qt_e = tid & 3; const size_t tok_e = (size_t)b * SEQ + ((tr_e >> 6) ? k1b : k1a) + 128 * (tr_e & 63);
        const u32x4 g0 = __builtin_nontemporal_load((const u32x4*)(Gb + tok_e * 1024 + dc * 64 + qt_e * 16)), g1 = __builtin_nontemporal_load((const u32x4*)(Gb + tok_e * 1024 + dc * 64 + qt_e * 16 + 8));
        if (k1p == 0) {
#pragma unroll
            for (int z = 0; z < 2; ++z) { const int ci = tid + 512 * z, row = ci >> 3, ch = ci & 7; *(LAS u32x4*)(lds + row * TP + ch * 16) = ld[z]; *(LAS u32x4*)(lds + (128 + row) * TP + ch * 16) = ld[2 + z]; }
        } else {
            const int s2 = tid >> 3, ch = tid & 7;
            const u32x4 yr = ld[0], yi = ld[1];
            const float fr = (float)s2 * (1.f / 64.f); const float sn = __builtin_amdgcn_sinf(fr), cs = __builtin_amdgcn_cosf(fr);
            u32x4 zr, zi;
#pragma unroll
            for (int e = 0; e < 4; ++e) { const float rl = bflo(yr[e]), rh = bfhi(yr[e]), il = bflo(yi[e]), ih = bfhi(yi[e]);
                zr[e] = pk2(rl * cs + il * sn, rh * cs + ih * sn); zi[e] = pk2(rl * sn - il * cs, rh * sn - ih * cs); }
            *(LAS u32x4*)(lds + s2 * TP + ch * 16) = yr; *(LAS u32x4*)(lds + (64 + s2) * TP + ch * 16) = yi;
            *(LAS u32x4*)(lds + (128 + s2) * TP + ch * 16) = zr; *(LAS u32x4*)(lds + (192 + s2) * TP + ch * 16) = zi;
        }
        __syncthreads();
        if (u + (int)gridDim.x < 4096) DFT2_ISSUE(u + (int)gridDim.x);
        f32x16 acc[2]; acc[0] = f32x16{}; acc[1] = f32x16{};
#pragma unroll
        for (int ks = 0; ks < 8; ++ks) { const s16x4 lo = trrd(rb + ks * 16 * TP), hi = trrd(rb + ks * 16 * TP + 4 * TP);
            const bf16x8 bfr = __builtin_shufflevector(lo, hi, 0, 1, 2, 3, 4, 5, 6, 7);
            acc[0] = __builtin_amdgcn_mfma_f32_32x32x16_bf16(af[0][ks], bfr, acc[0], 0, 0, 0);
            acc[1] = __builtin_amdgcn_mfma_f32_32x32x16_bf16(af[1][ks], bfr, acc[1], 0, 0, 0); }
#pragma unroll
        for (int z = 0; z < 2; ++z)
#pragma unroll
            for (int i = 0; i < 16; ++i) *(LAS bf16_t*)(tt + (ksub * 64 + 32 * z + crow(i, h)) * TTP + (mh * 64 + 32 * nt + l31) * 2) = (bf16_t)f2bf(acc[z][i]);
        __syncthreads();
        f32x16 o2 = f32x16{}, o2b = f32x16{};
#pragma unroll
        for (int ks = 0; ks < 8; ks += 2) { const bf16x8 tf = *(LAS const bf16x8*)(tt + (32 * mt2 + l31) * TTP + (16 * ks + 8 * h) * 2), tf2 = *(LAS const bf16x8*)(tt + (32 * mt2 + l31) * TTP + (16 * (ks + 1) + 8 * h) * 2);
            o2 = __builtin_amdgcn_mfma_f32_32x32x16_bf16(tf, gf[ks], o2, 0, 0, 0); o2b = __builtin_amdgcn_mfma_f32_32x32x16_bf16(tf2, gf[ks + 1], o2b, 0, 0, 0); }
#pragma unroll
        for (int i = 0; i < 16; ++i) o2[i] += o2b[i];
#pragma unroll
        for (int i = 0; i < 16; ++i) ot[(32 * mt2 + crow(i, h)) * 64 + 32 * nt2 + l31] = o2[i];
        __syncthreads();
        {
            const int tr = tid >> 2, qt = tid & 3, ks2 = tr >> 6, k2 = tr & 63;
            const size_t tok = (size_t)b * SEQ + (ks2 ? k1b : k1a) + 128 * k2;
            const LAS f32x4* op = (const LAS f32x4*)(ot + tr * 64 + qt * 16);
            const f32x4 v0 = op[0], v1 = op[1], v2 = op[2], v3 = op[3];
            u32x4 w0, w1;
            w0.x = pk2(v0.x * bflo(g0.x), v0.y * bfhi(g0.x)); w0.y = pk2(v0.z * bflo(g0.y), v0.w * bfhi(g0.y)); w0.z = pk2(v1.x * bflo(g0.z), v1.y * bfhi(g0.z)); w0.w = pk2(v1.z * bflo(g0.w), v1.w * bfhi(g0.w));
            w1.x = pk2(v2.x * bflo(g1.x), v2.y * bfhi(g1.x)); w1.y = pk2(v2.z * bflo(g1.y), v2.w * bfhi(g1.y)); w1.z = pk2(v3.x * bflo(g1.z), v3.y * bfhi(g1.z)); w1.w = pk2(v3.z * bflo(g1.w), v3.w * bfhi(g1.w));
            *(u32x4*)(ym + tok * 1024 + dc * 64 + qt * 16) = w0; *(u32x4*)(ym + tok * 1024 + dc * 64 + qt * 16 + 8) = w1;
        }
        __syncthreads();
    }
}

constexpr int KP = 144, VP = 192, KROWS = 384, LDS_VOFF = KROWS * KP;
struct AUnit { int b, hd, dil, L, r, i0; };
__device__ __forceinline__ AUnit attn_decode(int u, int hd0, int nh) {
    AUnit w; const int blk32 = u & 31; w.hd = hd0 + (u >> 5) % nh; w.b = u / (32 * nh);
    const int dsh = 2 * (w.hd >> 3), nbr = 32 >> dsh; w.dil = 1 << dsh; w.L = SEQ >> dsh; w.r = blk32 / nbr; w.i0 = (blk32 % nbr) * 256; return w;
}
__device__ __forceinline__ void attn_issue(const AUnit& w, const bf16_t* Qb, const bf16_t* Kb, const bf16_t* Vb, int tid, int wave, int lane, u32x4 (&kv)[6], u32x4 (&vv)[6]) {
    const int ch = tid & 7;
#pragma unroll
    for (int i = 0; i < 6; ++i) { const int row = (tid + 512 * i) >> 3; int pk = w.i0 - 64 + row; pk = pk < 0 ? 0 : (pk >= w.L ? w.L - 1 : pk);
        const size_t off = ((size_t)(w.b * 24 + w.hd) * SEQ + (size_t)(w.r * w.L + pk)) * 64 + ch * 8; kv[i] = *(const u32x4*)(Kb + off); vv[i] = *(const u32x4*)(Vb + off); }
}
__device__ __forceinline__ float attn_tile_exp(f32x16& st, int j, float tlf, float bsl, float rlo, float rhi) {
    float sum = 0.f;
#pragma unroll
    for (int i = 0; i < 16; ++i) { const float tmp = (float)(32 * j - 64 + (i & 3) + 8 * (i >> 2)) + tlf;
        float arg = __builtin_fmaf(-bsl, __builtin_fabsf(tmp), st[i]);
        arg = (tmp >= rlo && tmp <= rhi) ? arg : -1.0e30f;
        const float pe = __builtin_amdgcn_exp2f(arg); st[i] = pe; sum += pe; }
    return sum;
}
template <bool FUSED> __device__ __forceinline__ void attn_phase(const Args& a, LAS unsigned char* lds, int tid, int lane, int wave) {
    constexpr int HD0 = FUSED ? 0 : 8, NH = FUSED ? 8 : 16, NU = 8 * NH * 32;
    asm volatile("" : "+v"(tid), "+v"(lane));
    bf16_t* Qb = (bf16_t*)(a.ws + WS_Q); const bf16_t* Kb = (const bf16_t*)(a.ws + WS_K); const bf16_t* Vb = (const bf16_t*)(a.ws + WS_V); float* LSE = (float*)(a.ws + WS_LSE);
    const int h = lane >> 5, l31 = lane & 31;
    const int q = (lane & 15) >> 2, p = lane & 3, blk = (lane >> 4) & 1;
    int u = blockIdx.x;
    u32x4 kv[6], vv[6], qv[4];
#define ATTN_QLOAD(W) do { const bf16_t* qr_ = Qb + ((size_t)((W).b * 24 + (W).hd) * SEQ + (size_t)((W).r * (W).L + (W).i0 + 32 * wave + l31)) * 64; \
        _Pragma("unroll") for (int ks_ = 0; ks_ < 4; ++ks_) qv[ks_] = *(const u32x4*)(qr_ + 16 * ks_ + 8 * h); } while (0)
    if (u < NU) { const AUnit w0 = attn_decode(u, HD0, NH); attn_issue(w0, Qb, Kb, Vb, tid, wave, lane, kv, vv); ATTN_QLOAD(w0); }
    while (u < NU) {
        const AUnit w = attn_decode(u, HD0, NH);
        const int hd = w.hd, slot = hd & 7, L = w.L, i0 = w.i0;
        const int iq = i0 + 32 * wave + l31; const size_t tq = (size_t)w.b * SEQ + (size_t)iq * w.dil + w.r;
        bf16_t* qrow = Qb + ((size_t)(w.b * 24 + hd) * SEQ + (size_t)(w.r * L + iq)) * 64;
        {
            const int ch = tid & 7;
            const f32x4 g0 = *(const f32x4*)(a.kw + hd * 64 + ch * 8), g1 = *(const f32x4*)(a.kw + hd * 64 + ch * 8 + 4);
#pragma unroll
            for (int i = 0; i < 6; ++i) { const int row = (tid + 512 * i) >> 3;
                const float e0 = bflo(kv[i].x), e1 = bfhi(kv[i].x), e2 = bflo(kv[i].y), e3 = bfhi(kv[i].y), e4 = bflo(kv[i].z), e5 = bfhi(kv[i].z), e6 = bflo(kv[i].w), e7 = bfhi(kv[i].w);
                float ss = (e0 * e0 + e1 * e1) + (e2 * e2 + e3 * e3) + (e4 * e4 + e5 * e5) + (e6 * e6 + e7 * e7);
                ss += dpp_movf<0xB1>(ss); ss += dpp_movf<0x4E>(ss); ss += dpp_movf<0x141>(ss);
                const float rk = __builtin_amdgcn_rsqf(ss * (1.f / 64.f) + 1e-6f);
                u32x4 wv; wv.x = pk2(e0 * rk * g0.x, e1 * rk * g0.y); wv.y = pk2(e2 * rk * g0.z, e3 * rk * g0.w); wv.z = pk2(e4 * rk * g1.x, e5 * rk * g1.y); wv.w = pk2(e6 * rk * g1.z, e7 * rk * g1.w);
                *(LAS u32x4*)(lds + row * KP + ch * 16) = wv;
                *(LAS u32x4*)(lds + LDS_VOFF + row * VP + ch * 16) = vv[i];
                if (i & 1) __builtin_amdgcn_sched_barrier(0); }
        }
        bf16x8 qf[4];
        {
            float ss = 0.f;
#pragma unroll
            for (int ks = 0; ks < 4; ++ks)
#pragma unroll
                for (int e = 0; e < 4; ++e) { const float lo = bflo(qv[ks][e]), hi = bfhi(qv[ks][e]); ss += lo * lo + hi * hi; }
            ss += __shfl_xor(ss, 32);
            const float rq = 0.125f * LOG2E * __builtin_amdgcn_rsqf(ss * (1.f / 64.f) + 1e-6f);
#pragma unroll
            for (int ks = 0; ks < 4; ++ks) { const f32x4 g0 = *(const f32x4*)(a.qw + hd * 64 + 16 * ks + 8 * h), g1 = *(const f32x4*)(a.qw + hd * 64 + 16 * ks + 8 * h + 4); u32x4 wv;
                wv.x = pk2(bflo(qv[ks].x) * rq * g0.x, bfhi(qv[ks].x) * rq * g0.y); wv.y = pk2(bflo(qv[ks].y) * rq * g0.z, bfhi(qv[ks].y) * rq * g0.w);
                wv.z = pk2(bflo(qv[ks].z) * rq * g1.x, bfhi(qv[ks].z) * rq * g1.y); wv.w = pk2(bflo(qv[ks].w) * rq * g1.z, bfhi(qv[ks].w) * rq * g1.w);
                qf[ks] = __builtin_bit_cast(bf16x8, wv); }
        }
        const float mb = ((const float*)(a.ws + WS_RS))[hd];
        __syncthreads();
        const int un = u + gridDim.x;
        if (un < NU) { const AUnit wn = attn_decode(un, HD0, NH); attn_issue(wn, Qb, Kb, Vb, tid, wave, lane, kv, vv); }
        const float bsl = __builtin_amdgcn_exp2f(-(float)(slot + 1)) * (float)w.dil * LOG2E;
        int tl = 4 * h - l31; asm volatile("" : "+v"(tl));
        const float tlf = (float)tl;
        const int lo_i = -iq > -64 ? -iq : -64, hi_i = (L - 1 - iq) < 64 ? (L - 1 - iq) : 64;
        const float rlo = (float)lo_i, rhi = (float)hi_i;
        const int wq0 = i0 + 32 * wave;
        const bool edge = (wq0 < 64) || (wq0 + 32 > L - 64);
        float sum = 0.f;
        f32x16 o[2]; o[0] = f32x16{}; o[1] = f32x16{};
#pragma unroll
        for (int j = 0; j < 5; ++j) {
            f32x16 st;
#pragma unroll
            for (int i = 0; i < 16; ++i) st[i] = -mb;
            LAS const unsigned char* kp = lds + (32 * wave + 32 * j + l31) * KP + 16 * h;
#pragma unroll
            for (int ks = 0; ks < 4; ++ks) { const bf16x8 kf = *(LAS const bf16x8*)(kp + 32 * ks); st = __builtin_amdgcn_mfma_f32_32x32x16_bf16(kf, qf[ks], st, 0, 0, 0); }
            sum += attn_tile_exp(st, j, tlf, bsl, rlo, rhi);
#pragma unroll
            for (int s2 = 0; s2 < 2; ++s2) { u32x4 pw; pw.x = pk2(st[8 * s2 + 0], st[8 * s2 + 1]); pw.y = pk2(st[8 * s2 + 2], st[8 * s2 + 3]); pw.z = pk2(st[8 * s2 + 4], st[8 * s2 + 5]); pw.w = pk2(st[8 * s2 + 6], st[8 * s2 + 7]);
                const bf16x8 pf = __builtin_bit_cast(bf16x8, pw);
                LAS const unsigned char* vp = lds + LDS_VOFF + (32 * wave + 32 * j + 16 * s2 + 4 * h + q) * VP + 32 * blk + 8 * p;
#pragma unroll
                for (int dt = 0; dt < 2; ++dt) { const s16x4 lo = trrd(vp + dt * 64), hi = trrd(vp + 8 * VP + dt * 64);
                    const bf16x8 vf = __builtin_shufflevector(lo, hi, 0, 1, 2, 3, 4, 5, 6, 7);
                    o[dt] = __builtin_amdgcn_mfma_f32_32x32x16_bf16(vf, pf, o[dt], 0, 0, 0); } }
            __builtin_amdgcn_sched_barrier(0);
        }
        sum += __shfl_xor(sum, 32);
        if (un < NU) { const AUnit wq = attn_decode(un, HD0, NH); ATTN_QLOAD(wq); }
        const float inv = __builtin_amdgcn_rcpf(sum);
        {
            u32x4 fo1[4], fo2[4], fg[4]; float fl1[4], fl2[4];
            if constexpr (FUSED) {
                const bf16_t* Gb = (const bf16_t*)(a.ws + WS_G);
#pragma unroll
                for (int it = 0; it < 4; ++it) { const int r = 8 * it + (lane >> 3), c16 = lane & 7, t = i0 + 32 * wave + r; const size_t tokg = (size_t)w.b * SEQ + t;
                    fl1[it] = LSE[tokg * 24 + 8 + slot]; fl2[it] = LSE[tokg * 24 + 16 + slot];
                    fo1[it] = __builtin_nontemporal_load((const u32x4*)(Qb + ((size_t)(w.b * 24 + 8 + slot) * SEQ + (t & 3) * 2048 + (t >> 2)) * 64 + c16 * 8));
                    fo2[it] = __builtin_nontemporal_load((const u32x4*)(Qb + ((size_t)(w.b * 24 + 16 + slot) * SEQ + (t & 15) * 512 + (t >> 4)) * 64 + c16 * 8));
                    fg[it] = __builtin_nontemporal_load((const u32x4*)(Gb + tokg * 1024 + 512 + slot * 64 + c16 * 8)); }
            }
            LAS unsigned char* ost = lds + 129024 + wave * 4096;
#pragma unroll
            for (int dt = 0; dt < 2; ++dt)
#pragma unroll
                for (int ig = 0; ig < 4; ++ig) { u32x2 wv; wv.x = pk2(o[dt][4 * ig] * inv, o[dt][4 * ig + 1] * inv); wv.y = pk2(o[dt][4 * ig + 2] * inv, o[dt][4 * ig + 3] * inv);
                    const int p8 = 8 * dt + 2 * ig + h; *(LAS u32x2*)(ost + l31 * 128 + 8 * (p8 ^ (l31 & 15))) = wv; }
            if constexpr (FUSED) { if (h == 0) ((LAS float*)(lds + 161808))[wave * 32 + l31] = mb + __builtin_amdgcn_logf(sum); }
            asm volatile("s_waitcnt lgkmcnt(0)" ::: "memory");
            if constexpr (!FUSED) {
                bf16_t* obase = qrow - l31 * 64;
#pragma unroll
                for (int it = 0; it < 4; ++it) { const int r = 8 * it + (lane >> 3), c16 = lane & 7;
                    u32x4 v = *(LAS const u32x4*)(ost + r * 128 + 16 * (c16 ^ ((r & 15) >> 1)));
                    if (r & 1) { const unsigned t0 = v.x, t1 = v.y; v.x = v.z; v.y = v.w; v.z = t0; v.w = t1; }
                    *(u32x4*)(obase + (size_t)r * 64 + c16 * 8) = v; asm volatile("" ::: "memory"); }
            } else {
                bf16_t* ym = (bf16_t*)(a.ws + WS_Z);
#pragma unroll
                for (int it = 0; it < 4; ++it) { const int r = 8 * it + (lane >> 3), c16 = lane & 7;
                    u32x4 v = *(LAS const u32x4*)(ost + r * 128 + 16 * (c16 ^ ((r & 15) >> 1)));
                    if (r & 1) { const unsigned t0 = v.x, t1 = v.y; v.x = v.z; v.y = v.w; v.z = t0; v.w = t1; }
                    const int t = i0 + 32 * wave + r; const size_t tokg = (size_t)w.b * SEQ + t;
                    const float l0 = ((LAS const float*)(lds + 161808))[wave * 32 + r], l1 = fl1[it], l2 = fl2[it];
                    const float mxl = fmaxf(l0, fmaxf(l1, l2));
                    float w0 = __builtin_amdgcn_exp2f(l0 - mxl), w1 = __builtin_amdgcn_exp2f(l1 - mxl), w2 = __builtin_amdgcn_exp2f(l2 - mxl);
                    const float iw = __builtin_amdgcn_rcpf(w0 + w1 + w2); w0 *= iw; w1 *= iw; w2 *= iw;
                    u32x4 ov;
#pragma unroll
                    for (int e = 0; e < 4; ++e) { const float lo = (bflo(v[e]) * w0 + bflo(fo1[it][e]) * w1 + bflo(fo2[it][e]) * w2) * bflo(fg[it][e]); const float hi = (bfhi(v[e]) * w0 + bfhi(fo1[it][e]) * w1 + bfhi(fo2[it][e]) * w2) * bfhi(fg[it][e]); ov[e] = pk2(lo, hi); }
                    *(u32x4*)(ym + tokg * 1024 + 512 + slot * 64 + c16 * 8) = ov; }
            }
        }
        if constexpr (!FUSED) { if (h == 0) LSE[tq * 24 + hd] = mb + __builtin_amdgcn_logf(sum); }
        __syncthreads();
        u = un;
    }
}
__device__ __forceinline__ void merge_phase(const Args& a, int lane, int wave) {
    asm volatile("" : "+v"(lane));
    const bf16_t* Ob = (const bf16_t*)(a.ws + WS_Q); const bf16_t* Gb = (const bf16_t*)(a.ws + WS_G); const float* LSE = (const float*)(a.ws + WS_LSE); bf16_t* ym = (bf16_t*)(a.ws + WS_Z);
    const int gw = blockIdx.x * 8 + wave, NGW = gridDim.x * 8, slot = lane >> 3;
    for (int tok0 = gw; tok0 < MTOK; tok0 += 2 * NGW) {
        u32x4 o0[2], o1[2], o2[2], g[2]; float l0[2], l1[2], l2[2];
#pragma unroll
        for (int z = 0; z < 2; ++z) { int tok = tok0 + z * NGW; tok = tok < MTOK ? tok : tok0;
            l0[z] = LSE[(size_t)tok * 24 + slot]; l1[z] = LSE[(size_t)tok * 24 + 8 + slot]; l2[z] = LSE[(size_t)tok * 24 + 16 + slot];
            const int b = tok >> 13, t = tok & (SEQ - 1), part = lane & 7;
            o0[z] = __builtin_nontemporal_load((const u32x4*)(Ob + ((size_t)(b * 24 + slot) * SEQ + t) * 64 + part * 8));
            o1[z] = __builtin_nontemporal_load((const u32x4*)(Ob + ((size_t)(b * 24 + 8 + slot) * SEQ + (t & 3) * 2048 + (t >> 2)) * 64 + part * 8));
            o2[z] = __builtin_nontemporal_load((const u32x4*)(Ob + ((size_t)(b * 24 + 16 + slot) * SEQ + (t & 15) * 512 + (t >> 4)) * 64 + part * 8));
            g[z] = __builtin_nontemporal_load((const u32x4*)(Gb + (size_t)tok * 1024 + 512 + lane * 8)); }
#pragma unroll
        for (int z = 0; z < 2; ++z) { const int tok = tok0 + z * NGW; if (tok >= MTOK) break;
            const float mx = fmaxf(l0[z], fmaxf(l1[z], l2[z]));
            float w0 = __builtin_amdgcn_exp2f(l0[z] - mx), w1 = __builtin_amdgcn_exp2f(l1[z] - mx), w2 = __builtin_amdgcn_exp2f(l2[z] - mx);
            const float inv = 1.0f / (w0 + w1 + w2); w0 *= inv; w1 *= inv; w2 *= inv;
            u32x4 w;
#pragma unroll
            for (int e = 0; e < 4; ++e) { const float lo = (bflo(o0[z][e]) * w0 + bflo(o1[z][e]) * w1 + bflo(o2[z][e]) * w2) * bflo(g[z][e]); const float hi = (bfhi(o0[z][e]) * w0 + bfhi(o1[z][e]) * w1 + bfhi(o2[z][e]) * w2) * bfhi(g[z][e]); w[e] = pk2(lo, hi); }
            *(u32x4*)(ym + (size_t)tok * 1024 + 512 + lane * 8) = w; }
    }
}

#define XB_TMO      128
#define XB_XCNT(j)  (256  + 64 * (j))
#define XB_XSUB(j)  (1280 + 64 * (j))
#define XB_XGEN(j)  (2304 + 64 * (j))
#define XB_TOP      3328
#define XB_TOPGEN   3392
#define XCD_BAR_WORDS 3456
#define XB_SPIN_CAP (1u << 18)

__device__ __forceinline__ unsigned xb_ld(unsigned* p)              { return __hip_atomic_load(p, __ATOMIC_RELAXED, __HIP_MEMORY_SCOPE_AGENT); }
__device__ __forceinline__ unsigned xb_add(unsigned* p, unsigned v) { return __hip_atomic_fetch_add(p, v, __ATOMIC_RELAXED, __HIP_MEMORY_SCOPE_AGENT); }
__device__ __forceinline__ unsigned xb_xcc_id() { return (unsigned)__builtin_amdgcn_s_getreg((3 << 11) | 20) & 0xFu; }
#define XB_SPIN(cond, bar) do { unsigned _sp = 0; while (cond) { __builtin_amdgcn_s_sleep(1); \
    if ((++_sp & 255u) == 0u) { if (xb_ld(&(bar)[XB_TMO])) break; if (_sp > XB_SPIN_CAP) { atomicAdd(&(bar)[XB_TMO], 1u); break; } } } } while (0)

struct XcdBarrier {
    unsigned* bar; unsigned x;
    volatile LAS unsigned* st;
};

__device__ __forceinline__ XcdBarrier xcd_barrier_post(unsigned* bar, volatile LAS unsigned* st) {
    XcdBarrier b; b.bar = bar; b.x = xb_xcc_id(); b.st = st;
    if (threadIdx.x == 0) (void)xb_add(&bar[XB_XCNT(b.x)], 1u);
    return b;
}
__device__ __forceinline__ void xcd_barrier_complete(unsigned* bar, unsigned x, unsigned& nloc, unsigned& nx) {
    const unsigned G = gridDim.x * gridDim.y * gridDim.z;
    unsigned sum, cnt, mine, sp = 0u;
    for (;;) {
        sum = 0u; cnt = 0u; mine = 0u;
#pragma unroll
        for (unsigned j = 0; j < 16; ++j) { const unsigned c = xb_ld(&bar[XB_XCNT(j)]); sum += c; cnt += (c > 0u) ? 1u : 0u; mine = (j == x) ? c : mine; }
        if (sum == G) break;
        __builtin_amdgcn_s_sleep(1);
        if ((++sp & 255u) == 0u) { if (xb_ld(&bar[XB_TMO])) break; if (sp > XB_SPIN_CAP) { atomicAdd(&bar[XB_TMO], 1u); break; } }
    }
    nloc = mine > 0u ? mine : 1u; nx = cnt > 0u ? cnt : 1u;
}

__device__ __forceinline__ void xcd_barrier(const XcdBarrier& b) {
    asm volatile("s_waitcnt vmcnt(0)" ::: "memory");
    __syncthreads();
    if (threadIdx.x == 0) {
        unsigned* bar = b.bar;
        __builtin_amdgcn_s_waitcnt(0);
        unsigned nloc = b.st[0], nx = b.st[1];
        if (nloc == 0u) { xcd_barrier_complete(bar, b.x, nloc, nx); b.st[0] = nloc; b.st[1] = nx; }
        const unsigned old = xb_add(&bar[XB_XSUB(b.x)], 1u);
        const unsigned gen = old / nloc;
        if (old + 1u == (gen + 1u) * nloc) {
            __builtin_amdgcn_fence(__ATOMIC_RELEASE, "agent");
            asm volatile("s_waitcnt vmcnt(0)" ::: "memory");
            const unsigned og = xb_add(&bar[XB_TOP], 1u);
            const unsigned tg = og / nx;
            if (og + 1u == (tg + 1u) * nx) xb_add(&bar[XB_TOPGEN], 1u);
            else XB_SPIN(xb_ld(&bar[XB_TOPGEN]) == tg, bar);
            __builtin_amdgcn_fence(__ATOMIC_ACQUIRE, "agent");
            xb_add(&bar[XB_XGEN(b.x)], 1u);
            asm volatile("s_waitcnt vmcnt(0)" ::: "memory");
        } else {
            XB_SPIN(xb_ld(&bar[XB_XGEN(b.x)]) == gen, bar);
            __builtin_amdgcn_fence(__ATOMIC_ACQUIRE, "agent");
            asm volatile("s_waitcnt vmcnt(0)" ::: "memory");
        }
    }
    __syncthreads();
}

__global__ void __launch_bounds__(512, 2) mega_fwd(Args a) {
    extern __shared__ __attribute__((aligned(16))) unsigned char lds_raw[];
    LAS unsigned char* lds = (LAS unsigned char*)lds_raw;
    cg::grid_group grid = cg::this_grid();
    const int tid = threadIdx.x, lane = tid & 63, wave = __builtin_amdgcn_readfirstlane(tid >> 6);
    volatile LAS unsigned* bst = (volatile LAS unsigned*)(lds + 161792);
    if (tid < 2) bst[tid] = 0u;
    __syncthreads();
    XcdBarrier bar = xcd_barrier_post((unsigned*)(a.ws + WS_BAR), bst);
    if (a.ws == nullptr) grid.sync();
#ifndef REP0
#define REP0 1
#define REP1 1
#define REPD1 1
#define REPD2 1
#define REPM 1
#define REP4 1
#endif
    for (int rep = 0; rep < REP0; ++rep) phase0(a, lds, tid, lane, wave);
    xcd_barrier(bar);
    {
        pg8::Gemm g{(const pg8::bf16_t*)(a.ws + WS_XB), (const pg8::bf16_t*)(a.ws + WS_WT), MTOK, NIN, DM}; pg8::StaticOrder S; S.init(MTOK, NIN, gridDim.x, (int)blockIdx.x, REP1);
        Epi1 E{(bf16_t*)(a.ws + WS_Z), (bf16_t*)(a.ws + WS_G), (bf16_t*)(a.ws + WS_Q), (bf16_t*)(a.ws + WS_K), (bf16_t*)(a.ws + WS_V)};
        pg8::gemm_phase<Epi1, pg8::StaticOrder, true, true>(lds, g, S, E);
    }
    xcd_barrier(bar);
    attn_phase<false>(a, lds, tid, lane, wave);
    for (int rep = 0; rep < REPD1; ++rep) dft1_phase(a, lds, tid, lane, wave);
    xcd_barrier(bar);
    for (int rep = 0; rep < REPD2; ++rep) dft2_phase(a, lds, tid, lane, wave);
    attn_phase<true>(a, lds, tid, lane, wave);
    xcd_barrier(bar);
    {
        pg8::Gemm g{(const pg8::bf16_t*)(a.ws + WS_Z), (const pg8::bf16_t*)(a.ws + WS_WOT), MTOK, DM, DM}; pg8::StaticOrder S; S.init(MTOK, DM, gridDim.x, (int)blockIdx.x, REP4);
        Epi2 E{a.x, a.out};
        pg8::gemm_phase<Epi2, pg8::StaticOrder, true, true>(lds, g, S, E);
    }
}

extern "C" void kernel_launch(void* const* d_in, const int* in_sizes, int n_in, void* d_out, int out_size, void* d_ws, size_t ws_size, hipStream_t stream) {
    static int grid = 0;
    if (grid == 0) {
        if (n_in != 7 || in_sizes[0] != MTOK * DM || out_size != MTOK * DM || ws_size < WS_END) { fprintf(stderr, "kernel_launch: unexpected shapes / workspace (%d inputs, ws %zu)\n", n_in, ws_size); grid = -1; return; }
        int dev = 0, cus = 0, per_cu = 0;
        hipGetDevice(&dev); hipDeviceGetAttribute(&cus, hipDeviceAttributeMultiprocessorCount, dev);
        hipFuncSetAttribute((const void*)mega_fwd, hipFuncAttributeMaxDynamicSharedMemorySize, LDS_BYTES);
        hipOccupancyMaxActiveBlocksPerMultiprocessor(&per_cu, (const void*)mega_fwd, 512, LDS_BYTES);
        if (per_cu < 1) { fprintf(stderr, "kernel_launch: occupancy query says %d blocks per CU\n", per_cu); per_cu = 1; }
        grid = cus;
        (void)hipGetLastError();
    }
    if (grid < 0) return;
    Args a{};
    a.x = (const float*)d_in[0]; a.norm_w = (const float*)d_in[1]; a.w_in = (const float*)d_in[2]; a.qw = (const float*)d_in[3]; a.kw = (const float*)d_in[4];
    a.wf = (const float*)d_in[5]; a.w_out = (const float*)d_in[6]; a.out = (float*)d_out; a.ws = (unsigned char*)d_ws;
    if (hipMemsetAsync((char*)d_ws + WS_BAR, 0, 16384, stream) != hipSuccess) { fprintf(stderr, "kernel_launch: memset of the barrier words failed\n"); return; }
    void* args[] = {&a};
    hipError_t e = hipLaunchCooperativeKernel((const void*)mega_fwd, dim3(grid), dim3(512), args, LDS_BYTES, stream);
    if (e != hipSuccess) fprintf(stderr, "cooperative launch failed: %s (grid %d)\n", hipGetErrorString(e), grid);
}
```
